# Optimizing an MI355X kernel written in HIP

```python
import math
import numpy as np
import jax
import jax.numpy as jnp
from jax import lax

D_MODEL = 2048
BATCH = 8
SEQ = 4096
DEPTH = 4

HEAD_DIM = 128
D_MIX = D_MODEL
N_HEADS_TOTAL = D_MIX // HEAD_DIM
N_HEADS_B = N_HEADS_TOTAL // 4
N_HEADS_C = (3 * N_HEADS_TOTAL) // 8
N_HEADS_A = N_HEADS_TOTAL - N_HEADS_B - N_HEADS_C
CONV_WIDTH = 4
GDN_CHUNK = 64
SGU_CHUNK = 128
NSA_KV_HEADS = 2
CMP_LEN = 32
CMP_STRIDE = 16
SEL_LEN = 64
SEL_TOPK = 16
SEL_QBLOCK = 32
WINDOW = 512
WIN_BLOCK = 128
RPB_BUCKETS = 32
RPB_MAX_DIST = 128
D_FF = 4 * D_MODEL
NORM_EPS = 1e-6
NEG_BIG = -1e30
SEL_FORCE = 1e9

kernel_name = 'hybrid_gdn_sgu_nsa_trunk'


def _proj_sizes():
    da = N_HEADS_A * HEAD_DIM
    db = N_HEADS_B * HEAD_DIM
    dc = N_HEADS_C * HEAD_DIM
    dkv = NSA_KV_HEADS * HEAD_DIM
    return [da, da, da, da, N_HEADS_A, N_HEADS_A, db, db, dc, dkv, dkv, dkv, dkv, dkv, dkv, 3 * N_HEADS_C]


def _split_points():
    return [int(v) for v in np.cumsum(_proj_sizes())[:-1]]


def _rms_norm(x, gain):
    xf = x.astype(jnp.float32)
    y = xf * lax.rsqrt(jnp.mean(xf * xf, axis=-1, keepdims=True) + NORM_EPS)
    return (y * gain.astype(jnp.float32)).astype(x.dtype)


def _layer_norm(x, gain, bias):
    xf = x.astype(jnp.float32)
    mu = jnp.mean(xf, axis=-1, keepdims=True)
    var = jnp.mean(jnp.square(xf - mu), axis=-1, keepdims=True)
    y = (xf - mu) * lax.rsqrt(var + NORM_EPS) * gain.astype(jnp.float32) + bias.astype(jnp.float32)
    return y.astype(x.dtype)


def _l2norm(x):
    return x * lax.rsqrt(jnp.sum(x * x, axis=-1, keepdims=True) + NORM_EPS)


def _masked_softmax(s, mask):
    s = jnp.where(mask, s.astype(jnp.float32), NEG_BIG)
    m = jnp.max(s, axis=-1, keepdims=True)
    p = jnp.where(mask, jnp.exp(s - m), 0.0)
    return p / jnp.maximum(jnp.sum(p, axis=-1, keepdims=True), 1e-30)


def _t5_bucket(dist):
    n = jnp.maximum(dist, 0)
    max_exact = RPB_BUCKETS // 2
    log_ratio = jnp.log(jnp.maximum(n, 1).astype(jnp.float32) / max_exact) / math.log(RPB_MAX_DIST / max_exact)
    large = jnp.minimum(max_exact + (log_ratio * (RPB_BUCKETS - max_exact)).astype(jnp.int32), RPB_BUCKETS - 1)
    return jnp.where(n < max_exact, n, large)


def _rel_bias(dist, table):
    b = table[_t5_bucket(dist)]
    return jnp.moveaxis(b, -1, 0).reshape(NSA_KV_HEADS, N_HEADS_C // NSA_KV_HEADS, *dist.shape)


def _causal_short_conv(x, w):
    k = w.shape[0]
    s_ = x.shape[1]
    xp = jnp.pad(x, ((0, 0), (k - 1, 0), (0, 0)))
    y = xp[:, 0:s_] * w[0]
    for j in range(1, k):
        y = y + xp[:, j:j + s_] * w[j]
    return y


def _gated_delta_rule(q, k, v, g, beta):
    b_, h_, s_, dk = q.shape
    dv = v.shape[-1]
    c = GDN_CHUNK
    n = s_ // c
    q = q * (dk ** -0.5)
    q, k, v = (t.reshape(b_, h_, n, c, t.shape[-1]) for t in (q, k, v))
    g = jnp.cumsum(g.reshape(b_, h_, n, c), axis=-1)
    beta = beta.reshape(b_, h_, n, c)
    incl = jnp.tril(jnp.ones((c, c), dtype=bool))
    strict = jnp.tril(jnp.ones((c, c), dtype=bool), -1)
    decay = jnp.exp(jnp.where(incl, g[..., :, None] - g[..., None, :], -jnp.inf))
    k_beta = k * beta[..., None]
    v_beta = v * beta[..., None]
    lower = jnp.where(strict, jnp.einsum('bhnik,bhnjk->bhnij', k_beta, k) * decay, 0.0)
    eye = jnp.eye(c, dtype=q.dtype)
    t_inv = lax.linalg.triangular_solve(lower + eye, jnp.broadcast_to(eye, lower.shape),
                                        left_side=True, lower=True, unit_diagonal=True)
    u = t_inv @ v_beta
    w = t_inv @ (k_beta * jnp.exp(g)[..., None])
    a_intra = jnp.where(incl, jnp.einsum('bhnik,bhnjk->bhnij', q, k) * decay, 0.0)

    def step(state, xs):
        q_c, k_c, u_c, w_c, g_c, a_c = xs
        v_new = u_c - w_c @ state
        o_c = (q_c * jnp.exp(g_c)[..., None]) @ state + a_c @ v_new
        g_last = g_c[..., -1:]
        state = state * jnp.exp(g_last)[..., None] + jnp.einsum(
            'bhck,bhcv->bhkv', k_c * jnp.exp(g_last - g_c)[..., None], v_new)
        return state, o_c

    xs = tuple(jnp.moveaxis(t, 2, 0) for t in (q, k, u, w, g, a_intra))
    state0 = jnp.zeros((b_, h_, dk, dv), q.dtype)
    _, o = lax.scan(step, state0, xs)
    return jnp.moveaxis(o, 0, 2).reshape(b_, h_, s_, dv)


def _mixer_gdn(q, k, v, z, b_raw, a_raw, conv_w, a_log, dt_bias, norm_g):
    out_dtype = q.dtype
    bsz, s_, _ = q.shape
    h_, d_ = N_HEADS_A, HEAD_DIM
    qkv = jax.nn.silu(_causal_short_conv(jnp.concatenate([q, k, v], axis=-1), conv_w))
    q, k, v = jnp.split(qkv.astype(jnp.float32), 3, axis=-1)
    heads = lambda t: t.reshape(bsz, s_, h_, d_).transpose(0, 2, 1, 3)
    q, k, v = _l2norm(heads(q)), _l2norm(heads(k)), heads(v)
    beta = jax.nn.sigmoid(b_raw.astype(jnp.float32)).transpose(0, 2, 1)
    g = (-jnp.exp(a_log.astype(jnp.float32))
         * jax.nn.softplus(a_raw.astype(jnp.float32) + dt_bias.astype(jnp.float32))).transpose(0, 2, 1)
    o = _gated_delta_rule(q, k, v, g, beta).transpose(0, 2, 1, 3)
    o = _rms_norm(o, norm_g) * jax.nn.silu(z.astype(jnp.float32).reshape(bsz, s_, h_, d_))
    return o.reshape(bsz, s_, h_ * d_).astype(out_dtype)


def _mixer_sgu(u, v, ln_g, ln_b, w_s, b_s):
    bsz, s_, _ = u.shape
    n = s_ // SGU_CHUNK
    u = jax.nn.gelu(u)
    v = _layer_norm(jax.nn.gelu(v), ln_g, ln_b)
    v = v.reshape(bsz, n, SGU_CHUNK, N_HEADS_B, HEAD_DIM)
    causal = jnp.tril(jnp.ones((SGU_CHUNK, SGU_CHUNK), dtype=bool))
    w = jnp.where(causal, w_s, 0.0).astype(v.dtype)
    mixed = jnp.einsum('gts,bnsgc->bntgc', w, v) + b_s.T[None, None, :, :, None].astype(v.dtype)
    return u * mixed.reshape(bsz, s_, N_HEADS_B * HEAD_DIM)


def _mixer_nsa(q, k_cmp, v_cmp, k_slc, v_slc, k_win, v_win, gate_raw,
               q_norm_g, k_norm_g, cmp_pos, cmp_w1, cmp_w2, rel_bias):
    bsz, s_, _ = q.shape
    g_, h_, d_ = NSA_KV_HEADS, N_HEADS_C, HEAD_DIM
    r_ = h_ // g_
    pos = jnp.arange(s_, dtype=jnp.int32)
    q = _rms_norm(q.reshape(bsz, s_, g_, r_, d_), q_norm_g).transpose(0, 2, 3, 1, 4) * (d_ ** -0.5)
    kv_heads = lambda t: t.reshape(bsz, s_, g_, d_).transpose(0, 2, 1, 3)

    n_cmp = (s_ - CMP_LEN) // CMP_STRIDE + 1
    cmp_start = np.arange(n_cmp) * CMP_STRIDE
    blk_idx = cmp_start[:, None] + np.arange(CMP_LEN)[None, :]

    def compress(t, p, w1, w2):
        blocks = t[:, :, blk_idx] + p
        return jax.nn.gelu(blocks.reshape(bsz, g_, n_cmp, CMP_LEN * d_) @ w1) @ w2

    kc = _rms_norm(compress(kv_heads(k_cmp), cmp_pos[0], cmp_w1[0], cmp_w2[0]), k_norm_g)
    vc = compress(kv_heads(v_cmp), cmp_pos[1], cmp_w1[1], cmp_w2[1])
    cmp_end = jnp.asarray(cmp_start + CMP_LEN - 1, dtype=jnp.int32)
    dist_c = pos[:, None] - cmp_end[None, :]
    s_c = jnp.einsum('bgrsd,bgnd->bgrsn', q, kc) + _rel_bias(dist_c, rel_bias)
    p_c = _masked_softmax(s_c, dist_c >= 0)
    o_c = jnp.einsum('bgrsn,bgnd->bgrsd', p_c.astype(vc.dtype), vc)

    n_sel = s_ // SEL_LEN
    sel_start = np.arange(n_sel) * SEL_LEN
    overlap = (cmp_start[:, None] < sel_start[None, :] + SEL_LEN) & (cmp_start[:, None] + CMP_LEN > sel_start[None, :])
    importance = jnp.einsum('bgrsn,nj->bgsj', p_c, jnp.asarray(overlap, jnp.float32))
    cur = pos // SEL_LEN
    jsel = jnp.arange(n_sel, dtype=jnp.int32)
    causal_blk = jsel[None, :] <= cur[:, None]
    forced = (jsel[None, :] == 0) | (jsel[None, :] == cur[:, None]) | (jsel[None, :] == cur[:, None] - 1)
    score = jnp.where(forced, SEL_FORCE, jnp.where(causal_blk, importance, NEG_BIG))
    n_top = min(SEL_TOPK, n_sel)
    top_score, top_idx = lax.top_k(score, n_top)
    top_ok = top_score > 0.5 * NEG_BIG

    ks = _rms_norm(kv_heads(k_slc), k_norm_g).reshape(bsz, g_, n_sel, SEL_LEN, d_)
    vs = kv_heads(v_slc).reshape(bsz, g_, n_sel, SEL_LEN, d_)
    qb_len = SEL_QBLOCK
    n_qb = s_ // qb_len
    gather = jax.vmap(jax.vmap(lambda blocks, idx: blocks[idx]))
    table_g = rel_bias.reshape(RPB_BUCKETS, g_, r_).transpose(1, 0, 2)
    g_ar = jnp.arange(g_)[None, :, None, None, None]

    def sel_block(args):
        qb, idxb, okb, i = args
        kg = gather(ks, idxb)
        vg = gather(vs, idxb)
        qpos = i * qb_len + jnp.arange(qb_len, dtype=jnp.int32)
        kpos = idxb[..., None] * SEL_LEN + jnp.arange(SEL_LEN, dtype=jnp.int32)
        dist = qpos[None, None, :, None, None] - kpos
        mask = okb[..., None] & (dist >= 0)
        bias = table_g[g_ar, _t5_bucket(dist)].transpose(0, 1, 5, 2, 3, 4)
        s = jnp.einsum('bgrqd,bgqnld->bgrqnl', qb, kg) + bias
        p = _masked_softmax(s.reshape(bsz, g_, r_, qb_len, n_top * SEL_LEN),
                            mask.reshape(bsz, g_, 1, qb_len, n_top * SEL_LEN))
        return jnp.einsum('bgrqm,bgqmd->bgrqd', p.astype(vg.dtype),
                          vg.reshape(bsz, g_, qb_len, n_top * SEL_LEN, d_))

    xs = (jnp.moveaxis(q.reshape(bsz, g_, r_, n_qb, qb_len, d_), 3, 0),
          jnp.moveaxis(top_idx.reshape(bsz, g_, n_qb, qb_len, n_top), 2, 0),
          jnp.moveaxis(top_ok.reshape(bsz, g_, n_qb, qb_len, n_top), 2, 0),
          jnp.arange(n_qb, dtype=jnp.int32))
    o_s = lax.map(sel_block, xs)
    o_s = jnp.moveaxis(o_s, 0, 3).reshape(bsz, g_, r_, s_, d_)

    n_prev = WINDOW // WIN_BLOCK
    n_wb = s_ // WIN_BLOCK
    band_len = (n_prev + 1) * WIN_BLOCK

    def band(t):
        tp = jnp.pad(t, ((0, 0), (0, 0), (n_prev * WIN_BLOCK, 0), (0, 0))).reshape(bsz, g_, n_wb + n_prev, WIN_BLOCK, d_)
        return jnp.concatenate([tp[:, :, j:j + n_wb] for j in range(n_prev + 1)], axis=3)

    kw = band(_rms_norm(kv_heads(k_win), k_norm_g))
    vw = band(kv_heads(v_win))
    qpos_w = pos.reshape(n_wb, WIN_BLOCK)
    kpos_w = (jnp.arange(n_wb, dtype=jnp.int32)[:, None] - n_prev) * WIN_BLOCK + jnp.arange(band_len, dtype=jnp.int32)[None, :]
    dist_w = qpos_w[:, :, None] - kpos_w[:, None, :]
    mask_w = (dist_w >= 0) & (dist_w < WINDOW) & (kpos_w[:, None, :] >= 0)
    s_w = jnp.einsum('bgrnqd,bgnkd->bgrnqk', q.reshape(bsz, g_, r_, n_wb, WIN_BLOCK, d_), kw) + _rel_bias(dist_w, rel_bias)
    p_w = _masked_softmax(s_w, mask_w)
    o_w = jnp.einsum('bgrnqk,bgnkd->bgrnqd', p_w.astype(vw.dtype), vw).reshape(bsz, g_, r_, s_, d_)

    gates = jax.nn.sigmoid(gate_raw.astype(jnp.float32)).reshape(bsz, s_, 3, g_, r_)
    gates = gates.transpose(2, 0, 3, 4, 1)[..., None].astype(o_c.dtype)
    o = gates[0] * o_c + gates[1] * o_s + gates[2] * o_w
    return o.transpose(0, 3, 1, 2, 4).reshape(bsz, s_, h_ * d_)


def setup_inputs(seed: int = 0) -> dict:
    key = jax.random.key(seed)
    ks = jax.random.split(key, 21)
    f32 = jnp.float32
    nrm = lambda k, shape, scale: scale * jax.random.normal(k, shape, f32)
    gain = lambda k, shape: 1.0 + 0.02 * jax.random.normal(k, shape, f32)
    d_proj = sum(_proj_sizes())
    x = jax.random.normal(ks[0], (BATCH, SEQ, D_MODEL), f32)
    attn_norm = gain(ks[1], (DEPTH, D_MODEL))
    w_in = nrm(ks[2], (DEPTH, D_MODEL, d_proj), D_MODEL ** -0.5)
    conv_a = nrm(ks[3], (DEPTH, CONV_WIDTH, 3 * N_HEADS_A * HEAD_DIM), CONV_WIDTH ** -0.5)
    a_log = jnp.log(jax.random.uniform(ks[4], (DEPTH, N_HEADS_A), f32, 1.0, 16.0))
    dt = jnp.exp(jax.random.uniform(ks[5], (DEPTH, N_HEADS_A), f32, math.log(1e-3), math.log(1e-1)))
    dt_bias = dt + jnp.log(-jnp.expm1(-dt))
    gdn_norm = gain(ks[6], (DEPTH, HEAD_DIM))
    sgu_ln_g = gain(ks[7], (DEPTH, N_HEADS_B * HEAD_DIM))
    sgu_ln_b = nrm(ks[8], (DEPTH, N_HEADS_B * HEAD_DIM), 0.02)
    sgu_w = nrm(ks[9], (DEPTH, N_HEADS_B, SGU_CHUNK, SGU_CHUNK), SGU_CHUNK ** -0.5)
    sgu_b = gain(ks[10], (DEPTH, N_HEADS_B, SGU_CHUNK))
    nsa_q_norm = gain(ks[11], (DEPTH, HEAD_DIM))
    nsa_k_norm = gain(ks[12], (DEPTH, HEAD_DIM))
    cmp_pos = nrm(ks[13], (DEPTH, 2, CMP_LEN, HEAD_DIM), 0.02)
    cmp_w1 = nrm(ks[14], (DEPTH, 2, CMP_LEN * HEAD_DIM, HEAD_DIM), (CMP_LEN * HEAD_DIM) ** -0.5)
    cmp_w2 = nrm(ks[15], (DEPTH, 2, HEAD_DIM, HEAD_DIM), HEAD_DIM ** -0.5)
    rel_bias = nrm(ks[16], (RPB_BUCKETS, N_HEADS_C), 0.2)
    w_out = nrm(ks[17], (DEPTH, D_MIX, D_MODEL), D_MIX ** -0.5)
    mlp_norm = gain(ks[18], (DEPTH, D_MODEL))
    w_up = nrm(ks[19], (DEPTH, D_MODEL, D_FF), D_MODEL ** -0.5)
    w_down = nrm(ks[20], (DEPTH, D_FF, D_MODEL), D_FF ** -0.5)
    return {'x': x, 'attn_norm': attn_norm, 'w_in': w_in, 'conv_a': conv_a, 'a_log': a_log,
            'dt_bias': dt_bias, 'gdn_norm': gdn_norm, 'sgu_ln_g': sgu_ln_g, 'sgu_ln_b': sgu_ln_b,
            'sgu_w': sgu_w, 'sgu_b': sgu_b, 'nsa_q_norm': nsa_q_norm, 'nsa_k_norm': nsa_k_norm,
            'cmp_pos': cmp_pos, 'cmp_w1': cmp_w1, 'cmp_w2': cmp_w2, 'rel_bias': rel_bias,
            'w_out': w_out, 'mlp_norm': mlp_norm, 'w_up': w_up, 'w_down': w_down}


def reference(x, attn_norm, w_in, conv_a, a_log, dt_bias, gdn_norm, sgu_ln_g, sgu_ln_b, sgu_w, sgu_b,
              nsa_q_norm, nsa_k_norm, cmp_pos, cmp_w1, cmp_w2, rel_bias, w_out, mlp_norm, w_up, w_down):
    for l in range(DEPTH):
        h = _rms_norm(x, attn_norm[l])
        (qa, ka, va, za, ba, aa, ub, vb, qc, kcc, vcc, ksl, vsl, kwn, vwn, gc) = jnp.split(
            h @ w_in[l], _split_points(), axis=-1)
        mix = jnp.concatenate([
            _mixer_gdn(qa, ka, va, za, ba, aa, conv_a[l], a_log[l], dt_bias[l], gdn_norm[l]),
            _mixer_sgu(ub, vb, sgu_ln_g[l], sgu_ln_b[l], sgu_w[l], sgu_b[l]),
            _mixer_nsa(qc, kcc, vcc, ksl, vsl, kwn, vwn, gc, nsa_q_norm[l], nsa_k_norm[l],
                       cmp_pos[l], cmp_w1[l], cmp_w2[l], rel_bias),
        ], axis=-1)
        x = x + mix @ w_out[l]
        h = _rms_norm(x, mlp_norm[l])
        x = x + jnp.square(jax.nn.relu(h @ w_up[l])) @ w_down[l]
    return x
```

```cpp
#include <hip/hip_runtime.h>
#include <cstdio>
#include <cstdint>
namespace pg8 {
#define PG8_LAS __attribute__((address_space(3)))
typedef unsigned short bf16_t;
typedef short bf16x8 __attribute__((ext_vector_type(8)));
typedef float f32x4 __attribute__((ext_vector_type(4)));
typedef unsigned u32x4 __attribute__((ext_vector_type(4)));
constexpr int BM = 256, BK = 64, HALF = 128, HTB = HALF * BK * 2  , STAGE_BYTES = 8 * HTB, NXCD = 8, WGM = 8;

__host__ __device__ __forceinline__ int lds_byte(int r, int c) { const int st = (r >> 4) * 2 + (c >> 5), rr = r & 15, cc = c & 31, ob = rr * 64 + cc * 2; return st * 1024 + (ob ^ (((ob >> 9) & 1) << 5)); }
__host__ __device__ __forceinline__ void stage_rc(int b, int& R, int& C) { const int st = b / 1024, sb = b % 1024, swz = sb ^ (((sb >> 9) & 1) << 5); R = (st >> 1) * 16 + swz / 64; C = (st & 1) * 32 + (swz % 64) / 2; }
__host__ __device__ __forceinline__ int perm32(int rho) { const int n = rho >> 4, i = rho & 15; return 8 * (i >> 2) + 4 * n + (i & 3); }

struct Unit { int pm, pn; };
struct Gemm { const bf16_t* A; const bf16_t* Bt; int M, N, K, pad; };

struct StaticOrder {
    int nM, nN, nwg, G, c;
    __host__ __device__ void init(int M, int N, int G_, int c_) { nM = M / BM; nN = N / BM; nwg = nM * nN; G = G_; c = c_; }
    __host__ __device__ bool next(int i, Unit& u) const {
        const long L = (long)i * G + c; if (L >= nwg) return false;
        int wgid = (int)L; { const int q = nwg / NXCD, r = nwg % NXCD, xcd = wgid % NXCD, off = wgid / NXCD; wgid = (xcd < r ? xcd * (q + 1) : r * (q + 1) + (xcd - r) * q) + off; }
        const int nig = WGM * nN, gid = wgid / nig, fm = gid * WGM, gsz = (nM - fm) < WGM ? (nM - fm) : WGM;
        u.pm = fm + ((wgid % nig) % gsz); u.pn = (wgid % nig) / gsz; return true;
    }
    __device__ __forceinline__ void a_ready(const Unit&) const {}
    __device__ __forceinline__ void done(const Unit&) const {}
};
__device__ __forceinline__ unsigned cvt_pk_bf16(float lo, float hi) { unsigned r; asm volatile("v_cvt_pk_bf16_f32 %0, %1, %2" : "=v"(r) : "v"(lo), "v"(hi)); return r; }

struct EpiProj {
    static constexpr bool PERM = true, AFTER_DRAIN = false;
    bf16_t* O; float* small; int ldc; int small_pn;
    __device__ __forceinline__ void operator()(const f32x4 (&acc)[2][2][4][2], const Unit& u, int wr, int wc, int fr, int fq) const {
        const int row0 = u.pm * BM + wr * 64 + fr;
        if (u.pn == small_pn) {
            if (wc == 0) {
#pragma unroll
                for (int ai = 0; ai < 2; ++ai)
#pragma unroll
                    for (int m = 0; m < 4; ++m) { float* p = small + (size_t)(row0 + ai * HALF + m * 16) * 32 + 8 * fq;
                        *(f32x4*)p = acc[ai][0][m][0]; *(f32x4*)(p + 4) = acc[ai][0][m][1]; }
            }
            return;
        }
        const int col0 = u.pn * BM + wc * 32 + 8 * fq;
#pragma unroll
        for (int ai = 0; ai < 2; ++ai)
#pragma unroll
            for (int m = 0; m < 4; ++m) { bf16_t* rowp = O + (size_t)(row0 + ai * HALF + m * 16) * ldc + col0;
#pragma unroll
                for (int bj = 0; bj < 2; ++bj) { const f32x4 v0 = acc[ai][bj][m][0], v1 = acc[ai][bj][m][1];
                    u32x4 w; w.x = cvt_pk_bf16(v0[0], v0[1]); w.y = cvt_pk_bf16(v0[2], v0[3]); w.z = cvt_pk_bf16(v1[0], v1[1]); w.w = cvt_pk_bf16(v1[2], v1[3]);
                    *(u32x4*)(rowp + bj * HALF) = w; } }
    }
};
struct EpiRelu2 {
    static constexpr bool PERM = true, AFTER_DRAIN = false;
    bf16_t* O; int ldc; int pad;
    __device__ __forceinline__ void operator()(const f32x4 (&acc)[2][2][4][2], const Unit& u, int wr, int wc, int fr, int fq) const {
        const int row0 = u.pm * BM + wr * 64 + fr;
        const int col0 = u.pn * BM + wc * 32 + 8 * fq;
#pragma unroll
        for (int ai = 0; ai < 2; ++ai)
#pragma unroll
            for (int m = 0; m < 4; ++m) { bf16_t* rowp = O + (size_t)(row0 + ai * HALF + m * 16) * ldc + col0;
#pragma unroll
                for (int bj = 0; bj < 2; ++bj) { f32x4 v0 = acc[ai][bj][m][0], v1 = acc[ai][bj][m][1];
#pragma unroll
                    for (int j = 0; j < 4; ++j) { const float a = fmaxf(v0[j], 0.f), b = fmaxf(v1[j], 0.f); v0[j] = a * a; v1[j] = b * b; }
                    u32x4 w; w.x = cvt_pk_bf16(v0[0], v0[1]); w.y = cvt_pk_bf16(v0[2], v0[3]); w.z = cvt_pk_bf16(v1[0], v1[1]); w.w = cvt_pk_bf16(v1[2], v1[3]);
                    *(u32x4*)(rowp + bj * HALF) = w; } }
    }
};
struct EpiRes {
    static constexpr bool PERM = false, AFTER_DRAIN = false;
    const float* base; float* out; int ldc; int pad;
    __device__ __forceinline__ void operator()(const f32x4 (&acc)[2][2][4][2], const Unit& u, int wr, int wc, int fr, int fq) const {
        const int row0 = u.pm * BM + wr * 64 + fr, col0 = u.pn * BM + wc * 32 + 4 * fq;
#pragma unroll
        for (int ai = 0; ai < 2; ++ai)
#pragma unroll
            for (int m = 0; m < 4; ++m) { const size_t off = (size_t)(row0 + ai * HALF + m * 16) * ldc + col0;
#pragma unroll
                for (int bj = 0; bj < 2; ++bj)
#pragma unroll
                    for (int n = 0; n < 2; ++n) { const f32x4 b = *(const f32x4*)(base + off + bj * HALF + n * 16); *(f32x4*)(out + off + bj * HALF + n * 16) = b + acc[ai][bj][m][n]; }
                if (m & 1) asm volatile("" ::: "memory"); }
    }
};
template <class Epi, class Sched, bool ALIGN_EPI = false, bool SP2 = false>
__device__ __forceinline__ void gemm_phase(PG8_LAS unsigned char* lds, const Gemm g, const Sched& S, const Epi& E) {
    const int tid = threadIdx.x, wid = __builtin_amdgcn_readfirstlane(tid >> 6), lane = tid & 63, wr = wid >> 2, wc = wid & 3, fr = lane & 15, fq = lane >> 4;
    const int K = g.K, nt = K / BK;
    unsigned voffA[2], voffB[2];
#pragma unroll
    for (int i = 0; i < 2; ++i) { int R, C; stage_rc(tid * 16 + i * 8192, R, C); const int Rb = Epi::PERM ? ((R & ~31) + perm32(R & 31)) : R;
        voffA[i] = (unsigned)(R * K + C) * 2u; voffB[i] = (unsigned)(Rb * K + C) * 2u; }
    const size_t kstep = (size_t)(BK * 2);
    const size_t hstep = (size_t)HALF * K * 2;
    const size_t tstep = 2 * hstep;
    const unsigned ldsw = (unsigned)wid * 1024u;
    const int aoff = lds_byte(wr * 64 + fr, fq * 8), boff = lds_byte(wc * 32 + fr, fq * 8);
#define PG8_SA(b, h) (((b) * 2 + (h)) * HTB)
#define PG8_SB(b, h) ((4 + (b) * 2 + (h)) * HTB)
#define PG8_STAGE(bufoff, gbase, voff) do { _Pragma("unroll") for (int _i = 0; _i < 2; ++_i) \
        __builtin_amdgcn_global_load_lds((const unsigned*)((const char*)(gbase) + (voff)[_i]), (PG8_LAS unsigned*)(lds + (bufoff) + ldsw + _i * 8192), 16, 0, 0); } while (0)
#define PG8_LDA(dst, b, h) do { _Pragma("unroll") for (int m = 0; m < 4; ++m) _Pragma("unroll") for (int k = 0; k < 2; ++k) dst[m][k] = *(const PG8_LAS bf16x8*)(lds + PG8_SA(b, h) + aoff + m * 2048 + k * 1024); } while (0)
#define PG8_LDB(dst, b, h) do { _Pragma("unroll") for (int n = 0; n < 2; ++n) _Pragma("unroll") for (int k = 0; k < 2; ++k) dst[n][k] = *(const PG8_LAS bf16x8*)(lds + PG8_SB(b, h) + boff + n * 2048 + k * 1024); } while (0)
#define PG8_MMA(ai, bj, At, Bt) do { __builtin_amdgcn_s_setprio(1); _Pragma("unroll") for (int m = 0; m < 4; ++m) _Pragma("unroll") for (int n = 0; n < 2; ++n) _Pragma("unroll") for (int k = 0; k < 2; ++k) \
        acc[ai][bj][m][n] = __builtin_amdgcn_mfma_f32_16x16x32_bf16(Bt[n][k], At[m][k], acc[ai][bj][m][n], 0, 0, 0); __builtin_amdgcn_s_setprio(0); } while (0)
#define PG8_WAIT_V(n) asm volatile("s_waitcnt vmcnt(" #n ")" ::: "memory")
#define PG8_WAIT_L(n) asm volatile("s_waitcnt lgkmcnt(" #n ")" ::: "memory")
#define PG8_BAR __builtin_amdgcn_s_barrier()
#define PG8_SCHED __builtin_amdgcn_sched_barrier(0)
    Unit cur, nxt; int ui = 0;
    if (!S.next(0, cur)) return;
    f32x4 acc[2][2][4][2];
#pragma unroll
    for (int a = 0; a < 2; ++a)
#pragma unroll
        for (int b = 0; b < 2; ++b)
#pragma unroll
            for (int m = 0; m < 4; ++m)
#pragma unroll
                for (int n = 0; n < 2; ++n) acc[a][b][m][n] = (f32x4){0.f, 0.f, 0.f, 0.f};
    bf16x8 At[4][2], B0[2][2], B1[2][2];
    const char* cA = (const char*)g.A + (size_t)cur.pm * tstep; const char* cB = (const char*)g.Bt + (size_t)cur.pn * tstep;
    S.a_ready(cur);
    if constexpr (SP2) {
        PG8_STAGE(PG8_SB(0, 0), cB, voffB); PG8_STAGE(PG8_SB(0, 1), cB + hstep, voffB); PG8_STAGE(PG8_SA(0, 0), cA, voffA); PG8_STAGE(PG8_SA(0, 1), cA + hstep, voffA);
        if (wr == 1) PG8_BAR;
        PG8_WAIT_V(2); PG8_BAR;
        PG8_STAGE(PG8_SB(1, 0), cB + kstep, voffB); PG8_STAGE(PG8_SA(1, 0), cA + kstep, voffA); PG8_STAGE(PG8_SB(1, 1), cB + hstep + kstep, voffB);
        PG8_WAIT_V(6); PG8_BAR;
    } else {
        PG8_STAGE(PG8_SB(0, 0), cB, voffB); PG8_STAGE(PG8_SA(0, 0), cA, voffA); PG8_STAGE(PG8_SB(0, 1), cB + hstep, voffB); PG8_STAGE(PG8_SA(0, 1), cA + hstep, voffA);
        if (wr == 1) PG8_BAR;
        PG8_WAIT_V(4); PG8_BAR;
        PG8_STAGE(PG8_SB(1, 0), cB + kstep, voffB); PG8_STAGE(PG8_SA(1, 0), cA + kstep, voffA); PG8_STAGE(PG8_SB(1, 1), cB + hstep + kstep, voffB);
        PG8_WAIT_V(6); PG8_BAR;
    }
    for (;;) {
        const bool has_next = S.next(ui + 1, nxt);
        const char* nA = has_next ? (const char*)g.A + (size_t)nxt.pm * tstep : cA; const char* nB = has_next ? (const char*)g.Bt + (size_t)nxt.pn * tstep : cB;
        for (int t = 0; t < nt; t += 2) {
            const bool last = (t == nt - 2);
            const char* a1 = cA + (size_t)(t + 1) * kstep;
            const char* a2 = last ? nA : cA + (size_t)(t + 2) * kstep; const char* b2 = last ? nB : cB + (size_t)(t + 2) * kstep;
            const char* a3 = a2 + kstep; const char* b3 = b2 + kstep;
            if (last && has_next) S.a_ready(nxt);
            if constexpr (SP2) {
            PG8_LDB(B0, 0, 0); PG8_LDB(B1, 0, 1); PG8_SCHED; PG8_LDA(At, 0, 0); PG8_STAGE(PG8_SA(1, 1), a1 + hstep, voffA);
            PG8_WAIT_V(8); PG8_WAIT_L(0); PG8_BAR; PG8_MMA(0, 0, At, B0); PG8_MMA(0, 1, At, B1); PG8_BAR; PG8_SCHED;
            PG8_LDA(At, 0, 1); PG8_STAGE(PG8_SB(0, 0), b2, voffB); PG8_STAGE(PG8_SB(0, 1), b2 + hstep, voffB); PG8_STAGE(PG8_SA(0, 0), a2, voffA);
            PG8_WAIT_V(8); PG8_WAIT_L(0); PG8_BAR; PG8_MMA(1, 0, At, B0); PG8_MMA(1, 1, At, B1); PG8_BAR; PG8_SCHED;
            PG8_LDB(B0, 1, 0); PG8_LDB(B1, 1, 1); PG8_SCHED; PG8_LDA(At, 1, 0); PG8_STAGE(PG8_SA(0, 1), a2 + hstep, voffA);
            PG8_WAIT_V(8); PG8_WAIT_L(0); PG8_BAR; PG8_MMA(0, 0, At, B0); PG8_MMA(0, 1, At, B1); PG8_BAR; PG8_SCHED;
            PG8_LDA(At, 1, 1); PG8_STAGE(PG8_SB(1, 0), b3, voffB); PG8_STAGE(PG8_SB(1, 1), b3 + hstep, voffB); PG8_STAGE(PG8_SA(1, 0), a3, voffA);
            PG8_WAIT_V(8); PG8_WAIT_L(0); PG8_BAR; PG8_MMA(1, 0, At, B0); PG8_MMA(1, 1, At, B1); PG8_BAR; PG8_SCHED;
            } else {
            PG8_LDB(B0, 0, 0); PG8_SCHED; PG8_LDA(At, 0, 0); PG8_STAGE(PG8_SA(1, 1), a1 + hstep, voffA);
            PG8_WAIT_L(8); PG8_BAR; PG8_WAIT_L(0); PG8_MMA(0, 0, At, B0); PG8_BAR; PG8_SCHED;
            PG8_LDB(B1, 0, 1); PG8_STAGE(PG8_SB(0, 0), b2, voffB);
            PG8_BAR; PG8_WAIT_L(0); PG8_MMA(0, 1, At, B1); PG8_BAR;
            PG8_LDA(At, 0, 1); PG8_STAGE(PG8_SA(0, 0), a2, voffA);
            PG8_BAR; PG8_WAIT_L(0); PG8_MMA(1, 0, At, B0); PG8_BAR; PG8_SCHED;
            PG8_STAGE(PG8_SB(0, 1), b2 + hstep, voffB);
            PG8_WAIT_V(6); PG8_BAR; PG8_MMA(1, 1, At, B1); PG8_BAR;
            PG8_LDB(B0, 1, 0); PG8_SCHED; PG8_LDA(At, 1, 0); PG8_STAGE(PG8_SA(0, 1), a2 + hstep, voffA);
            PG8_WAIT_L(8); PG8_BAR; PG8_WAIT_L(0); PG8_MMA(0, 0, At, B0); PG8_BAR; PG8_SCHED;
            PG8_LDB(B1, 1, 1); PG8_STAGE(PG8_SB(1, 0), b3, voffB);
            PG8_BAR; PG8_WAIT_L(0); PG8_MMA(0, 1, At, B1); PG8_BAR;
            PG8_LDA(At, 1, 1); PG8_STAGE(PG8_SA(1, 0), a3, voffA);
            PG8_BAR; PG8_WAIT_L(0); PG8_MMA(1, 0, At, B0); PG8_BAR; PG8_SCHED;
            PG8_STAGE(PG8_SB(1, 1), b3 + hstep, voffB);
            PG8_WAIT_V(6); PG8_BAR; PG8_MMA(1, 1, At, B1); PG8_BAR;
            }
        }
        if constexpr (ALIGN_EPI) { if (wr == 0) PG8_BAR; }
        if constexpr (!Epi::AFTER_DRAIN) { E(acc, cur, wr, wc, fr, fq); S.done(cur); }
        if (!has_next) break;
#pragma unroll
        for (int a = 0; a < 2; ++a)
#pragma unroll
            for (int b = 0; b < 2; ++b)
#pragma unroll
                for (int m = 0; m < 4; ++m)
#pragma unroll
                    for (int n = 0; n < 2; ++n) acc[a][b][m][n] = (f32x4){0.f, 0.f, 0.f, 0.f};
        cur = nxt; cA = nA; cB = nB; ++ui;
        if constexpr (ALIGN_EPI) { if (wr == 1) PG8_BAR; }
    }
    PG8_WAIT_V(0);
    if constexpr (!ALIGN_EPI) { if (wr == 0) PG8_BAR; }
    PG8_BAR;
    if constexpr (Epi::AFTER_DRAIN) { E.fused(acc, cur, wr, wc, fr, fq, lds, wid, lane); S.done(cur); }
#undef PG8_SA
#undef PG8_SB
#undef PG8_STAGE
#undef PG8_LDA
#undef PG8_LDB
#undef PG8_MMA
#undef PG8_WAIT_V
#undef PG8_WAIT_L
#undef PG8_BAR
#undef PG8_SCHED
}
}

typedef unsigned short bf16;
typedef float f32x4 __attribute__((ext_vector_type(4)));
typedef float f32x2 __attribute__((ext_vector_type(2)));
typedef unsigned u32x4 __attribute__((ext_vector_type(4)));
typedef unsigned u32x2 __attribute__((ext_vector_type(2)));
constexpr int D_MODEL = 2048, BATCH = 8, SEQ = 4096, DEPTH = 4, HD = 128, D_FF = 8192;
constexpr int M = BATCH * SEQ;
constexpr int NPROJ_ORIG = 6430, NPROJ = 6656;
constexpr int PC_QA = 0, PC_KA = 768, PC_VA = 1536, PC_ZA = 2304, PC_UB = 3072, PC_VB = 3584, PC_QC = 4096, PC_KCC = 4864, PC_VCC = 5120,
              PC_KSL = 5376, PC_VSL = 5632, PC_KWN = 5888, PC_VWN = 6144, PC_SMALL = 6400;
constexpr int SM_BA = 0, SM_AA = 6, SM_GC = 12;
constexpr int N_CMP = 255;
constexpr float NORM_EPS = 1e-6f;
__host__ __device__ __forceinline__ int win_map(int n) {
    if (n < 3072) return n;
    if (n < 4096) return 3084 + (n - 3072);
    if (n < 6400) return 4108 + (n - 4096);
    if (n < 6412) return 3072 + (n - 6400);
    if (n < 6430) return n;
    return -1;
}
constexpr size_t MiB = 1u << 20;
constexpr size_t WS_CTL = 0;
constexpr size_t WS_WIN = 1 * MiB, WS_WOUT = 27 * MiB, WS_WUP = 35 * MiB, WS_WDN = 67 * MiB;
constexpr size_t WS_HB = 100 * MiB;
constexpr size_t WS_R1 = 228 * MiB;
constexpr size_t WS_PROJ = WS_R1, WS_SMALL = 644 * MiB, WS_NQ = 648 * MiB, WS_NKS = 696 * MiB, WS_NKW = 712 * MiB;
constexpr size_t WS_HID = WS_R1;
constexpr size_t WS_GQ = 740 * MiB, WS_VLN = 884 * MiB, WS_KC = 916 * MiB, WS_VC = 918 * MiB, WS_BG = 920 * MiB, WS_END = 922 * MiB;

__device__ __forceinline__ float bf2f(bf16 v) { return __uint_as_float(((unsigned)v) << 16); }
__device__ __forceinline__ bf16 f2bf(float f) { unsigned u = __float_as_uint(f); return (bf16)((u + 0x7fffu + ((u >> 16) & 1u)) >> 16); }
__device__ __forceinline__ unsigned pk2(float lo, float hi) { return (unsigned)f2bf(lo) | ((unsigned)f2bf(hi) << 16); }
__device__ __forceinline__ float wave_sum(float v) {
#pragma unroll
    for (int o = 1; o < 64; o <<= 1) v += __shfl_xor(v, o);
    return v;
}
__device__ __forceinline__ float wave_max(float v) {
#pragma unroll
    for (int o = 1; o < 64; o <<= 1) v = fmaxf(v, __shfl_xor(v, o));
    return v;
}
__device__ __forceinline__ float sigmoidf_(float x) { return 1.0f / (1.0f + __expf(-x)); }
__device__ __forceinline__ float siluf_(float x) { return x * sigmoidf_(x); }
__device__ __forceinline__ float gelu_tanh(float x) { const float u = 0.7978845608028654f * (x + 0.044715f * x * x * x); return 0.5f * x * (1.0f + tanhf(u)); }
__device__ __forceinline__ float softplusf_(float x) { return x > 20.f ? x : log1pf(__expf(x)); }
__device__ __forceinline__ int t5_bucket(int dist) {
    const int n = dist > 0 ? dist : 0;
    if (n < 16) return n;
    const float lr = logf((float)n / 16.0f) / 2.0794415416798357f;
    const int large = 16 + (int)(lr * 16.0f);
    return large < 31 ? large : 31;
}

template <int MAP> __global__ __launch_bounds__(256) void k_transpose(const float* __restrict__ W, int K, int N_orig, bf16* __restrict__ WT, int N_out) {
    __shared__ float scr_all[4][64 * 33];
    const int lane = threadIdx.x & 63, wave = threadIdx.x >> 6;
    float* scr = scr_all[wave];
    const int nblk = N_out / 32, nitems = (K / 64) * nblk;
    for (int it = blockIdx.x * 4 + wave; it < nitems; it += gridDim.x * 4) {
        const int kb = it / nblk, nb = it % nblk, k0 = 64 * kb, n0 = 32 * nb;
        const int n = n0 + (lane & 31); const int no = MAP ? win_map(n) : n;
#pragma unroll 8
        for (int i = 0; i < 32; ++i) { const int kk = 2 * i + (lane >> 5); scr[kk * 33 + (lane & 31)] = no >= 0 ? W[(size_t)(k0 + kk) * N_orig + no] : 0.f; }
        __builtin_amdgcn_s_waitcnt(0); asm volatile("" ::: "memory");
        const int c = lane & 7;
#pragma unroll
        for (int j = 0; j < 4; ++j) { const int nn = (lane >> 3) + 8 * j; const float* s = scr + (8 * c) * 33 + nn;
            u32x4 o; o.x = pk2(s[0 * 33], s[1 * 33]); o.y = pk2(s[2 * 33], s[3 * 33]); o.z = pk2(s[4 * 33], s[5 * 33]); o.w = pk2(s[6 * 33], s[7 * 33]);
            *(u32x4*)(WT + (size_t)(n0 + nn) * K + k0 + 8 * c) = o; }
        __builtin_amdgcn_s_waitcnt(0); asm volatile("" ::: "memory");
    }
}

__global__ __launch_bounds__(256) void k_rmsnorm(const float* __restrict__ x, const float* __restrict__ gain, bf16* __restrict__ out) {
    const int lane = threadIdx.x & 63; const int gw = blockIdx.x * 4 + (threadIdx.x >> 6), ngw = gridDim.x * 4;
    for (int m = gw; m < M; m += ngw) {
        const f32x4* xr = (const f32x4*)(x + (size_t)m * D_MODEL) + lane; f32x4 v[8]; float s = 0.f;
#pragma unroll
        for (int j = 0; j < 8; ++j) { v[j] = xr[64 * j]; s += (v[j].x * v[j].x + v[j].y * v[j].y) + (v[j].z * v[j].z + v[j].w * v[j].w); }
        const float rstd = rsqrtf(wave_sum(s) * (1.f / D_MODEL) + NORM_EPS);
        u32x2* o = (u32x2*)(out + (size_t)m * D_MODEL) + lane;
#pragma unroll
        for (int j = 0; j < 8; ++j) { const f32x4 g = ((const f32x4*)gain)[64 * j + lane]; u32x2 w; w.x = pk2(v[j].x * rstd * g.x, v[j].y * rstd * g.y); w.y = pk2(v[j].z * rstd * g.z, v[j].w * rstd * g.w); o[64 * j] = w; }
    }
}

__global__ __launch_bounds__(256) void k_gdn_prep(const bf16* __restrict__ proj, const float* __restrict__ small, const float* __restrict__ conv_w, const float* __restrict__ a_log,
                                                  const float* __restrict__ dt_bias, bf16* __restrict__ GQ, float* __restrict__ BG) {
    const int lane = threadIdx.x & 63; const int gw = blockIdx.x * 4 + (threadIdx.x >> 6), ngw = gridDim.x * 4;
    for (int p = gw; p < M * 18; p += ngw) {
        const int m = p / 18, j = p % 18, t = m & (SEQ - 1), c = j * 128 + lane * 2;
        float y0 = 0.f, y1 = 0.f;
#pragma unroll
        for (int tap = 0; tap < 4; ++tap) { const int tt = t - 3 + tap; if (tt >= 0) { const unsigned pr = *(const unsigned*)(proj + (size_t)(m - 3 + tap) * NPROJ + c);
            y0 += conv_w[tap * 2304 + c] * bf2f((bf16)(pr & 0xffff)); y1 += conv_w[tap * 2304 + c + 1] * bf2f((bf16)(pr >> 16)); } }
        y0 = siluf_(y0); y1 = siluf_(y1);
        if (j < 12) { const float ss = wave_sum(y0 * y0 + y1 * y1); float r = rsqrtf(ss + NORM_EPS); if (j < 6) r *= 0.08838834764831845f; y0 *= r; y1 *= r; }
        *(unsigned*)(GQ + (size_t)m * 2304 + c) = pk2(y0, y1);
    }
    for (int i = blockIdx.x * 256 + threadIdx.x; i < M * 6; i += gridDim.x * 256) { const int m = i / 6, h = i % 6;
        BG[(size_t)m * 12 + h] = sigmoidf_(small[(size_t)m * 32 + SM_BA + h]);
        BG[(size_t)m * 12 + 6 + h] = -__expf(a_log[h]) * softplusf_(small[(size_t)m * 32 + SM_AA + h] + dt_bias[h]); }
}
__global__ __launch_bounds__(512) void k_gdn_scan(const bf16* __restrict__ GQ, const float* __restrict__ BG, const bf16* __restrict__ proj, const float* __restrict__ norm_g, bf16* __restrict__ mix) {
    __shared__ float sq[8][4 * 36], sk[8][4 * 36], sv[8][128], osh[8][128], sc[8][2];
    const int tid = threadIdx.x, b = blockIdx.x / 6, h = blockIdx.x % 6, c = tid >> 2, p = tid & 3, lane = tid & 63, wave = tid >> 6;
    float S[32];
#pragma unroll
    for (int j = 0; j < 32; ++j) S[j] = 0.f;
    for (int t0 = 0; t0 < SEQ; t0 += 8) {
        for (int i = tid; i < 8 * 384; i += 512) { const int tt = i / 384, r = i % 384, which = r >> 7, d = r & 127;
            const float v = bf2f(GQ[(size_t)(b * SEQ + t0 + tt) * 2304 + which * 768 + h * 128 + d]);
            if (which == 0) sq[tt][(d >> 5) * 36 + (d & 31)] = v; else if (which == 1) sk[tt][(d >> 5) * 36 + (d & 31)] = v; else sv[tt][d] = v; }
        if (tid < 8) { const size_t m = (size_t)b * SEQ + t0 + tid; sc[tid][0] = BG[m * 12 + h]; sc[tid][1] = __expf(BG[m * 12 + 6 + h]); }
        __syncthreads();
#pragma unroll 1
        for (int tt = 0; tt < 8; ++tt) {
            const float beta = sc[tt][0], eg = sc[tt][1];
            float kS = 0.f;
#pragma unroll
            for (int j = 0; j < 32; ++j) kS += sk[tt][p * 36 + j] * S[j];
            kS += __shfl_xor(kS, 1); kS += __shfl_xor(kS, 2);
            const float coef = beta * (sv[tt][c] - eg * kS);
            float o = 0.f;
#pragma unroll
            for (int j = 0; j < 32; ++j) { S[j] = eg * S[j] + sk[tt][p * 36 + j] * coef; o += sq[tt][p * 36 + j] * S[j]; }
            o += __shfl_xor(o, 1); o += __shfl_xor(o, 2);
            if (p == 0) osh[tt][c] = o;
        }
        __syncthreads();
        { const int tt = wave; const size_t m = (size_t)b * SEQ + t0 + tt; const int c0 = lane * 2;
          const float o0 = osh[tt][c0], o1 = osh[tt][c0 + 1]; const float rstd = rsqrtf(wave_sum(o0 * o0 + o1 * o1) * (1.f / 128.f) + NORM_EPS);
          const unsigned zz = *(const unsigned*)(proj + m * NPROJ + PC_ZA + h * 128 + c0);
          const float r0 = o0 * rstd * norm_g[c0] * siluf_(bf2f((bf16)(zz & 0xffff))), r1 = o1 * rstd * norm_g[c0 + 1] * siluf_(bf2f((bf16)(zz >> 16)));
          *(unsigned*)(mix + m * D_MODEL + h * 128 + c0) = pk2(r0, r1); }
        __syncthreads();
    }
}

__global__ __launch_bounds__(256) void k_sgu_prep(const bf16* __restrict__ proj, const float* __restrict__ ln_g, const float* __restrict__ ln_b, bf16* __restrict__ VLN) {
    const int lane = threadIdx.x & 63; const int gw = blockIdx.x * 4 + (threadIdx.x >> 6), ngw = gridDim.x * 4;
    for (int m = gw; m < M; m += ngw) {
        const u32x4 raw = *(const u32x4*)(proj + (size_t)m * NPROJ + PC_VB + lane * 8); float v[8];
        const unsigned rw[4] = {raw.x, raw.y, raw.z, raw.w};
        float s = 0.f;
#pragma unroll
        for (int j = 0; j < 4; ++j) { v[2 * j] = gelu_tanh(bf2f((bf16)(rw[j] & 0xffff))); v[2 * j + 1] = gelu_tanh(bf2f((bf16)(rw[j] >> 16))); s += v[2 * j] + v[2 * j + 1]; }
        const float mu = wave_sum(s) * (1.f / 512.f); float q = 0.f;
#pragma unroll
        for (int j = 0; j < 8; ++j) { v[j] -= mu; q += v[j] * v[j]; }
        const float rstd = rsqrtf(wave_sum(q) * (1.f / 512.f) + NORM_EPS);
        u32x4 o; unsigned ow[4];
#pragma unroll
        for (int j = 0; j < 4; ++j) { const int c = lane * 8 + 2 * j; ow[j] = pk2(v[2 * j] * rstd * ln_g[c] + ln_b[c], v[2 * j + 1] * rstd * ln_g[c + 1] + ln_b[c + 1]); }
        o.x = ow[0]; o.y = ow[1]; o.z = ow[2]; o.w = ow[3];
        *(u32x4*)(VLN + (size_t)m * 512 + lane * 8) = o;
    }
}
__global__ __launch_bounds__(512) void k_sgu_mix(const bf16* __restrict__ proj, const bf16* __restrict__ VLN, const float* __restrict__ sgu_w, const float* __restrict__ sgu_b, bf16* __restrict__ mix) {
    __shared__ bf16 vs[128][128];
    const int tid = threadIdx.x, g = blockIdx.x & 3, n = (blockIdx.x >> 2) & 31, b = blockIdx.x >> 7;
    const size_t m0 = (size_t)b * SEQ + n * 128;
    for (int i = tid; i < 128 * 128; i += 512) { const int s = i >> 7, c = i & 127; vs[s][c] = VLN[(m0 + s) * 512 + g * 128 + c]; }
    __syncthreads();
    const int c = tid & 127, tq = tid >> 7;
    for (int t = tq * 32; t < tq * 32 + 32; ++t) {
        const float* wr = sgu_w + ((size_t)g * 128 + t) * 128; float acc = 0.f;
        for (int s = 0; s <= t; ++s) acc += wr[s] * bf2f(vs[s][c]);
        const float u = gelu_tanh(bf2f(proj[(m0 + t) * NPROJ + PC_UB + g * 128 + c]));
        mix[(m0 + t) * D_MODEL + 768 + g * 128 + c] = f2bf(u * (acc + sgu_b[g * 128 + t]));
    }
}

__global__ __launch_bounds__(256) void k_nsa_prep(const bf16* __restrict__ proj, const float* __restrict__ qg, const float* __restrict__ kg, bf16* __restrict__ NQ, bf16* __restrict__ NKS, bf16* __restrict__ NKW) {
    const int lane = threadIdx.x & 63; const int gw = blockIdx.x * 4 + (threadIdx.x >> 6), ngw = gridDim.x * 4;
    for (int p = gw; p < M * 10; p += ngw) {
        const int m = p / 10, j = p % 10, c0 = lane * 2;
        const int src = j < 6 ? PC_QC + j * 128 : (j < 8 ? PC_KSL + (j - 6) * 128 : PC_KWN + (j - 8) * 128);
        const unsigned pr = *(const unsigned*)(proj + (size_t)m * NPROJ + src + c0);
        float y0 = bf2f((bf16)(pr & 0xffff)), y1 = bf2f((bf16)(pr >> 16));
        float r = rsqrtf(wave_sum(y0 * y0 + y1 * y1) * (1.f / 128.f) + NORM_EPS);
        const float* gn = j < 6 ? qg : kg; if (j < 6) r *= 0.08838834764831845f;
        const unsigned o = pk2(y0 * r * gn[c0], y1 * r * gn[c0 + 1]);
        if (j < 6) *(unsigned*)(NQ + (size_t)m * 768 + j * 128 + c0) = o;
        else if (j < 8) *(unsigned*)(NKS + (size_t)m * 256 + (j - 6) * 128 + c0) = o;
        else *(unsigned*)(NKW + (size_t)m * 256 + (j - 8) * 128 + c0) = o;
    }
}
__global__ __launch_bounds__(128) void k_nsa_compress(const bf16* __restrict__ proj, const float* __restrict__ pos, const float* __restrict__ w1, const float* __restrict__ w2, const float* __restrict__ kg,
                                                      float* __restrict__ KC, float* __restrict__ VC) {
    __shared__ bf16 tok[144][128]; __shared__ float posl[32][128]; __shared__ float hid[8][128]; __shared__ float red[8][2];
    const int tid = threadIdx.x, bid = blockIdx.x, kv = bid & 1, grp = (bid >> 1) & 31, g = (bid >> 6) & 1, b = bid >> 7, n0 = grp * 8;
    const int col = (kv == 0 ? PC_KCC : PC_VCC) + g * 128;
    for (int i = tid; i < 144 * 128; i += 128) { const int tk = i >> 7, d = i & 127; const int t = 16 * n0 + tk; tok[tk][d] = t < SEQ ? proj[(size_t)(b * SEQ + t) * NPROJ + col + d] : (bf16)0; }
    for (int i = tid; i < 32 * 128; i += 128) posl[i >> 7][i & 127] = pos[(size_t)kv * 4096 + i];
    __syncthreads();
    float acc[8];
#pragma unroll
    for (int nn = 0; nn < 8; ++nn) acc[nn] = 0.f;
    const float* w1p = w1 + (size_t)kv * 4096 * 128 + tid;
    for (int l = 0; l < 32; ++l)
        for (int d = 0; d < 128; ++d) { const float w = w1p[(size_t)(l * 128 + d) * 128]; const float pp = posl[l][d];
#pragma unroll
            for (int nn = 0; nn < 8; ++nn) acc[nn] += (bf2f(tok[16 * nn + l][d]) + pp) * w; }
#pragma unroll
    for (int nn = 0; nn < 8; ++nn) hid[nn][tid] = gelu_tanh(acc[nn]);
    __syncthreads();
    float out[8];
#pragma unroll
    for (int nn = 0; nn < 8; ++nn) out[nn] = 0.f;
    const float* w2p = w2 + (size_t)kv * 128 * 128 + tid;
    for (int i = 0; i < 128; ++i) { const float w = w2p[(size_t)i * 128];
#pragma unroll
        for (int nn = 0; nn < 8; ++nn) out[nn] += hid[nn][i] * w; }
    if (kv == 0) {
#pragma unroll
        for (int nn = 0; nn < 8; ++nn) { const float s = wave_sum(out[nn] * out[nn]); if ((tid & 63) == 0) red[nn][tid >> 6] = s; }
        __syncthreads();
#pragma unroll
        for (int nn = 0; nn < 8; ++nn) out[nn] *= rsqrtf((red[nn][0] + red[nn][1]) * (1.f / 128.f) + NORM_EPS) * kg[tid];
    }
    float* dst = kv == 0 ? KC : VC;
#pragma unroll
    for (int nn = 0; nn < 8; ++nn) if (n0 + nn < N_CMP) dst[((size_t)(b * 2 + g) * N_CMP + n0 + nn) * 128 + tid] = out[nn];
}
__global__ __launch_bounds__(128) void k_nsa_attn(const bf16* __restrict__ NQ, const bf16* __restrict__ NKS, const bf16* __restrict__ NKW, const bf16* __restrict__ proj,
                                                  const float* __restrict__ KC, const float* __restrict__ VC, const float* __restrict__ small, const float* __restrict__ rel_bias, bf16* __restrict__ mix) {
    __shared__ float qs_all[2][3][128]; __shared__ float pc_all[2][3][256]; __shared__ float sc_all[2][3][1024]; __shared__ float bias_s[32][6];
    const int tid = threadIdx.x, lane = tid & 63, wave = tid >> 6;
    for (int i = tid; i < 192; i += 128) bias_s[i / 6][i % 6] = rel_bias[i];
    const int idx = blockIdx.x * 2 + wave, t = idx & (SEQ - 1), g = (idx >> 12) & 1, b = idx >> 13;
    const size_t m = (size_t)b * SEQ + t;
    float (*qs)[128] = qs_all[wave]; float (*pc)[256] = pc_all[wave]; float (*sc)[1024] = sc_all[wave];
    for (int i = lane; i < 384; i += 64) qs[i >> 7][i & 127] = bf2f(NQ[m * 768 + g * 384 + i]);
    __syncthreads();
    const int hb = g * 3;
    float oc[3][2], os[3][2], ow[3][2];
    const int nvalid = t >= 31 ? ((t - 31) >> 4) + 1 : 0;
    {
        float mx[3] = {-3.0e38f, -3.0e38f, -3.0e38f};
        for (int base = 0; base < 256; base += 64) { const int n = base + lane; float s[3] = {-3.0e38f, -3.0e38f, -3.0e38f};
            if (n < nvalid) { const f32x4* kr = (const f32x4*)(KC + ((size_t)(b * 2 + g) * N_CMP + n) * 128); float a0 = 0.f, a1 = 0.f, a2 = 0.f;
#pragma unroll 2
                for (int d = 0; d < 32; ++d) { const f32x4 kk = kr[d]; const f32x4 q0 = *(const f32x4*)&qs[0][4 * d], q1 = *(const f32x4*)&qs[1][4 * d], q2 = *(const f32x4*)&qs[2][4 * d];
                    a0 += kk.x * q0.x + kk.y * q0.y + kk.z * q0.z + kk.w * q0.w; a1 += kk.x * q1.x + kk.y * q1.y + kk.z * q1.z + kk.w * q1.w; a2 += kk.x * q2.x + kk.y * q2.y + kk.z * q2.z + kk.w * q2.w; }
                const int bk = t5_bucket(t - (16 * n + 31)); s[0] = a0 + bias_s[bk][hb]; s[1] = a1 + bias_s[bk][hb + 1]; s[2] = a2 + bias_s[bk][hb + 2]; }
#pragma unroll
            for (int r = 0; r < 3; ++r) { pc[r][n] = s[r]; mx[r] = fmaxf(mx[r], s[r]); } }
#pragma unroll
        for (int r = 0; r < 3; ++r) { mx[r] = wave_max(mx[r]); float sum = 0.f;
            for (int base = 0; base < 256; base += 64) { const int n = base + lane; const float e = n < nvalid ? __expf(pc[r][n] - mx[r]) : 0.f; pc[r][n] = e; sum += e; }
            sum = wave_sum(sum); const float inv = 1.0f / fmaxf(sum, 1e-30f);
            for (int base = 0; base < 256; base += 64) pc[r][base + lane] *= inv; }
        __builtin_amdgcn_s_waitcnt(0); asm volatile("" ::: "memory");
#pragma unroll
        for (int r = 0; r < 3; ++r) { oc[r][0] = 0.f; oc[r][1] = 0.f; }
        for (int n = 0; n < nvalid; ++n) { const f32x2 vv = *(const f32x2*)(VC + ((size_t)(b * 2 + g) * N_CMP + n) * 128 + 2 * lane);
#pragma unroll
            for (int r = 0; r < 3; ++r) { const float p = pc[r][n]; oc[r][0] += p * vv.x; oc[r][1] += p * vv.y; } }
    }
    unsigned long long mask;
    {
        const int j = lane, cur = t >> 6; float imp = 0.f;
        for (int n = 4 * j - 1; n <= 4 * j + 3; ++n) if (n >= 0 && n < N_CMP) imp += pc[0][n] + pc[1][n] + pc[2][n];
        const bool forced = (j == 0) || (j == cur) || (j == cur - 1);
        const float score = forced ? 1e9f : (j <= cur ? imp : -1e30f);
        int rank = 0;
        for (int i = 0; i < 64; ++i) { const float si = __shfl(score, i); rank += (si > score || (si == score && i < j)) ? 1 : 0; }
        mask = __ballot(rank < 16 && j <= cur);
    }
    {
        float mx[3] = {-3.0e38f, -3.0e38f, -3.0e38f}; int slot = 0;
        for (unsigned long long mm = mask; mm; mm &= mm - 1, ++slot) { const int blk = __builtin_ctzll(mm); const int kpos = blk * 64 + lane; float s[3] = {-3.0e38f, -3.0e38f, -3.0e38f};
            if (kpos <= t) { const u32x4* kr = (const u32x4*)(NKS + ((size_t)b * SEQ + kpos) * 256 + g * 128); float a0 = 0.f, a1 = 0.f, a2 = 0.f;
#pragma unroll 2
                for (int d = 0; d < 16; ++d) { const u32x4 kk = kr[d]; const unsigned kw[4] = {kk.x, kk.y, kk.z, kk.w};
#pragma unroll
                    for (int e = 0; e < 4; ++e) { const float k0 = bf2f((bf16)(kw[e] & 0xffff)), k1 = bf2f((bf16)(kw[e] >> 16)); const int dd = 8 * d + 2 * e;
                        a0 += k0 * qs[0][dd] + k1 * qs[0][dd + 1]; a1 += k0 * qs[1][dd] + k1 * qs[1][dd + 1]; a2 += k0 * qs[2][dd] + k1 * qs[2][dd + 1]; } }
                const int bk = t5_bucket(t - kpos); s[0] = a0 + bias_s[bk][hb]; s[1] = a1 + bias_s[bk][hb + 1]; s[2] = a2 + bias_s[bk][hb + 2]; }
#pragma unroll
            for (int r = 0; r < 3; ++r) { sc[r][slot * 64 + lane] = s[r]; mx[r] = fmaxf(mx[r], s[r]); } }
        const int nslot = slot; float inv[3];
#pragma unroll
        for (int r = 0; r < 3; ++r) { mx[r] = wave_max(mx[r]); float sum = 0.f;
            for (int i = lane; i < nslot * 64; i += 64) { const float sv = sc[r][i]; const float e = sv > -1.0e38f ? __expf(sv - mx[r]) : 0.f; sc[r][i] = e; sum += e; }
            sum = wave_sum(sum); inv[r] = 1.0f / fmaxf(sum, 1e-30f); }
        __builtin_amdgcn_s_waitcnt(0); asm volatile("" ::: "memory");
#pragma unroll
        for (int r = 0; r < 3; ++r) { os[r][0] = 0.f; os[r][1] = 0.f; }
        slot = 0;
        for (unsigned long long mm = mask; mm; mm &= mm - 1, ++slot) { const int blk = __builtin_ctzll(mm); const int kmax = (t - blk * 64) < 63 ? (t - blk * 64) : 63;
            for (int kk = 0; kk <= kmax; ++kk) { const unsigned vv = *(const unsigned*)(proj + ((size_t)b * SEQ + blk * 64 + kk) * NPROJ + PC_VSL + g * 128 + 2 * lane);
                const float v0 = bf2f((bf16)(vv & 0xffff)), v1 = bf2f((bf16)(vv >> 16));
#pragma unroll
                for (int r = 0; r < 3; ++r) { const float p = sc[r][slot * 64 + kk]; os[r][0] += p * v0; os[r][1] += p * v1; } } }
#pragma unroll
        for (int r = 0; r < 3; ++r) { os[r][0] *= inv[r]; os[r][1] *= inv[r]; }
    }
    {
        const int lo = t - 511 > 0 ? t - 511 : 0, nk = t - lo + 1; float mx[3] = {-3.0e38f, -3.0e38f, -3.0e38f};
        for (int base = 0; base < nk; base += 64) { const int kpos = lo + base + lane; float s[3] = {-3.0e38f, -3.0e38f, -3.0e38f};
            if (kpos <= t) { const u32x4* kr = (const u32x4*)(NKW + ((size_t)b * SEQ + kpos) * 256 + g * 128); float a0 = 0.f, a1 = 0.f, a2 = 0.f;
#pragma unroll 2
                for (int d = 0; d < 16; ++d) { const u32x4 kk = kr[d]; const unsigned kw[4] = {kk.x, kk.y, kk.z, kk.w};
#pragma unroll
                    for (int e = 0; e < 4; ++e) { const float k0 = bf2f((bf16)(kw[e] & 0xffff)), k1 = bf2f((bf16)(kw[e] >> 16)); const int dd = 8 * d + 2 * e;
                        a0 += k0 * qs[0][dd] + k1 * qs[0][dd + 1]; a1 += k0 * qs[1][dd] + k1 * qs[1][dd + 1]; a2 += k0 * qs[2][dd] + k1 * qs[2][dd + 1]; } }
                const int bk = t5_bucket(t - kpos); s[0] = a0 + bias_s[bk][hb]; s[1] = a1 + bias_s[bk][hb + 1]; s[2] = a2 + bias_s[bk][hb + 2]; }
#pragma unroll
            for (int r = 0; r < 3; ++r) { sc[r][base + lane] = s[r]; mx[r] = fmaxf(mx[r], s[r]); } }
        const int ntot = (nk + 63) & ~63; float inv[3];
#pragma unroll
        for (int r = 0; r < 3; ++r) { mx[r] = wave_max(mx[r]); float sum = 0.f;
            for (int i = lane; i < ntot; i += 64) { const float sv = sc[r][i]; const float e = sv > -1.0e38f ? __expf(sv - mx[r]) : 0.f; sc[r][i] = e; sum += e; }
            sum = wave_sum(sum); inv[r] = 1.0f / fmaxf(sum, 1e-30f); }
        __builtin_amdgcn_s_waitcnt(0); asm volatile("" ::: "memory");
#pragma unroll
        for (int r = 0; r < 3; ++r) { ow[r][0] = 0.f; ow[r][1] = 0.f; }
        for (int kk = 0; kk < nk; ++kk) { const unsigned vv = *(const unsigned*)(proj + ((size_t)b * SEQ + lo + kk) * NPROJ + PC_VWN + g * 128 + 2 * lane);
            const float v0 = bf2f((bf16)(vv & 0xffff)), v1 = bf2f((bf16)(vv >> 16));
#pragma unroll
            for (int r = 0; r < 3; ++r) { const float p = sc[r][kk]; ow[r][0] += p * v0; ow[r][1] += p * v1; } }
#pragma unroll
        for (int r = 0; r < 3; ++r) { ow[r][0] *= inv[r]; ow[r][1] *= inv[r]; }
    }
#pragma unroll
    for (int r = 0; r < 3; ++r) { const float* gp = small + m * 32 + SM_GC + hb + r;
        const float g0 = sigmoidf_(gp[0]), g1 = sigmoidf_(gp[6]), g2 = sigmoidf_(gp[12]);
        *(unsigned*)(mix + m * D_MODEL + 1280 + (hb + r) * 128 + 2 * lane) = pk2(g0 * oc[r][0] + g1 * os[r][0] + g2 * ow[r][0], g0 * oc[r][1] + g1 * os[r][1] + g2 * ow[r][1]); }
}

template <class Epi> __global__ __launch_bounds__(512, 2) void k_gemm(pg8::Gemm g, Epi E) {
    extern __shared__ __attribute__((aligned(16))) unsigned char shm[];
    pg8::StaticOrder S; S.init(g.M, g.N, (int)gridDim.x, (int)blockIdx.x);
    pg8::gemm_phase<Epi, pg8::StaticOrder, true, true>((PG8_LAS unsigned char*)shm, g, S, E);
}

extern "C" void kernel_launch(void* const* d_in, const int* in_sizes, int n_in, void* d_out, int out_size, void* d_ws, size_t ws_size, hipStream_t stream) {
    static int grid = 0;
    if (grid == 0) {
        if (n_in != 21 || in_sizes[0] != M * D_MODEL || out_size != M * D_MODEL || ws_size < WS_END) {
            fprintf(stderr, "kernel_launch: unexpected shapes: n_in %d in0 %d out %d ws %zu (need %zu)\n", n_in, n_in > 0 ? in_sizes[0] : -1, out_size, ws_size, (size_t)WS_END); grid = -1; return; }
        int dev = 0, cus = 0; (void)hipGetDevice(&dev); (void)hipDeviceGetAttribute(&cus, hipDeviceAttributeMultiprocessorCount, dev);
        (void)hipFuncSetAttribute((const void*)k_gemm<pg8::EpiProj>, hipFuncAttributeMaxDynamicSharedMemorySize, pg8::STAGE_BYTES);
        (void)hipFuncSetAttribute((const void*)k_gemm<pg8::EpiRelu2>, hipFuncAttributeMaxDynamicSharedMemorySize, pg8::STAGE_BYTES);
        (void)hipFuncSetAttribute((const void*)k_gemm<pg8::EpiRes>, hipFuncAttributeMaxDynamicSharedMemorySize, pg8::STAGE_BYTES);
        grid = cus > 0 ? cus : 256;
    }
    if (grid < 0) return;
    const float* x_in = (const float*)d_in[0];
    const float *attn_norm = (const float*)d_in[1], *w_in = (const float*)d_in[2], *conv_a = (const float*)d_in[3], *a_log = (const float*)d_in[4], *dt_bias = (const float*)d_in[5],
                *gdn_norm = (const float*)d_in[6], *sgu_ln_g = (const float*)d_in[7], *sgu_ln_b = (const float*)d_in[8], *sgu_w = (const float*)d_in[9], *sgu_b = (const float*)d_in[10],
                *nsa_q_norm = (const float*)d_in[11], *nsa_k_norm = (const float*)d_in[12], *cmp_pos = (const float*)d_in[13], *cmp_w1 = (const float*)d_in[14], *cmp_w2 = (const float*)d_in[15],
                *rel_bias = (const float*)d_in[16], *w_out = (const float*)d_in[17], *mlp_norm = (const float*)d_in[18], *w_up = (const float*)d_in[19], *w_down = (const float*)d_in[20];
    float* out = (float*)d_out; unsigned char* ws = (unsigned char*)d_ws;
    bf16 *Wt_in = (bf16*)(ws + WS_WIN), *Wt_out = (bf16*)(ws + WS_WOUT), *Wt_up = (bf16*)(ws + WS_WUP), *Wt_dn = (bf16*)(ws + WS_WDN);
    bf16 *HB = (bf16*)(ws + WS_HB), *PROJ = (bf16*)(ws + WS_PROJ), *NQ = (bf16*)(ws + WS_NQ), *NKS = (bf16*)(ws + WS_NKS), *NKW = (bf16*)(ws + WS_NKW), *HID = (bf16*)(ws + WS_HID),
         *GQ = (bf16*)(ws + WS_GQ), *VLN = (bf16*)(ws + WS_VLN);
    float *SMALL = (float*)(ws + WS_SMALL), *KC = (float*)(ws + WS_KC), *VC = (float*)(ws + WS_VC), *BG = (float*)(ws + WS_BG);
    for (int l = 0; l < DEPTH; ++l) {
        const float* xc = l == 0 ? x_in : out;
        hipLaunchKernelGGL(k_transpose<1>, dim3(2048), dim3(256), 0, stream, w_in + (size_t)l * D_MODEL * NPROJ_ORIG, D_MODEL, NPROJ_ORIG, Wt_in, NPROJ);
        hipLaunchKernelGGL(k_transpose<0>, dim3(2048), dim3(256), 0, stream, w_out + (size_t)l * D_MODEL * D_MODEL, D_MODEL, D_MODEL, Wt_out, D_MODEL);
        hipLaunchKernelGGL(k_transpose<0>, dim3(2048), dim3(256), 0, stream, w_up + (size_t)l * D_MODEL * D_FF, D_MODEL, D_FF, Wt_up, D_FF);
        hipLaunchKernelGGL(k_transpose<0>, dim3(2048), dim3(256), 0, stream, w_down + (size_t)l * D_FF * D_MODEL, D_FF, D_MODEL, Wt_dn, D_MODEL);
        hipLaunchKernelGGL(k_rmsnorm, dim3(2048), dim3(256), 0, stream, xc, attn_norm + l * D_MODEL, HB);
        { pg8::Gemm g{HB, Wt_in, M, NPROJ, D_MODEL, 0}; pg8::EpiProj E{PROJ, SMALL, NPROJ, PC_SMALL / 256};
          hipLaunchKernelGGL(k_gemm<pg8::EpiProj>, dim3(grid), dim3(512), pg8::STAGE_BYTES, stream, g, E); }
        hipLaunchKernelGGL(k_gdn_prep, dim3(2048), dim3(256), 0, stream, PROJ, SMALL, conv_a + (size_t)l * 4 * 2304, a_log + l * 6, dt_bias + l * 6, GQ, BG);
        hipLaunchKernelGGL(k_sgu_prep, dim3(2048), dim3(256), 0, stream, PROJ, sgu_ln_g + l * 512, sgu_ln_b + l * 512, VLN);
        hipLaunchKernelGGL(k_nsa_prep, dim3(2048), dim3(256), 0, stream, PROJ, nsa_q_norm + l * 128, nsa_k_norm + l * 128, NQ, NKS, NKW);
        hipLaunchKernelGGL(k_nsa_compress, dim3(1024), dim3(128), 0, stream, PROJ, cmp_pos + (size_t)l * 2 * 4096, cmp_w1 + (size_t)l * 2 * 4096 * 128, cmp_w2 + (size_t)l * 2 * 128 * 128, nsa_k_norm + l * 128, KC, VC);
        hipLaunchKernelGGL(k_gdn_scan, dim3(48), dim3(512), 0, stream, GQ, BG, PROJ, gdn_norm + l * 128, HB);
        hipLaunchKernelGGL(k_sgu_mix, dim3(1024), dim3(512), 0, stream, PROJ, VLN, sgu_w + (size_t)l * 4 * 128 * 128, sgu_b + l * 512, HB);
        hipLaunchKernelGGL(k_nsa_attn, dim3(M * 2 / 2), dim3(128), 0, stream, NQ, NKS, NKW, PROJ, KC, VC, SMALL, rel_bias, HB);
        { pg8::Gemm g{HB, Wt_out, M, D_MODEL, D_MODEL, 0}; pg8::EpiRes E{xc, out, D_MODEL, 0};
          hipLaunchKernelGGL(k_gemm<pg8::EpiRes>, dim3(grid), dim3(512), pg8::STAGE_BYTES, stream, g, E); }
        hipLaunchKernelGGL(k_rmsnorm, dim3(2048), dim3(256), 0, stream, out, mlp_norm + l * D_MODEL, HB);
        { pg8::Gemm g{HB, Wt_up, M, D_FF, D_MODEL, 0}; pg8::EpiRelu2 E{HID, D_FF, 0};
          hipLaunchKernelGGL(k_gemm<pg8::EpiRelu2>, dim3(grid), dim3(512), pg8::STAGE_BYTES, stream, g, E); }
        { pg8::Gemm g{HID, Wt_dn, M, D_MODEL, D_FF, 0}; pg8::EpiRes E{out, out, D_MODEL, 0};
          hipLaunchKernelGGL(k_gemm<pg8::EpiRes>, dim3(grid), dim3(512), pg8::STAGE_BYTES, stream, g, E); }
    }
}
```

```cpp
#include <hip/hip_runtime.h>
#include <cstdio>
#include <cstdint>
namespace pg8 {
#define PG8_LAS __attribute__((address_space(3)))
typedef unsigned short bf16_t;
typedef short bf16x8 __attribute__((ext_vector_type(8)));
typedef float f32x4 __attribute__((ext_vector_type(4)));
typedef unsigned u32x4 __attribute__((ext_vector_type(4)));
constexpr int BM = 256, BK = 64, HALF = 128, HTB = HALF * BK * 2  , STAGE_BYTES = 8 * HTB, NXCD = 8, WGM = 4;

__host__ __device__ __forceinline__ int lds_byte(int r, int c) { const int st = (r >> 4) * 2 + (c >> 5), rr = r & 15, cc = c & 31, ob = rr * 64 + cc * 2; return st * 1024 + (ob ^ (((ob >> 9) & 1) << 5)); }
__host__ __device__ __forceinline__ void stage_rc(int b, int& R, int& C) { const int st = b / 1024, sb = b % 1024, swz = sb ^ (((sb >> 9) & 1) << 5); R = (st >> 1) * 16 + swz / 64; C = (st & 1) * 32 + (swz % 64) / 2; }
__host__ __device__ __forceinline__ int perm32(int rho) { const int n = rho >> 4, i = rho & 15; return 8 * (i >> 2) + 4 * n + (i & 3); }

struct Unit { int pm, pn; };
struct Gemm { const bf16_t* A; const bf16_t* Bt; int M, N, K, pad; };

struct StaticOrder {
    int nM, nN, nwg, G, c;
    __host__ __device__ void init(int M, int N, int G_, int c_) { nM = M / BM; nN = N / BM; nwg = nM * nN; G = G_; c = c_; }
    __host__ __device__ bool next(int i, Unit& u) const {
        const long L = (long)i * G + c; if (L >= nwg) return false;
        int wgid = (int)L; { const int q = nwg / NXCD, r = nwg % NXCD, xcd = wgid % NXCD, off = wgid / NXCD; wgid = (xcd < r ? xcd * (q + 1) : r * (q + 1) + (xcd - r) * q) + off; }
        const int nig = WGM * nN, gid = wgid / nig, fm = gid * WGM, gsz = (nM - fm) < WGM ? (nM - fm) : WGM;
        u.pm = fm + ((wgid % nig) % gsz); u.pn = (wgid % nig) / gsz; return true;
    }
    __device__ __forceinline__ void a_ready(const Unit&) const {}
    __device__ __forceinline__ void done(const Unit&) const {}
};
__device__ __forceinline__ unsigned cvt_pk_bf16(float lo, float hi) { unsigned r; asm volatile("v_cvt_pk_bf16_f32 %0, %1, %2" : "=v"(r) : "v"(lo), "v"(hi)); return r; }

struct EpiProj {
    static constexpr bool PERM = true, AFTER_DRAIN = false;
    bf16_t* O; float* small; const float* rowsq; int ldc; int small_pn;
    __device__ __forceinline__ void operator()(const f32x4 (&acc)[2][2][4][2], const Unit& u, int wr, int wc, int fr, int fq) const {
        const int row0 = u.pm * BM + wr * 64 + fr;
        float rs[2][4];
#pragma unroll
        for (int ai = 0; ai < 2; ++ai)
#pragma unroll
            for (int m = 0; m < 4; ++m) rs[ai][m] = rsqrtf(rowsq[row0 + ai * HALF + m * 16] * (1.0f / 2048.0f) + 1e-6f);
        if (u.pn == small_pn) {
            if (wc == 0) {
#pragma unroll
                for (int ai = 0; ai < 2; ++ai)
#pragma unroll
                    for (int m = 0; m < 4; ++m) { float* p = small + (size_t)(row0 + ai * HALF + m * 16) * 32 + 8 * fq;
                        *(f32x4*)p = acc[ai][0][m][0] * rs[ai][m]; *(f32x4*)(p + 4) = acc[ai][0][m][1] * rs[ai][m]; }
            }
            return;
        }
        const int col0 = u.pn * BM + wc * 32 + 8 * fq;
#pragma unroll
        for (int ai = 0; ai < 2; ++ai)
#pragma unroll
            for (int m = 0; m < 4; ++m) { bf16_t* rowp = O + (size_t)(row0 + ai * HALF + m * 16) * ldc + col0;
#pragma unroll
                for (int bj = 0; bj < 2; ++bj) { const f32x4 v0 = acc[ai][bj][m][0] * rs[ai][m], v1 = acc[ai][bj][m][1] * rs[ai][m];
                    u32x4 w; w.x = cvt_pk_bf16(v0[0], v0[1]); w.y = cvt_pk_bf16(v0[2], v0[3]); w.z = cvt_pk_bf16(v1[0], v1[1]); w.w = cvt_pk_bf16(v1[2], v1[3]);
                    *(u32x4*)(rowp + bj * HALF) = w; } }
    }
};
struct EpiRelu2 {
    static constexpr bool PERM = true, AFTER_DRAIN = false;
    bf16_t* O; const float* rowsq; int ldc; int pad;
    __device__ __forceinline__ void operator()(const f32x4 (&acc)[2][2][4][2], const Unit& u, int wr, int wc, int fr, int fq) const {
        const int row0 = u.pm * BM + wr * 64 + fr;
        const int col0 = u.pn * BM + wc * 32 + 8 * fq;
#pragma unroll
        for (int ai = 0; ai < 2; ++ai)
#pragma unroll
            for (int m = 0; m < 4; ++m) { bf16_t* rowp = O + (size_t)(row0 + ai * HALF + m * 16) * ldc + col0;
                const float r2 = 1.0f / (rowsq[row0 + ai * HALF + m * 16] * (1.0f / 2048.0f) + 1e-6f);
#pragma unroll
                for (int bj = 0; bj < 2; ++bj) { f32x4 v0 = acc[ai][bj][m][0], v1 = acc[ai][bj][m][1];
#pragma unroll
                    for (int j = 0; j < 4; ++j) { const float a = fmaxf(v0[j], 0.f), b = fmaxf(v1[j], 0.f); v0[j] = a * a * r2; v1[j] = b * b * r2; }
                    u32x4 w; w.x = cvt_pk_bf16(v0[0], v0[1]); w.y = cvt_pk_bf16(v0[2], v0[3]); w.z = cvt_pk_bf16(v1[0], v1[1]); w.w = cvt_pk_bf16(v1[2], v1[3]);
                    __builtin_nontemporal_store(w, (u32x4*)(rowp + bj * HALF)); } }
    }
};
struct EpiRes {
    static constexpr bool PERM = true, AFTER_DRAIN = false;
    const bf16_t* base; bf16_t* xb; float* outf; float* rowsq; int ldc; int pad;
    __device__ __forceinline__ void operator()(const f32x4 (&acc)[2][2][4][2], const Unit& u, int wr, int wc, int fr, int fq) const {
        const int row0 = u.pm * BM + wr * 64 + fr, col0 = u.pn * BM + wc * 32 + 8 * fq;
#pragma unroll
        for (int ai = 0; ai < 2; ++ai) {
            u32x4 t[4][2];
#pragma unroll
            for (int m = 0; m < 4; ++m)
#pragma unroll
                for (int bj = 0; bj < 2; ++bj) t[m][bj] = *(const u32x4*)(base + (size_t)(row0 + ai * HALF + m * 16) * ldc + col0 + bj * HALF);
#pragma unroll
            for (int m = 0; m < 4; ++m) { const int row = row0 + ai * HALF + m * 16; const size_t off = (size_t)row * ldc + col0; float ss = 0.f;
#pragma unroll
                for (int bj = 0; bj < 2; ++bj) { const u32x4 b = t[m][bj]; const f32x4 a0 = acc[ai][bj][m][0], a1 = acc[ai][bj][m][1];
                    f32x4 o0, o1;
                    o0[0] = __builtin_bit_cast(float, b.x << 16) + a0[0]; o0[1] = __builtin_bit_cast(float, b.x & 0xffff0000u) + a0[1]; o0[2] = __builtin_bit_cast(float, b.y << 16) + a0[2]; o0[3] = __builtin_bit_cast(float, b.y & 0xffff0000u) + a0[3];
                    o1[0] = __builtin_bit_cast(float, b.z << 16) + a1[0]; o1[1] = __builtin_bit_cast(float, b.z & 0xffff0000u) + a1[1]; o1[2] = __builtin_bit_cast(float, b.w << 16) + a1[2]; o1[3] = __builtin_bit_cast(float, b.w & 0xffff0000u) + a1[3];
                    ss += ((o0[0] * o0[0] + o0[1] * o0[1]) + (o0[2] * o0[2] + o0[3] * o0[3])) + ((o1[0] * o1[0] + o1[1] * o1[1]) + (o1[2] * o1[2] + o1[3] * o1[3]));
                    if (outf) { *(f32x4*)(outf + off + bj * HALF) = o0; *(f32x4*)(outf + off + bj * HALF + 4) = o1; }
                    else { u32x4 w; w.x = cvt_pk_bf16(o0[0], o0[1]); w.y = cvt_pk_bf16(o0[2], o0[3]); w.z = cvt_pk_bf16(o1[0], o1[1]); w.w = cvt_pk_bf16(o1[2], o1[3]); *(u32x4*)(xb + off + bj * HALF) = w; } }
                ss += __shfl_xor(ss, 16); ss += __shfl_xor(ss, 32);
                if (fq == 0) rowsq[(size_t)row * 32 + u.pn * 4 + wc] = ss; }
            asm volatile("" ::: "memory");
        }
    }
};
template <class Epi, class Sched, bool ALIGN_EPI = false, bool SP2 = false>
__device__ __forceinline__ void gemm_phase(PG8_LAS unsigned char* lds, const Gemm g, const Sched& S, const Epi& E) {
    int tid_ = threadIdx.x; asm volatile("" : "+v"(tid_));
    const int tid = tid_, wid = __builtin_amdgcn_readfirstlane(tid >> 6), lane = tid & 63, wr = wid >> 2, wc = wid & 3, fr = lane & 15, fq = lane >> 4;
    const int K = g.K, nt = K / BK;
    unsigned voffA[2], voffB[2];
#pragma unroll
    for (int i = 0; i < 2; ++i) { int R, C; stage_rc(tid * 16 + i * 8192, R, C); const int Rb = Epi::PERM ? ((R & ~31) + perm32(R & 31)) : R;
        voffA[i] = (unsigned)(R * K + C) * 2u; voffB[i] = (unsigned)(Rb * K + C) * 2u; }
    const size_t kstep = (size_t)(BK * 2);
    const size_t hstep = (size_t)HALF * K * 2;
    const size_t tstep = 2 * hstep;
    const unsigned ldsw = (unsigned)wid * 1024u;
    const int aoff = lds_byte(wr * 64 + fr, fq * 8), boff = lds_byte(wc * 32 + fr, fq * 8);
#define PG8_SA(b, h) (((b) * 2 + (h)) * HTB)
#define PG8_SB(b, h) ((4 + (b) * 2 + (h)) * HTB)
#define PG8_STAGE(bufoff, gbase, voff) do { _Pragma("unroll") for (int _i = 0; _i < 2; ++_i) \
        __builtin_amdgcn_global_load_lds((const unsigned*)((const char*)(gbase) + (voff)[_i]), (PG8_LAS unsigned*)(lds + (bufoff) + ldsw + _i * 8192), 16, 0, 0); } while (0)
#define PG8_LDA(dst, b, h) do { _Pragma("unroll") for (int m = 0; m < 4; ++m) _Pragma("unroll") for (int k = 0; k < 2; ++k) dst[m][k] = *(const PG8_LAS bf16x8*)(lds + PG8_SA(b, h) + aoff + m * 2048 + k * 1024); } while (0)
#define PG8_LDB(dst, b, h) do { _Pragma("unroll") for (int n = 0; n < 2; ++n) _Pragma("unroll") for (int k = 0; k < 2; ++k) dst[n][k] = *(const PG8_LAS bf16x8*)(lds + PG8_SB(b, h) + boff + n * 2048 + k * 1024); } while (0)
#define PG8_MMA(ai, bj, At, Bt) do { __builtin_amdgcn_s_setprio(1); _Pragma("unroll") for (int m = 0; m < 4; ++m) _Pragma("unroll") for (int n = 0; n < 2; ++n) _Pragma("unroll") for (int k = 0; k < 2; ++k) \
        acc[ai][bj][m][n] = __builtin_amdgcn_mfma_f32_16x16x32_bf16(Bt[n][k], At[m][k], acc[ai][bj][m][n], 0, 0, 0); __builtin_amdgcn_s_setprio(0); } while (0)
#define PG8_WAIT_V(n) asm volatile("s_waitcnt vmcnt(" #n ")" ::: "memory")
#define PG8_WAIT_L(n) asm volatile("s_waitcnt lgkmcnt(" #n ")" ::: "memory")
#define PG8_BAR __builtin_amdgcn_s_barrier()
#define PG8_SCHED __builtin_amdgcn_sched_barrier(0)
    Unit cur, nxt; int ui = 0;
    if (!S.next(0, cur)) return;
    f32x4 acc[2][2][4][2];
#pragma unroll
    for (int a = 0; a < 2; ++a)
#pragma unroll
        for (int b = 0; b < 2; ++b)
#pragma unroll
            for (int m = 0; m < 4; ++m)
#pragma unroll
                for (int n = 0; n < 2; ++n) acc[a][b][m][n] = (f32x4){0.f, 0.f, 0.f, 0.f};
    bf16x8 At[4][2], B0[2][2], B1[2][2];
    const char* cA = (const char*)g.A + (size_t)cur.pm * tstep; const char* cB = (const char*)g.Bt + (size_t)cur.pn * tstep;
    S.a_ready(cur);
    if constexpr (SP2) {
        PG8_STAGE(PG8_SB(0, 0), cB, voffB); PG8_STAGE(PG8_SB(0, 1), cB + hstep, voffB); PG8_STAGE(PG8_SA(0, 0), cA, voffA); PG8_STAGE(PG8_SA(0, 1), cA + hstep, voffA);
        if (wr == 1) PG8_BAR;
        PG8_WAIT_V(2); PG8_BAR;
        PG8_STAGE(PG8_SB(1, 0), cB + kstep, voffB); PG8_STAGE(PG8_SA(1, 0), cA + kstep, voffA); PG8_STAGE(PG8_SB(1, 1), cB + hstep + kstep, voffB);
        PG8_WAIT_V(6); PG8_BAR;
    } else {
        PG8_STAGE(PG8_SB(0, 0), cB, voffB); PG8_STAGE(PG8_SA(0, 0), cA, voffA); PG8_STAGE(PG8_SB(0, 1), cB + hstep, voffB); PG8_STAGE(PG8_SA(0, 1), cA + hstep, voffA);
        if (wr == 1) PG8_BAR;
        PG8_WAIT_V(4); PG8_BAR;
        PG8_STAGE(PG8_SB(1, 0), cB + kstep, voffB); PG8_STAGE(PG8_SA(1, 0), cA + kstep, voffA); PG8_STAGE(PG8_SB(1, 1), cB + hstep + kstep, voffB);
        PG8_WAIT_V(6); PG8_BAR;
    }
    for (;;) {
        const bool has_next = S.next(ui + 1, nxt);
        const char* nA = has_next ? (const char*)g.A + (size_t)nxt.pm * tstep : cA; const char* nB = has_next ? (const char*)g.Bt + (size_t)nxt.pn * tstep : cB;
        for (int t = 0; t < nt; t += 2) {
            const bool last = (t == nt - 2);
            const char* a1 = cA + (size_t)(t + 1) * kstep;
            const char* a2 = last ? nA : cA + (size_t)(t + 2) * kstep; const char* b2 = last ? nB : cB + (size_t)(t + 2) * kstep;
            const char* a3 = a2 + kstep; const char* b3 = b2 + kstep;
            if (last && has_next) S.a_ready(nxt);
            if constexpr (SP2) {
            PG8_LDB(B0, 0, 0); PG8_LDB(B1, 0, 1); PG8_SCHED; PG8_LDA(At, 0, 0); PG8_STAGE(PG8_SA(1, 1), a1 + hstep, voffA);
            PG8_WAIT_V(8); PG8_WAIT_L(0); PG8_BAR; PG8_MMA(0, 0, At, B0); PG8_MMA(0, 1, At, B1); PG8_BAR; PG8_SCHED;
            PG8_LDA(At, 0, 1); PG8_STAGE(PG8_SB(0, 0), b2, voffB); PG8_STAGE(PG8_SB(0, 1), b2 + hstep, voffB); PG8_STAGE(PG8_SA(0, 0), a2, voffA);
            PG8_WAIT_V(8); PG8_WAIT_L(0); PG8_BAR; PG8_MMA(1, 0, At, B0); PG8_MMA(1, 1, At, B1); PG8_BAR; PG8_SCHED;
            PG8_LDB(B0, 1, 0); PG8_LDB(B1, 1, 1); PG8_SCHED; PG8_LDA(At, 1, 0); PG8_STAGE(PG8_SA(0, 1), a2 + hstep, voffA);
            PG8_WAIT_V(8); PG8_WAIT_L(0); PG8_BAR; PG8_MMA(0, 0, At, B0); PG8_MMA(0, 1, At, B1); PG8_BAR; PG8_SCHED;
            PG8_LDA(At, 1, 1); PG8_STAGE(PG8_SB(1, 0), b3, voffB); PG8_STAGE(PG8_SB(1, 1), b3 + hstep, voffB); PG8_STAGE(PG8_SA(1, 0), a3, voffA);
            PG8_WAIT_V(8); PG8_WAIT_L(0); PG8_BAR; PG8_MMA(1, 0, At, B0); PG8_MMA(1, 1, At, B1); PG8_BAR; PG8_SCHED;
            } else {
            PG8_LDB(B0, 0, 0); PG8_SCHED; PG8_LDA(At, 0, 0); PG8_STAGE(PG8_SA(1, 1), a1 + hstep, voffA);
            PG8_WAIT_L(8); PG8_BAR; PG8_WAIT_L(0); PG8_MMA(0, 0, At, B0); PG8_BAR; PG8_SCHED;
            PG8_LDB(B1, 0, 1); PG8_STAGE(PG8_SB(0, 0), b2, voffB);
            PG8_BAR; PG8_WAIT_L(0); PG8_MMA(0, 1, At, B1); PG8_BAR;
            PG8_LDA(At, 0, 1); PG8_STAGE(PG8_SA(0, 0), a2, voffA);
            PG8_BAR; PG8_WAIT_L(0); PG8_MMA(1, 0, At, B0); PG8_BAR; PG8_SCHED;
            PG8_STAGE(PG8_SB(0, 1), b2 + hstep, voffB);
            PG8_WAIT_V(6); PG8_BAR; PG8_MMA(1, 1, At, B1); PG8_BAR;
            PG8_LDB(B0, 1, 0); PG8_SCHED; PG8_LDA(At, 1, 0); PG8_STAGE(PG8_SA(0, 1), a2 + hstep, voffA);
            PG8_WAIT_L(8); PG8_BAR; PG8_WAIT_L(0); PG8_MMA(0, 0, At, B0); PG8_BAR; PG8_SCHED;
            PG8_LDB(B1, 1, 1); PG8_STAGE(PG8_SB(1, 0), b3, voffB);
            PG8_BAR; PG8_WAIT_L(0); PG8_MMA(0, 1, At, B1); PG8_BAR;
            PG8_LDA(At, 1, 1); PG8_STAGE(PG8_SA(1, 0), a3, voffA);
            PG8_BAR; PG8_WAIT_L(0); PG8_MMA(1, 0, At, B0); PG8_BAR; PG8_SCHED;
            PG8_STAGE(PG8_SB(1, 1), b3 + hstep, voffB);
            PG8_WAIT_V(6); PG8_BAR; PG8_MMA(1, 1, At, B1); PG8_BAR;
            }
        }
        if constexpr (ALIGN_EPI) { if (wr == 0) PG8_BAR; }
        if constexpr (!Epi::AFTER_DRAIN) { E(acc, cur, wr, wc, fr, fq); S.done(cur); }
        if (!has_next) break;
#pragma unroll
        for (int a = 0; a < 2; ++a)
#pragma unroll
            for (int b = 0; b < 2; ++b)
#pragma unroll
                for (int m = 0; m < 4; ++m)
#pragma unroll
                    for (int n = 0; n < 2; ++n) acc[a][b][m][n] = (f32x4){0.f, 0.f, 0.f, 0.f};
        cur = nxt; cA = nA; cB = nB; ++ui;
        if constexpr (ALIGN_EPI) { if (wr == 1) PG8_BAR; }
    }
    PG8_WAIT_V(0);
    if constexpr (!ALIGN_EPI) { if (wr == 0) PG8_BAR; }
    PG8_BAR;
    if constexpr (Epi::AFTER_DRAIN) { E.fused(acc, cur, wr, wc, fr, fq, lds, wid, lane); S.done(cur); }
#undef PG8_SA
#undef PG8_SB
#undef PG8_STAGE
#undef PG8_LDA
#undef PG8_LDB
#undef PG8_MMA
#undef PG8_WAIT_V
#undef PG8_WAIT_L
#undef PG8_BAR
#undef PG8_SCHED
}
}

typedef unsigned short bf16;
typedef float f32x4 __attribute__((ext_vector_type(4)));
typedef float f32x2 __attribute__((ext_vector_type(2)));
typedef unsigned u32x4 __attribute__((ext_vector_type(4)));
typedef unsigned u32x2 __attribute__((ext_vector_type(2)));
constexpr int D_MODEL = 2048, BATCH = 8, SEQ = 4096, DEPTH = 4, HD = 128, D_FF = 8192;
constexpr int M = BATCH * SEQ;
constexpr int NPROJ_ORIG = 6430, NPROJ = 6656;
constexpr int PC_QA = 0, PC_KA = 768, PC_VA = 1536, PC_ZA = 2304, PC_UB = 3072, PC_VB = 3584, PC_QC = 4096, PC_KCC = 4864, PC_VCC = 5120,
              PC_KSL = 5376, PC_VSL = 5632, PC_KWN = 5888, PC_VWN = 6144, PC_SMALL = 6400;
constexpr int SM_BA = 0, SM_AA = 6, SM_GC = 12;
constexpr int N_CMP = 255;
constexpr float NORM_EPS = 1e-6f;
__host__ __device__ __forceinline__ int win_map(int n) {
    if (n < 3072) return n;
    if (n < 4096) return 3084 + (n - 3072);
    if (n < 6400) return 4108 + (n - 4096);
    if (n < 6412) return 3072 + (n - 6400);
    if (n < 6430) return n;
    return -1;
}
constexpr size_t MiB = 1u << 20;
constexpr size_t WS_CTL = 0;
constexpr size_t WS_WIN = 1 * MiB, WS_WOUT = 27 * MiB, WS_WUP = 35 * MiB, WS_WDN = 67 * MiB;
constexpr size_t WS_HB = 100 * MiB;
constexpr size_t WS_R1 = 228 * MiB;
constexpr size_t WS_PROJ = WS_R1, WS_SMALL = 644 * MiB, WS_NQ = 648 * MiB, WS_NKS = 696 * MiB, WS_NKW = 712 * MiB;
constexpr size_t WS_KCB = 728 * MiB, WS_VCT = 729 * MiB, WS_SELM = 730 * MiB, WS_EGL = 731 * MiB, WS_W1T = 732 * MiB, WS_W2T = 734 * MiB, WS_C1 = 735 * MiB, WS_WSG = 735 * MiB + 65536, WS_RSQ1 = 956 * MiB, WS_RSQ2 = 956 * MiB + 131072;
constexpr size_t WS_RSP = 1020 * MiB;
constexpr size_t WS_XG2 = 740 * MiB;
constexpr size_t WS_HID = WS_R1;
constexpr size_t WS_UF = 740 * MiB, WS_WP = 788 * MiB, WS_QGP = 836 * MiB, WS_KDT = 884 * MiB, WS_AP = 932 * MiB;
constexpr size_t WS_VLN = 956 * MiB, WS_VST = 988 * MiB, WS_VWT = 1004 * MiB, WS_KC = 1020 * MiB, WS_VC = 1022 * MiB, WS_END = 1024 * MiB;
constexpr size_t CTL_QUEUE = 32768;

__device__ __forceinline__ float bf2f(bf16 v) { return __uint_as_float(((unsigned)v) << 16); }
typedef __bf16 bf16x2_hw __attribute__((ext_vector_type(2)));
__device__ __forceinline__ unsigned pk2(float lo, float hi) { f32x2 v = {lo, hi}; return __builtin_bit_cast(unsigned, __builtin_convertvector(v, bf16x2_hw)); }
__device__ __forceinline__ bf16 f2bf(float f) { return (bf16)(pk2(f, 0.f) & 0xffffu); }
__device__ __forceinline__ float row16_sum(float x) {
    x += __builtin_bit_cast(float, __builtin_amdgcn_update_dpp(0, __builtin_bit_cast(int, x), 0x128, 0xf, 0xf, false));
    x += __builtin_bit_cast(float, __builtin_amdgcn_update_dpp(0, __builtin_bit_cast(int, x), 0x124, 0xf, 0xf, false));
    x += __builtin_bit_cast(float, __builtin_amdgcn_update_dpp(0, __builtin_bit_cast(int, x), 0x122, 0xf, 0xf, false));
    x += __builtin_bit_cast(float, __builtin_amdgcn_update_dpp(0, __builtin_bit_cast(int, x), 0x121, 0xf, 0xf, false));
    return x;
}
__device__ __forceinline__ float wave_sum(float v) {
    v = row16_sum(v);
    const float s0 = __builtin_bit_cast(float, __builtin_amdgcn_readlane(__builtin_bit_cast(int, v), 0)), s1 = __builtin_bit_cast(float, __builtin_amdgcn_readlane(__builtin_bit_cast(int, v), 16));
    const float s2 = __builtin_bit_cast(float, __builtin_amdgcn_readlane(__builtin_bit_cast(int, v), 32)), s3 = __builtin_bit_cast(float, __builtin_amdgcn_readlane(__builtin_bit_cast(int, v), 48));
    return (s0 + s1) + (s2 + s3);
}
__device__ __forceinline__ float wave_max(float v) {
#pragma unroll
    for (int o = 1; o < 64; o <<= 1) v = fmaxf(v, __shfl_xor(v, o));
    return v;
}
__device__ __forceinline__ float sigmoidf_(float x) { return 1.0f / (1.0f + __expf(-x)); }
__device__ __forceinline__ float siluf_(float x) { return x * sigmoidf_(x); }
__device__ __forceinline__ float gelu_tanh(float x) { const float u = 1.5957691216057308f * (x + 0.044715f * x * x * x); return x * __builtin_amdgcn_rcpf(1.0f + __expf(-u)); }
__device__ __forceinline__ float softplusf_(float x) { const float e = __expf(-fabsf(x)); const float lp = e < 0.01f ? e * (1.f - e * (0.5f - e * 0.33333334f)) : __logf(1.f + e); return fmaxf(x, 0.f) + lp; }
__device__ __forceinline__ int t5_bucket(int dist) {
    const int n = dist > 0 ? dist : 0;
    if (n < 16) return n;
    const float lr = logf((float)n / 16.0f) / 2.0794415416798357f;
    const int large = 16 + (int)(lr * 16.0f);
    return large < 31 ? large : 31;
}

#define XB_TMO      128
#define XB_XCNT(j)  (256  + 64 * (j))
#define XB_XSUB(j)  (1280 + 64 * (j))
#define XB_XGEN(j)  (2304 + 64 * (j))
#define XB_TOP      3328
#define XB_TOPGEN   3392
#define XCD_BAR_WORDS 3456
#define XB_SPIN_CAP (1u << 18)
#define LAS __attribute__((address_space(3)))

__device__ __forceinline__ unsigned xb_ld(unsigned* p)              { return __hip_atomic_load(p, __ATOMIC_RELAXED, __HIP_MEMORY_SCOPE_AGENT); }
__device__ __forceinline__ unsigned xb_add(unsigned* p, unsigned v) { return __hip_atomic_fetch_add(p, v, __ATOMIC_RELAXED, __HIP_MEMORY_SCOPE_AGENT); }
__device__ __forceinline__ unsigned xb_xcc_id() { return (unsigned)__builtin_amdgcn_s_getreg((3 << 11) | 20) & 0xFu; }
#define XB_SPIN(cond, bar) do { unsigned _sp = 0; while (cond) { __builtin_amdgcn_s_sleep(1); \
    if ((++_sp & 255u) == 0u) { if (xb_ld(&(bar)[XB_TMO])) break; if (_sp > XB_SPIN_CAP) { atomicAdd(&(bar)[XB_TMO], 1u); break; } } } } while (0)

struct XcdBarrier {
    unsigned* bar; unsigned x;
    volatile LAS unsigned* st;
};

__device__ __forceinline__ XcdBarrier xcd_barrier_post(unsigned* bar, volatile LAS unsigned* st) {
    XcdBarrier b; b.bar = bar; b.x = xb_xcc_id(); b.st = st;
    if (threadIdx.x == 0) (void)xb_add(&bar[XB_XCNT(b.x)], 1u);
    return b;
}
__device__ __forceinline__ void xcd_barrier_complete(unsigned* bar, unsigned x, unsigned& nloc, unsigned& nx) {
    const unsigned G = gridDim.x * gridDim.y * gridDim.z;
    unsigned sum, cnt, mine, sp = 0u;
    for (;;) {
        sum = 0u; cnt = 0u; mine = 0u;
#pragma unroll
        for (unsigned j = 0; j < 16; ++j) { const unsigned c = xb_ld(&bar[XB_XCNT(j)]); sum += c; cnt += (c > 0u) ? 1u : 0u; mine = (j == x) ? c : mine; }
        if (sum == G) break;
        __builtin_amdgcn_s_sleep(1);
        if ((++sp & 255u) == 0u) { if (xb_ld(&bar[XB_TMO])) break; if (sp > XB_SPIN_CAP) { atomicAdd(&bar[XB_TMO], 1u); break; } }
    }
    nloc = mine > 0u ? mine : 1u; nx = cnt > 0u ? cnt : 1u;
}

__device__ __forceinline__ void xcd_barrier(const XcdBarrier& b) {
    asm volatile("s_waitcnt vmcnt(0)" ::: "memory");
    __syncthreads();
    if (threadIdx.x == 0) {
        unsigned* bar = b.bar;
        __builtin_amdgcn_s_waitcnt(0);
        unsigned nloc = b.st[0], nx = b.st[1];
        if (nloc == 0u) { xcd_barrier_complete(bar, b.x, nloc, nx); b.st[0] = nloc; b.st[1] = nx; }
        const unsigned old = xb_add(&bar[XB_XSUB(b.x)], 1u);
        const unsigned gen = old / nloc;
        if (old + 1u == (gen + 1u) * nloc) {
            __builtin_amdgcn_fence(__ATOMIC_RELEASE, "agent");
            asm volatile("s_waitcnt vmcnt(0)" ::: "memory");
            const unsigned og = xb_add(&bar[XB_TOP], 1u);
            const unsigned tg = og / nx;
            if (og + 1u == (tg + 1u) * nx) xb_add(&bar[XB_TOPGEN], 1u);
            else XB_SPIN(xb_ld(&bar[XB_TOPGEN]) == tg, bar);
            __builtin_amdgcn_fence(__ATOMIC_ACQUIRE, "agent");
            xb_add(&bar[XB_XGEN(b.x)], 1u);
            asm volatile("s_waitcnt vmcnt(0)" ::: "memory");
        } else {
            XB_SPIN(xb_ld(&bar[XB_XGEN(b.x)]) == gen, bar);
            __builtin_amdgcn_fence(__ATOMIC_ACQUIRE, "agent");
            asm volatile("s_waitcnt vmcnt(0)" ::: "memory");
        }
    }
    __syncthreads();
}

#define LAS __attribute__((address_space(3)))
constexpr int NWAVES = 8, NTHREADS = 512;
constexpr int LDS_BYTES = 147456;
constexpr int LDS_MISC = LDS_BYTES - 256;
struct Params { const float* in[21]; float* out; unsigned char* ws; };
constexpr int LDS_PTAB = LDS_MISC + 16;
__device__ __forceinline__ int ltid() { int t = threadIdx.x; asm volatile("" : "+v"(t)); return t; }
__device__ __forceinline__ unsigned long long lds_ptr_raw(int i) {
    extern __shared__ __attribute__((aligned(16))) unsigned char lds_dyn[];
    const volatile LAS unsigned long long* tab = (const volatile LAS unsigned long long*)(lds_dyn + LDS_PTAB);
    int ii = i; asm volatile("" : "+v"(ii));
    const unsigned long long v = tab[ii];
    const unsigned lo = __builtin_amdgcn_readfirstlane((unsigned)v), hi = __builtin_amdgcn_readfirstlane((unsigned)(v >> 32));
    return ((unsigned long long)hi << 32) | lo;
}
#define GAS __attribute__((address_space(1)))
__device__ __forceinline__ unsigned char* gptr(int i) { return (unsigned char*)(GAS unsigned char*)lds_ptr_raw(i); }
__device__ __forceinline__ const float* in_ptr(int i) { return (const float*)gptr(i); }
enum { I_X = 0, I_ATTN_NORM, I_W_IN, I_CONV_A, I_A_LOG, I_DT_BIAS, I_GDN_NORM, I_SGU_LN_G, I_SGU_LN_B, I_SGU_W, I_SGU_B, I_NSA_QN, I_NSA_KN, I_CMP_POS, I_CMP_W1, I_CMP_W2, I_REL_BIAS, I_W_OUT, I_MLP_NORM, I_W_UP, I_W_DOWN };

template <int MAP> __device__ __forceinline__ void ph_transpose(const float* __restrict__ W, int K, int N_orig, bf16* __restrict__ WT, int N_out, const float* __restrict__ kscale = nullptr) {
    extern __shared__ __attribute__((aligned(16))) unsigned char lds_dyn[];
    const int tid = ltid(); const int lane = tid & 63, wave = tid >> 6;
    float* scr = (float*)lds_dyn + wave * (64 * 65);
    const int nblk = N_out / 64, nitems = (K / 64) * nblk;
    const int ksub = lane >> 4, n4 = (lane & 15) * 4;
    for (int it = blockIdx.x * NWAVES + wave; it < nitems; it += gridDim.x * NWAVES) {
        const int kb = it / nblk, nb = it % nblk, k0 = 64 * kb, n0 = 64 * nb;
        const int ng = n0 + n4; const int no = MAP ? win_map(ng) : ng;
        const bool vec = MAP ? (no >= 0 && win_map(ng + 3) == no + 3) : true;
        f32x4 v[16];
        if (vec) {
#pragma unroll
            for (int i = 0; i < 16; ++i) { const float* p = W + (size_t)(k0 + 4 * i + ksub) * N_orig + no; if (MAP) { const f32x2 a0 = *(const f32x2*)p, a1 = *(const f32x2*)(p + 2); v[i] = (f32x4){a0.x, a0.y, a1.x, a1.y}; }
                else v[i] = *(const f32x4*)p; }
        } else {
#pragma unroll
            for (int i = 0; i < 16; ++i) { const float* p = W + (size_t)(k0 + 4 * i + ksub) * N_orig;
#pragma unroll
                for (int e = 0; e < 4; ++e) { const int ne = MAP ? win_map(ng + e) : ng + e; v[i][e] = ne >= 0 ? p[ne] : 0.f; } }
        }
        if (kscale) {
#pragma unroll
            for (int i = 0; i < 16; ++i) v[i] *= kscale[k0 + 4 * i + ksub]; }
#pragma unroll
        for (int i = 0; i < 16; ++i) { float* d = scr + (4 * i + ksub) * 65 + n4; d[0] = v[i].x; d[1] = v[i].y; d[2] = v[i].z; d[3] = v[i].w; }
        __builtin_amdgcn_s_waitcnt(0); asm volatile("" ::: "memory");
        const int c = lane & 7;
#pragma unroll
        for (int j = 0; j < 8; ++j) { const int nn = (lane >> 3) + 8 * j; const float* sp = scr + (8 * c) * 65 + nn;
            u32x4 o; o.x = pk2(sp[0 * 65], sp[1 * 65]); o.y = pk2(sp[2 * 65], sp[3 * 65]); o.z = pk2(sp[4 * 65], sp[5 * 65]); o.w = pk2(sp[6 * 65], sp[7 * 65]);
            *(u32x4*)(WT + (size_t)(n0 + nn) * K + k0 + 8 * c) = o; }
        __builtin_amdgcn_s_waitcnt(0); asm volatile("" ::: "memory");
    }
}

__device__ __forceinline__ void ph_rmsnorm(const float* __restrict__ x, const float* __restrict__ gain, bf16* __restrict__ out) {
    const int tid = ltid(); const int lane = tid & 63; const int gw = blockIdx.x * NWAVES + (tid >> 6), ngw = gridDim.x * NWAVES;
    for (int m = gw; m < M; m += ngw) {
        const f32x4* xr = (const f32x4*)(x + (size_t)m * D_MODEL) + lane; f32x4 v[8]; float s = 0.f;
#pragma unroll
        for (int j = 0; j < 8; ++j) { v[j] = xr[64 * j]; s += (v[j].x * v[j].x + v[j].y * v[j].y) + (v[j].z * v[j].z + v[j].w * v[j].w); }
        const float rstd = rsqrtf(wave_sum(s) * (1.f / D_MODEL) + NORM_EPS);
        u32x2* o = (u32x2*)(out + (size_t)m * D_MODEL) + lane;
#pragma unroll
        for (int j = 0; j < 8; ++j) { const f32x4 g = ((const f32x4*)gain)[64 * j + lane]; u32x2 w; w.x = pk2(v[j].x * rstd * g.x, v[j].y * rstd * g.y); w.y = pk2(v[j].z * rstd * g.z, v[j].w * rstd * g.w); o[64 * j] = w; }
    }
}

__device__ __forceinline__ void ph_xg0(const float* __restrict__ x, const float* __restrict__ gain, bf16* __restrict__ xg, float* __restrict__ rowsq) {
    const int tid = ltid(); const int lane = tid & 63; const int gw = blockIdx.x * NWAVES + (tid >> 6), ngw = gridDim.x * NWAVES;
    for (int m = gw; m < M; m += ngw) {
        const f32x4* xr = (const f32x4*)(x + (size_t)m * D_MODEL) + lane; f32x4 v[8]; float s = 0.f;
#pragma unroll
        for (int j = 0; j < 8; ++j) { v[j] = xr[64 * j]; s += (v[j].x * v[j].x + v[j].y * v[j].y) + (v[j].z * v[j].z + v[j].w * v[j].w); }
        s = wave_sum(s); if (lane == 0) rowsq[m] = s;
        u32x2* o = (u32x2*)(xg + (size_t)m * D_MODEL) + lane;
#pragma unroll
        for (int j = 0; j < 8; ++j) { u32x2 w; w.x = pk2(v[j].x, v[j].y); w.y = pk2(v[j].z, v[j].w); o[64 * j] = w; }
    }
}
__device__ __forceinline__ void ph_rowsq_reduce(const float* __restrict__ part, float* __restrict__ rowsq) {
    const int tid = ltid();
    for (int r = blockIdx.x * NTHREADS + tid; r < M; r += gridDim.x * NTHREADS) { const f32x4* p = (const f32x4*)(part + (size_t)r * 32); float s = 0.f;
#pragma unroll
        for (int j = 0; j < 8; ++j) { const f32x4 v = p[j]; s += (v.x + v.y) + (v.z + v.w); }
        rowsq[r] = s; }
}
__device__ __forceinline__ void ph_zero_f32(float* __restrict__ p, int n) { const int tid = ltid(); for (int i = blockIdx.x * NTHREADS + tid; i < n; i += gridDim.x * NTHREADS) p[i] = 0.f; }
__device__ __forceinline__ void ph_gdn_prep(const bf16* __restrict__ proj, const float* __restrict__ small, const float* __restrict__ conv_w, const float* __restrict__ a_log,
                                            const float* __restrict__ dt_bias, bf16* __restrict__ GQ, float* __restrict__ BG) {
    const int tid = ltid(); const int lane = tid & 63; const int gw = blockIdx.x * NWAVES + (tid >> 6), ngw = gridDim.x * NWAVES;
    for (int p = gw; p < M * 18; p += ngw) {
        const int m = p / 18, j = p % 18, t = m & (SEQ - 1), c = j * 128 + lane * 2;
        float y0 = 0.f, y1 = 0.f;
#pragma unroll
        for (int tap = 0; tap < 4; ++tap) { const int tt = t - 3 + tap; if (tt >= 0) { const unsigned pr = *(const unsigned*)(proj + (size_t)(m - 3 + tap) * NPROJ + c);
            y0 += conv_w[tap * 2304 + c] * bf2f((bf16)(pr & 0xffff)); y1 += conv_w[tap * 2304 + c + 1] * bf2f((bf16)(pr >> 16)); } }
        y0 = siluf_(y0); y1 = siluf_(y1);
        if (j < 12) { const float ss = wave_sum(y0 * y0 + y1 * y1); float r = rsqrtf(ss + NORM_EPS); if (j < 6) r *= 0.08838834764831845f; y0 *= r; y1 *= r; }
        *(unsigned*)(GQ + (size_t)m * 2304 + c) = pk2(y0, y1);
    }
    for (int i = blockIdx.x * NTHREADS + tid; i < M * 6; i += gridDim.x * NTHREADS) { const int m = i / 6, h = i % 6;
        BG[(size_t)m * 12 + h] = sigmoidf_(small[(size_t)m * 32 + SM_BA + h]);
        BG[(size_t)m * 12 + 6 + h] = -__expf(a_log[h]) * softplusf_(small[(size_t)m * 32 + SM_AA + h] + dt_bias[h]); }
}
__device__ __forceinline__ void ph_gdn_scan(const bf16* __restrict__ GQ, const float* __restrict__ BG, const bf16* __restrict__ proj, const float* __restrict__ norm_g, bf16* __restrict__ mix, int nblk_scan) {
    extern __shared__ __attribute__((aligned(16))) unsigned char lds_dyn[];
    float (*sq)[144] = (float (*)[144])lds_dyn; float (*sk)[144] = (float (*)[144])(lds_dyn + 8 * 144 * 4);
    float (*sv)[128] = (float (*)[128])(lds_dyn + 16 * 144 * 4); float (*osh)[128] = (float (*)[128])(lds_dyn + 16 * 144 * 4 + 8 * 128 * 4);
    float (*sc)[2] = (float (*)[2])(lds_dyn + 16 * 144 * 4 + 16 * 128 * 4);
    const int tid = ltid(); const int c = tid >> 2, p = tid & 3, lane = tid & 63, wave = tid >> 6;
    for (int bh = blockIdx.x; bh < BATCH * 6; bh += nblk_scan) {
        const int b = bh / 6, h = bh % 6;
        float S[32];
#pragma unroll
        for (int j = 0; j < 32; ++j) S[j] = 0.f;
        for (int t0 = 0; t0 < SEQ; t0 += 8) {
            for (int i = tid; i < 8 * 384; i += NTHREADS) { const int tt = i / 384, r = i % 384, which = r >> 7, d = r & 127;
                const float v = bf2f(GQ[(size_t)(b * SEQ + t0 + tt) * 2304 + which * 768 + h * 128 + d]);
                if (which == 0) sq[tt][(d >> 5) * 36 + (d & 31)] = v; else if (which == 1) sk[tt][(d >> 5) * 36 + (d & 31)] = v; else sv[tt][d] = v; }
            if (tid < 8) { const size_t m = (size_t)b * SEQ + t0 + tid; sc[tid][0] = BG[m * 12 + h]; sc[tid][1] = __expf(BG[m * 12 + 6 + h]); }
            __syncthreads();
#pragma unroll 1
            for (int tt = 0; tt < 8; ++tt) {
                const float beta = sc[tt][0], eg = sc[tt][1];
                float kS = 0.f;
#pragma unroll
                for (int j = 0; j < 32; ++j) kS += sk[tt][p * 36 + j] * S[j];
                kS += __shfl_xor(kS, 1); kS += __shfl_xor(kS, 2);
                const float coef = beta * (sv[tt][c] - eg * kS);
                float o = 0.f;
#pragma unroll
                for (int j = 0; j < 32; ++j) { S[j] = eg * S[j] + sk[tt][p * 36 + j] * coef; o += sq[tt][p * 36 + j] * S[j]; }
                o += __shfl_xor(o, 1); o += __shfl_xor(o, 2);
                if (p == 0) osh[tt][c] = o;
            }
            __syncthreads();
            { const int tt = wave; const size_t m = (size_t)b * SEQ + t0 + tt; const int c0 = lane * 2;
              const float o0 = osh[tt][c0], o1 = osh[tt][c0 + 1]; const float rstd = rsqrtf(wave_sum(o0 * o0 + o1 * o1) * (1.f / 128.f) + NORM_EPS);
              const unsigned zz = *(const unsigned*)(proj + m * NPROJ + PC_ZA + h * 128 + c0);
              const float r0 = o0 * rstd * norm_g[c0] * siluf_(bf2f((bf16)(zz & 0xffff))), r1 = o1 * rstd * norm_g[c0 + 1] * siluf_(bf2f((bf16)(zz >> 16)));
              *(unsigned*)(mix + m * D_MODEL + h * 128 + c0) = pk2(r0, r1); }
            __syncthreads();
        }
    }
}

__device__ __forceinline__ void ph_sgu_prep(const bf16* __restrict__ proj, const float* __restrict__ ln_g, const float* __restrict__ ln_b, bf16* __restrict__ VLN) {
    const int tid = ltid(); const int lane = tid & 63; const int gw = blockIdx.x * NWAVES + (tid >> 6), ngw = gridDim.x * NWAVES;
    float lg[8], lb[8];
#pragma unroll
    for (int j = 0; j < 8; ++j) { lg[j] = ln_g[lane * 8 + j]; lb[j] = ln_b[lane * 8 + j]; }
    for (int m0 = gw; m0 < M; m0 += 4 * ngw) {
        u32x4 raw4[4];
#pragma unroll
        for (int k = 0; k < 4; ++k) { const int m = m0 + k * ngw < M ? m0 + k * ngw : m0; raw4[k] = *(const u32x4*)(proj + (size_t)m * NPROJ + PC_VB + lane * 8); }
#pragma unroll
        for (int k = 0; k < 4; ++k) { const int m = m0 + k * ngw;
            if (m < M) {
                float v[8]; const unsigned rw[4] = {raw4[k].x, raw4[k].y, raw4[k].z, raw4[k].w};
                float s = 0.f;
#pragma unroll
                for (int j = 0; j < 4; ++j) { v[2 * j] = gelu_tanh(bf2f((bf16)(rw[j] & 0xffff))); v[2 * j + 1] = gelu_tanh(bf2f((bf16)(rw[j] >> 16))); s += v[2 * j] + v[2 * j + 1]; }
                const float mu = wave_sum(s) * (1.f / 512.f); float q = 0.f;
#pragma unroll
                for (int j = 0; j < 8; ++j) { v[j] -= mu; q += v[j] * v[j]; }
                const float rstd = rsqrtf(wave_sum(q) * (1.f / 512.f) + NORM_EPS);
                u32x4 o; unsigned ow[4];
#pragma unroll
                for (int j = 0; j < 4; ++j) ow[j] = pk2(v[2 * j] * rstd * lg[2 * j] + lb[2 * j], v[2 * j + 1] * rstd * lg[2 * j + 1] + lb[2 * j + 1]);
                o.x = ow[0]; o.y = ow[1]; o.z = ow[2]; o.w = ow[3];
                *(u32x4*)(VLN + (size_t)m * 512 + lane * 8) = o;
            } }
    }
}
__device__ __forceinline__ void ph_sgu_mix(const bf16* __restrict__ proj, const bf16* __restrict__ VLN, const float* __restrict__ sgu_w, const float* __restrict__ sgu_b, bf16* __restrict__ mix, int first, int count) {
    extern __shared__ __attribute__((aligned(16))) unsigned char lds_dyn[];
    bf16 (*vs)[128] = (bf16 (*)[128])lds_dyn;
    const int tid = ltid();
    if ((int)blockIdx.x < first) return;
    for (int item = blockIdx.x - first; item < BATCH * 32 * 4; item += count) {
        const int g = item & 3, n = (item >> 2) & 31, b = item >> 7;
        const size_t m0 = (size_t)b * SEQ + n * 128;
        __syncthreads();
        for (int i = tid; i < 128 * 128; i += NTHREADS) { const int s = i >> 7, c = i & 127; vs[s][c] = VLN[(m0 + s) * 512 + g * 128 + c]; }
        __syncthreads();
        const int c = tid & 127, tq = tid >> 7;
        for (int t = tq * 32; t < tq * 32 + 32; ++t) {
            const float* wr = sgu_w + ((size_t)g * 128 + t) * 128; float acc = 0.f;
            for (int s = 0; s <= t; ++s) acc += wr[s] * bf2f(vs[s][c]);
            const float u = gelu_tanh(bf2f(proj[(m0 + t) * NPROJ + PC_UB + g * 128 + c]));
            mix[(m0 + t) * D_MODEL + 768 + g * 128 + c] = f2bf(u * (acc + sgu_b[g * 128 + t]));
        }
    }
    __syncthreads();
}

__device__ __forceinline__ void ph_nsa_prep(const bf16* __restrict__ proj, const float* __restrict__ qg, const float* __restrict__ kg, bf16* __restrict__ NQ, bf16* __restrict__ NKS, bf16* __restrict__ NKW) {
    const int tid = ltid(); const int lane = tid & 63; const int gw = blockIdx.x * NWAVES + (tid >> 6), ngw = gridDim.x * NWAVES;
    for (int p = gw; p < M * 10; p += ngw) {
        const int m = p / 10, j = p % 10, c0 = lane * 2;
        const int src = j < 6 ? PC_QC + j * 128 : (j < 8 ? PC_KSL + (j - 6) * 128 : PC_KWN + (j - 8) * 128);
        const unsigned pr = *(const unsigned*)(proj + (size_t)m * NPROJ + src + c0);
        float y0 = bf2f((bf16)(pr & 0xffff)), y1 = bf2f((bf16)(pr >> 16));
        float r = rsqrtf(wave_sum(y0 * y0 + y1 * y1) * (1.f / 128.f) + NORM_EPS);
        const float* gn = j < 6 ? qg : kg; if (j < 6) r *= 0.08838834764831845f;
        const unsigned o = pk2(y0 * r * gn[c0], y1 * r * gn[c0 + 1]);
        if (j < 6) *(unsigned*)(NQ + (size_t)m * 768 + j * 128 + c0) = o;
        else if (j < 8) *(unsigned*)(NKS + (size_t)m * 256 + (j - 6) * 128 + c0) = o;
        else *(unsigned*)(NKW + (size_t)m * 256 + (j - 8) * 128 + c0) = o;
    }
}
__device__ __forceinline__ void ph_nsa_compress(const bf16* __restrict__ proj, const float* __restrict__ pos, const float* __restrict__ w1, const float* __restrict__ w2, const float* __restrict__ kg,
                                                bf16* __restrict__ KCB, bf16* __restrict__ VCT) {
    extern __shared__ __attribute__((aligned(16))) unsigned char lds_dyn[];
    bf16 (*tok)[128] = (bf16 (*)[128])lds_dyn;
    float (*posl)[128] = (float (*)[128])(lds_dyn + 144 * 128 * 2);
    float (*hid)[128] = (float (*)[128])(lds_dyn + 144 * 128 * 2 + 32 * 128 * 4);
    float (*red)[2] = (float (*)[2])(lds_dyn + 144 * 128 * 2 + 32 * 128 * 4 + 8 * 128 * 4);
    const int tid = ltid(); const int j = tid & 127, q4 = tid >> 7;
    for (int item = blockIdx.x; item < 1024; item += gridDim.x) {
        const int kv = item & 1, grp = (item >> 1) & 31, g = (item >> 6) & 1, b = item >> 7, n0 = grp * 8;
        const int col = (kv == 0 ? PC_KCC : PC_VCC) + g * 128;
        __syncthreads();
        for (int i = tid; i < 144 * 128; i += NTHREADS) { const int tk = i >> 7, d = i & 127; const int t = 16 * n0 + tk; tok[tk][d] = t < SEQ ? proj[(size_t)(b * SEQ + t) * NPROJ + col + d] : (bf16)0; }
        for (int i = tid; i < 32 * 128; i += NTHREADS) posl[i >> 7][i & 127] = pos[(size_t)kv * 4096 + i];
        __syncthreads();
        float acc0 = 0.f, acc1 = 0.f;
        const float* w1p = w1 + (size_t)kv * 4096 * 128 + j;
        for (int l = 0; l < 32; ++l)
#pragma unroll 4
            for (int d = 0; d < 128; ++d) { const float w = w1p[(size_t)(l * 128 + d) * 128]; const float pp = posl[l][d];
                acc0 += (bf2f(tok[16 * (2 * q4) + l][d]) + pp) * w; acc1 += (bf2f(tok[16 * (2 * q4 + 1) + l][d]) + pp) * w; }
        hid[2 * q4][j] = gelu_tanh(acc0); hid[2 * q4 + 1][j] = gelu_tanh(acc1);
        __syncthreads();
        float out0 = 0.f, out1 = 0.f;
        const float* w2p = w2 + (size_t)kv * 128 * 128 + j;
        for (int i = 0; i < 128; ++i) { const float w = w2p[(size_t)i * 128]; out0 += hid[2 * q4][i] * w; out1 += hid[2 * q4 + 1][i] * w; }
        if (kv == 0) {
            const float s0 = wave_sum(out0 * out0), s1 = wave_sum(out1 * out1);
            if ((tid & 63) == 0) { red[2 * q4][(tid >> 6) & 1] = s0; red[2 * q4 + 1][(tid >> 6) & 1] = s1; }
            __syncthreads();
            out0 *= rsqrtf((red[2 * q4][0] + red[2 * q4][1]) * (1.f / 128.f) + NORM_EPS) * kg[j];
            out1 *= rsqrtf((red[2 * q4 + 1][0] + red[2 * q4 + 1][1]) * (1.f / 128.f) + NORM_EPS) * kg[j];
        }
#pragma unroll
        for (int e = 0; e < 2; ++e) { const int n = n0 + 2 * q4 + e; const float o = n < N_CMP ? (e ? out1 : out0) : 0.f;
            if (kv == 0) KCB[((size_t)(b * 2 + g) * 256 + n) * 128 + j] = f2bf(o);
            else VCT[((size_t)(b * 2 + g) * 128 + j) * 256 + (n & ~15) + ((n & 3) | ((n & 4) << 1) | ((n & 8) >> 1))] = f2bf(o); }
    }
    __syncthreads();
}
__device__ __forceinline__ void ph_nsa_attn(const bf16* __restrict__ NQ, const bf16* __restrict__ NKS, const bf16* __restrict__ NKW, const bf16* __restrict__ proj,
                                            const float* __restrict__ KC, const float* __restrict__ VC, const float* __restrict__ small, const float* __restrict__ rel_bias, bf16* __restrict__ mix, int first, int count) {
    extern __shared__ __attribute__((aligned(16))) unsigned char lds_dyn[];
    const int tid = ltid(); const int lane = tid & 63, wave = tid >> 6;
    if ((int)blockIdx.x < first) return;
    float (*bias_s)[6] = (float (*)[6])(lds_dyn + 8 * 16896);
    __syncthreads();
    for (int i = tid; i < 192; i += NTHREADS) bias_s[i / 6][i % 6] = rel_bias[i];
    __syncthreads();
    float (*qs)[128] = (float (*)[128])(lds_dyn + wave * 16896); float (*pc)[256] = (float (*)[256])(lds_dyn + wave * 16896 + 1536); float (*sc)[1024] = (float (*)[1024])(lds_dyn + wave * 16896 + 4608);
    for (int idx = (blockIdx.x - first) * NWAVES + wave; idx < M * 2; idx += count * NWAVES) {
    const int t = idx & (SEQ - 1), g = (idx >> 12) & 1, b = idx >> 13;
    const size_t m = (size_t)b * SEQ + t;
    for (int i = lane; i < 384; i += 64) qs[i >> 7][i & 127] = bf2f(NQ[m * 768 + g * 384 + i]);
    __builtin_amdgcn_s_waitcnt(0); asm volatile("" ::: "memory");
    const int hb = g * 3;
    float oc[3][2], os[3][2], ow[3][2];
    const int nvalid = t >= 31 ? ((t - 31) >> 4) + 1 : 0;
    {
        float mx[3] = {-3.0e38f, -3.0e38f, -3.0e38f};
        for (int base = 0; base < 256; base += 64) { const int n = base + lane; float s[3] = {-3.0e38f, -3.0e38f, -3.0e38f};
            if (n < nvalid) { const f32x4* kr = (const f32x4*)(KC + ((size_t)(b * 2 + g) * N_CMP + n) * 128); float a0 = 0.f, a1 = 0.f, a2 = 0.f;
#pragma unroll 2
                for (int d = 0; d < 32; ++d) { const f32x4 kk = kr[d]; const f32x4 q0 = *(const f32x4*)&qs[0][4 * d], q1 = *(const f32x4*)&qs[1][4 * d], q2 = *(const f32x4*)&qs[2][4 * d];
                    a0 += kk.x * q0.x + kk.y * q0.y + kk.z * q0.z + kk.w * q0.w; a1 += kk.x * q1.x + kk.y * q1.y + kk.z * q1.z + kk.w * q1.w; a2 += kk.x * q2.x + kk.y * q2.y + kk.z * q2.z + kk.w * q2.w; }
                const int bk = t5_bucket(t - (16 * n + 31)); s[0] = a0 + bias_s[bk][hb]; s[1] = a1 + bias_s[bk][hb + 1]; s[2] = a2 + bias_s[bk][hb + 2]; }
#pragma unroll
            for (int r = 0; r < 3; ++r) { pc[r][n] = s[r]; mx[r] = fmaxf(mx[r], s[r]); } }
#pragma unroll
        for (int r = 0; r < 3; ++r) { mx[r] = wave_max(mx[r]); float sum = 0.f;
            for (int base = 0; base < 256; base += 64) { const int n = base + lane; const float e = n < nvalid ? __expf(pc[r][n] - mx[r]) : 0.f; pc[r][n] = e; sum += e; }
            sum = wave_sum(sum); const float inv = 1.0f / fmaxf(sum, 1e-30f);
            for (int base = 0; base < 256; base += 64) pc[r][base + lane] *= inv; }
        __builtin_amdgcn_s_waitcnt(0); asm volatile("" ::: "memory");
#pragma unroll
        for (int r = 0; r < 3; ++r) { oc[r][0] = 0.f; oc[r][1] = 0.f; }
        for (int n = 0; n < nvalid; ++n) { const f32x2 vv = *(const f32x2*)(VC + ((size_t)(b * 2 + g) * N_CMP + n) * 128 + 2 * lane);
#pragma unroll
            for (int r = 0; r < 3; ++r) { const float p = pc[r][n]; oc[r][0] += p * vv.x; oc[r][1] += p * vv.y; } }
    }
    unsigned long long mask;
    {
        const int j = lane, cur = t >> 6; float imp = 0.f;
        for (int n = 4 * j - 1; n <= 4 * j + 3; ++n) if (n >= 0 && n < N_CMP) imp += pc[0][n] + pc[1][n] + pc[2][n];
        const bool forced = (j == 0) || (j == cur) || (j == cur - 1);
        const float score = forced ? 1e9f : (j <= cur ? imp : -1e30f);
        int rank = 0;
        for (int i = 0; i < 64; ++i) { const float si = __shfl(score, i); rank += (si > score || (si == score && i < j)) ? 1 : 0; }
        mask = __ballot(rank < 16 && j <= cur);
    }
    {
        float mx[3] = {-3.0e38f, -3.0e38f, -3.0e38f}; int slot = 0;
        for (unsigned long long mm = mask; mm; mm &= mm - 1, ++slot) { const int blk = __builtin_ctzll(mm); const int kpos = blk * 64 + lane; float s[3] = {-3.0e38f, -3.0e38f, -3.0e38f};
            if (kpos <= t) { const u32x4* kr = (const u32x4*)(NKS + ((size_t)b * SEQ + kpos) * 256 + g * 128); float a0 = 0.f, a1 = 0.f, a2 = 0.f;
#pragma unroll 2
                for (int d = 0; d < 16; ++d) { const u32x4 kk = kr[d]; const unsigned kw[4] = {kk.x, kk.y, kk.z, kk.w};
#pragma unroll
                    for (int e = 0; e < 4; ++e) { const float k0 = bf2f((bf16)(kw[e] & 0xffff)), k1 = bf2f((bf16)(kw[e] >> 16)); const int dd = 8 * d + 2 * e;
                        a0 += k0 * qs[0][dd] + k1 * qs[0][dd + 1]; a1 += k0 * qs[1][dd] + k1 * qs[1][dd + 1]; a2 += k0 * qs[2][dd] + k1 * qs[2][dd + 1]; } }
                const int bk = t5_bucket(t - kpos); s[0] = a0 + bias_s[bk][hb]; s[1] = a1 + bias_s[bk][hb + 1]; s[2] = a2 + bias_s[bk][hb + 2]; }
#pragma unroll
            for (int r = 0; r < 3; ++r) { sc[r][slot * 64 + lane] = s[r]; mx[r] = fmaxf(mx[r], s[r]); } }
        const int nslot = slot; float inv[3];
#pragma unroll
        for (int r = 0; r < 3; ++r) { mx[r] = wave_max(mx[r]); float sum = 0.f;
            for (int i = lane; i < nslot * 64; i += 64) { const float sv = sc[r][i]; const float e = sv > -1.0e38f ? __expf(sv - mx[r]) : 0.f; sc[r][i] = e; sum += e; }
            sum = wave_sum(sum); inv[r] = 1.0f / fmaxf(sum, 1e-30f); }
        __builtin_amdgcn_s_waitcnt(0); asm volatile("" ::: "memory");
#pragma unroll
        for (int r = 0; r < 3; ++r) { os[r][0] = 0.f; os[r][1] = 0.f; }
        slot = 0;
        for (unsigned long long mm = mask; mm; mm &= mm - 1, ++slot) { const int blk = __builtin_ctzll(mm); const int kmax = (t - blk * 64) < 63 ? (t - blk * 64) : 63;
            for (int kk = 0; kk <= kmax; ++kk) { const unsigned vv = *(const unsigned*)(proj + ((size_t)b * SEQ + blk * 64 + kk) * NPROJ + PC_VSL + g * 128 + 2 * lane);
                const float v0 = bf2f((bf16)(vv & 0xffff)), v1 = bf2f((bf16)(vv >> 16));
#pragma unroll
                for (int r = 0; r < 3; ++r) { const float p = sc[r][slot * 64 + kk]; os[r][0] += p * v0; os[r][1] += p * v1; } } }
#pragma unroll
        for (int r = 0; r < 3; ++r) { os[r][0] *= inv[r]; os[r][1] *= inv[r]; }
    }
    {
        const int lo = t - 511 > 0 ? t - 511 : 0, nk = t - lo + 1; float mx[3] = {-3.0e38f, -3.0e38f, -3.0e38f};
        for (int base = 0; base < nk; base += 64) { const int kpos = lo + base + lane; float s[3] = {-3.0e38f, -3.0e38f, -3.0e38f};
            if (kpos <= t) { const u32x4* kr = (const u32x4*)(NKW + ((size_t)b * SEQ + kpos) * 256 + g * 128); float a0 = 0.f, a1 = 0.f, a2 = 0.f;
#pragma unroll 2
                for (int d = 0; d < 16; ++d) { const u32x4 kk = kr[d]; const unsigned kw[4] = {kk.x, kk.y, kk.z, kk.w};
#pragma unroll
                    for (int e = 0; e < 4; ++e) { const float k0 = bf2f((bf16)(kw[e] & 0xffff)), k1 = bf2f((bf16)(kw[e] >> 16)); const int dd = 8 * d + 2 * e;
                        a0 += k0 * qs[0][dd] + k1 * qs[0][dd + 1]; a1 += k0 * qs[1][dd] + k1 * qs[1][dd + 1]; a2 += k0 * qs[2][dd] + k1 * qs[2][dd + 1]; } }
                const int bk = t5_bucket(t - kpos); s[0] = a0 + bias_s[bk][hb]; s[1] = a1 + bias_s[bk][hb + 1]; s[2] = a2 + bias_s[bk][hb + 2]; }
#pragma unroll
            for (int r = 0; r < 3; ++r) { sc[r][base + lane] = s[r]; mx[r] = fmaxf(mx[r], s[r]); } }
        const int ntot = (nk + 63) & ~63; float inv[3];
#pragma unroll
        for (int r = 0; r < 3; ++r) { mx[r] = wave_max(mx[r]); float sum = 0.f;
            for (int i = lane; i < ntot; i += 64) { const float sv = sc[r][i]; const float e = sv > -1.0e38f ? __expf(sv - mx[r]) : 0.f; sc[r][i] = e; sum += e; }
            sum = wave_sum(sum); inv[r] = 1.0f / fmaxf(sum, 1e-30f); }
        __builtin_amdgcn_s_waitcnt(0); asm volatile("" ::: "memory");
#pragma unroll
        for (int r = 0; r < 3; ++r) { ow[r][0] = 0.f; ow[r][1] = 0.f; }
        for (int kk = 0; kk < nk; ++kk) { const unsigned vv = *(const unsigned*)(proj + ((size_t)b * SEQ + lo + kk) * NPROJ + PC_VWN + g * 128 + 2 * lane);
            const float v0 = bf2f((bf16)(vv & 0xffff)), v1 = bf2f((bf16)(vv >> 16));
#pragma unroll
            for (int r = 0; r < 3; ++r) { const float p = sc[r][kk]; ow[r][0] += p * v0; ow[r][1] += p * v1; } }
#pragma unroll
        for (int r = 0; r < 3; ++r) { ow[r][0] *= inv[r]; ow[r][1] *= inv[r]; }
    }
#pragma unroll
    for (int r = 0; r < 3; ++r) { const float* gp = small + m * 32 + SM_GC + hb + r;
        const float g0 = sigmoidf_(gp[0]), g1 = sigmoidf_(gp[6]), g2 = sigmoidf_(gp[12]);
        *(unsigned*)(mix + m * D_MODEL + 1280 + (hb + r) * 128 + 2 * lane) = pk2(g0 * oc[r][0] + g1 * os[r][0] + g2 * ow[r][0], g0 * oc[r][1] + g1 * os[r][1] + g2 * ow[r][1]); }
    }
    __syncthreads();
}

typedef short bf16x8 __attribute__((ext_vector_type(8)));
typedef float f32x16 __attribute__((ext_vector_type(16)));
typedef __bf16 bf16x2_t __attribute__((ext_vector_type(2)));
#define MFMA32(a, b, c) __builtin_amdgcn_mfma_f32_32x32x16_bf16((a), (b), (c), 0, 0, 0)
constexpr float LOG2E = 1.4426950408889634f, LN2 = 0.6931471805599453f;
__device__ __forceinline__ unsigned cvt2(float lo, float hi) { f32x2 v = {lo, hi}; return __builtin_bit_cast(unsigned, __builtin_convertvector(v, bf16x2_t)); }
__device__ __forceinline__ int perm16(int k) { return (k & 3) | ((k & 4) << 1) | ((k & 8) >> 1); }
__device__ __forceinline__ bf16x8 ld_frag(const bf16* p) { return __builtin_bit_cast(bf16x8, *(const u32x4*)p); }

__device__ __forceinline__ void ph_nsa_prep2(const bf16* __restrict__ proj, const float* __restrict__ qg, const float* __restrict__ kg, bf16* __restrict__ NQ, bf16* __restrict__ KS, bf16* __restrict__ KW,
                                             bf16* __restrict__ VST, bf16* __restrict__ VWT) {
    const int tid = ltid(); const int lane = tid & 63; const int gw = blockIdx.x * NWAVES + (tid >> 6), ngw = gridDim.x * NWAVES;
    {
        const int c0 = (lane & 15) * 8;
        const f32x4 qg0 = *(const f32x4*)(qg + c0), qg1 = *(const f32x4*)(qg + c0 + 4), kg0 = *(const f32x4*)(kg + c0), kg1 = *(const f32x4*)(kg + c0 + 4);
        const int pstep = ngw * 4;
        for (int p0 = gw * 4 + (lane >> 4); p0 < M * 10; p0 += 4 * pstep) {
            u32x4 prr[4];
#pragma unroll
            for (int k = 0; k < 4; ++k) { const int p = p0 + k * pstep; const int pc = p < M * 10 ? p : p0; const int m = pc / 10, j = pc % 10;
                const int src = j < 6 ? PC_QC + j * 128 : (j < 8 ? PC_KSL + (j - 6) * 128 : PC_KWN + (j - 8) * 128);
                prr[k] = *(const u32x4*)(proj + (size_t)m * NPROJ + src + c0); }
#pragma unroll
            for (int k = 0; k < 4; ++k) { const int p = p0 + k * pstep;
                if (p < M * 10) {
                    const int m = p / 10, j = p % 10;
                    const unsigned pw[4] = {prr[k].x, prr[k].y, prr[k].z, prr[k].w};
                    float y[8]; float ss = 0.f;
#pragma unroll
                    for (int e = 0; e < 4; ++e) { y[2 * e] = bf2f((bf16)(pw[e] & 0xffff)); y[2 * e + 1] = bf2f((bf16)(pw[e] >> 16)); ss += y[2 * e] * y[2 * e] + y[2 * e + 1] * y[2 * e + 1]; }
                    float r = rsqrtf(row16_sum(ss) * (1.f / 128.f) + NORM_EPS);
                    if (j < 6) r *= 0.08838834764831845f * LOG2E;
                    const f32x4 g0 = j < 6 ? qg0 : kg0, g1 = j < 6 ? qg1 : kg1;
                    u32x4 o; o.x = cvt2(y[0] * r * g0.x, y[1] * r * g0.y); o.y = cvt2(y[2] * r * g0.z, y[3] * r * g0.w); o.z = cvt2(y[4] * r * g1.x, y[5] * r * g1.y); o.w = cvt2(y[6] * r * g1.z, y[7] * r * g1.w);
                    const int b = m >> 12, t = m & (SEQ - 1);
                    if (j < 6) *(u32x4*)(NQ + (size_t)m * 768 + j * 128 + c0) = o;
                    else if (j < 8) *(u32x4*)(KS + ((size_t)(b * 2 + (j - 6)) * SEQ + t) * 128 + c0) = o;
                    else *(u32x4*)(KW + ((size_t)(b * 2 + (j - 8)) * SEQ + t) * 128 + c0) = o;
                } }
        }
    }
    for (int task = gw; task < BATCH * 2 * 2 * 64; task += ngw) {
        const int tile = task & 63, which = (task >> 6) & 1, g = (task >> 7) & 1, b = task >> 8;
        const int t = tile * 64 + lane;
        const bf16* src = proj + (size_t)(b * SEQ + t) * NPROJ + (which ? PC_VWN : PC_VSL) + g * 128;
        bf16* dst = (which ? VWT : VST) + (size_t)(b * 2 + g) * 128 * SEQ + (t & ~15) + perm16(t & 15);
        u32x4 vv[16];
#pragma unroll
        for (int c = 0; c < 16; ++c) vv[c] = *(const u32x4*)(src + 8 * c);
#pragma unroll
        for (int c = 0; c < 16; ++c) { const unsigned w[4] = {vv[c].x, vv[c].y, vv[c].z, vv[c].w};
#pragma unroll
            for (int e = 0; e < 4; ++e) { dst[(size_t)(8 * c + 2 * e) * SEQ] = (bf16)(w[e] & 0xffff); dst[(size_t)(8 * c + 2 * e + 1) * SEQ] = (bf16)(w[e] >> 16); } }
    }
}

__device__ __forceinline__ void ph_nsa_select_naive(const bf16* __restrict__ NQ, const float* __restrict__ KC, const float* __restrict__ VC, const float* __restrict__ small, const float* __restrict__ rel_bias,
                                                    unsigned long long* __restrict__ SELM, bf16* __restrict__ OC) {
    extern __shared__ __attribute__((aligned(16))) unsigned char lds_dyn[];
    const int tid = ltid(); const int lane = tid & 63, wave = tid >> 6;
    float (*bias_s)[6] = (float (*)[6])(lds_dyn + 8 * 4608);
    __syncthreads();
    for (int i = tid; i < 192; i += NTHREADS) bias_s[i / 6][i % 6] = rel_bias[i];
    __syncthreads();
    float (*qs)[128] = (float (*)[128])(lds_dyn + wave * 4608); float (*pc)[256] = (float (*)[256])(lds_dyn + wave * 4608 + 1536);
    for (int idx = blockIdx.x * NWAVES + wave; idx < M * 2; idx += gridDim.x * NWAVES) {
        const int t = idx & (SEQ - 1), g = (idx >> 12) & 1, b = idx >> 13;
        const size_t m = (size_t)b * SEQ + t;
        for (int i = lane; i < 384; i += 64) qs[i >> 7][i & 127] = bf2f(NQ[m * 768 + g * 384 + i]) * LN2;
        __builtin_amdgcn_s_waitcnt(0); asm volatile("" ::: "memory");
        const int hb = g * 3;
        float oc[3][2];
        const int nvalid = t >= 31 ? ((t - 31) >> 4) + 1 : 0;
        float mx[3] = {-3.0e38f, -3.0e38f, -3.0e38f};
        for (int base = 0; base < 256; base += 64) { const int n = base + lane; float s[3] = {-3.0e38f, -3.0e38f, -3.0e38f};
            if (n < nvalid) { const f32x4* kr = (const f32x4*)(KC + ((size_t)(b * 2 + g) * N_CMP + n) * 128); float a0 = 0.f, a1 = 0.f, a2 = 0.f;
#pragma unroll 2
                for (int d = 0; d < 32; ++d) { const f32x4 kk = kr[d]; const f32x4 q0 = *(const f32x4*)&qs[0][4 * d], q1 = *(const f32x4*)&qs[1][4 * d], q2 = *(const f32x4*)&qs[2][4 * d];
                    a0 += kk.x * q0.x + kk.y * q0.y + kk.z * q0.z + kk.w * q0.w; a1 += kk.x * q1.x + kk.y * q1.y + kk.z * q1.z + kk.w * q1.w; a2 += kk.x * q2.x + kk.y * q2.y + kk.z * q2.z + kk.w * q2.w; }
                const int bk = t5_bucket(t - (16 * n + 31)); s[0] = a0 + bias_s[bk][hb]; s[1] = a1 + bias_s[bk][hb + 1]; s[2] = a2 + bias_s[bk][hb + 2]; }
#pragma unroll
            for (int r = 0; r < 3; ++r) { pc[r][n] = s[r]; mx[r] = fmaxf(mx[r], s[r]); } }
#pragma unroll
        for (int r = 0; r < 3; ++r) { mx[r] = wave_max(mx[r]); float sum = 0.f;
            for (int base = 0; base < 256; base += 64) { const int n = base + lane; const float e = n < nvalid ? __expf(pc[r][n] - mx[r]) : 0.f; pc[r][n] = e; sum += e; }
            sum = wave_sum(sum); const float inv = 1.0f / fmaxf(sum, 1e-30f);
            for (int base = 0; base < 256; base += 64) pc[r][base + lane] *= inv; }
        __builtin_amdgcn_s_waitcnt(0); asm volatile("" ::: "memory");
#pragma unroll
        for (int r = 0; r < 3; ++r) { oc[r][0] = 0.f; oc[r][1] = 0.f; }
        for (int n = 0; n < nvalid; ++n) { const f32x2 vv = *(const f32x2*)(VC + ((size_t)(b * 2 + g) * N_CMP + n) * 128 + 2 * lane);
#pragma unroll
            for (int r = 0; r < 3; ++r) { const float p = pc[r][n]; oc[r][0] += p * vv.x; oc[r][1] += p * vv.y; } }
        { const int j = lane, cur = t >> 6; float imp = 0.f;
          for (int n = 4 * j - 1; n <= 4 * j + 3; ++n) if (n >= 0 && n < N_CMP) imp += pc[0][n] + pc[1][n] + pc[2][n];
          const bool forced = (j == 0) || (j == cur) || (j == cur - 1);
          const float score = forced ? 1e9f : (j <= cur ? imp : -1e30f);
          int rank = 0;
          for (int i = 0; i < 64; ++i) { const float si = __shfl(score, i); rank += (si > score || (si == score && i < j)) ? 1 : 0; }
          const unsigned long long mask = __ballot(rank < 16 && j <= cur);
          if (lane == 0) SELM[(size_t)(b * 2 + g) * SEQ + t] = mask; }
#pragma unroll
        for (int r = 0; r < 3; ++r) { const float g0 = sigmoidf_(small[m * 32 + SM_GC + hb + r]);
            *(unsigned*)(OC + m * D_MODEL + 1280 + (hb + r) * 128 + 2 * lane) = cvt2(g0 * oc[r][0], g0 * oc[r][1]); }
    }
    __syncthreads();
}

constexpr int ATT_BUF = 32768, ATT_NBUF = 3;
constexpr int ATT_NEXT = 328, ATT_EOFF = 224;
constexpr int ATT_BTAB = ATT_NBUF * ATT_BUF, ATT_QW = ATT_BTAB + 4 * ATT_NEXT * 4;
#define ATT_SB() __builtin_amdgcn_sched_barrier(0)
#define ATT_BAR() asm volatile("s_waitcnt lgkmcnt(0)\n\ts_barrier" ::: "memory")
template <int MODE, int KIND> __device__ __forceinline__ void attn_tile(const LAS unsigned char* fq, const LAS unsigned char* tb, float msk, int dlim, const bf16x8 (&qf)[8], f32x16 (&O)[4], float& lsum) {
#define ATT_KF(kk_, s_) (*(const LAS u32x4*)(fq + ((kk_) * 8 + (s_)) * 1024))
#define ATT_VF(dt_, c_) (*(const LAS u32x4*)(fq + 16384 + ((dt_) * 4 + (c_)) * 1024))
#define ATT_BF(x_) __builtin_bit_cast(bf16x8, x_)
#define ATT_EXP(S_, half_, pb_) do { \
        if (KIND == 3 && dlim != 0) { _Pragma("unroll") for (int gq = 0; gq < 4; ++gq) { const f32x4 bv = *(const LAS f32x4*)(tb + 4 * (8 * gq + 32 * (half_))); \
            S_[4 * gq] += bv[0]; S_[4 * gq + 1] += bv[1]; S_[4 * gq + 2] += bv[2]; S_[4 * gq + 3] += bv[3]; } }     \
        _Pragma("unroll") for (int i = 0; i < 16; ++i) { float e = __builtin_amdgcn_exp2f(S_[i]); \
            if (KIND == 2) e = ((i & 3) + 8 * (i >> 2) + 32 * (half_) > dlim) ? e : 0.f; \
            if (MODE == 0) e *= msk; \
            S_[i] = e; lsum += e; } \
        _Pragma("unroll") for (int s2 = 0; s2 < 2; ++s2) { u32x4 w; w.x = cvt2(S_[8 * s2], S_[8 * s2 + 1]); w.y = cvt2(S_[8 * s2 + 2], S_[8 * s2 + 3]); w.z = cvt2(S_[8 * s2 + 4], S_[8 * s2 + 5]); w.w = cvt2(S_[8 * s2 + 6], S_[8 * s2 + 7]); pb_[s2] = ATT_BF(w); } } while (0)
#define ATT_SINIT(S_, half_) do { if (KIND == 1) { _Pragma("unroll") for (int gq = 0; gq < 4; ++gq) { const f32x4 bv = *(const LAS f32x4*)(tb + 4 * (8 * gq + 32 * (half_))); \
            S_[4 * gq] = bv[0]; S_[4 * gq + 1] = bv[1]; S_[4 * gq + 2] = bv[2]; S_[4 * gq + 3] = bv[3]; } } else { _Pragma("unroll") for (int i = 0; i < 16; ++i) S_[i] = 0.f; } } while (0)
    u32x4 fa[4], fb[4]; f32x16 S0, S1; bf16x8 pb0[2], pb1[2];
    ATT_SINIT(S0, 0);
#pragma unroll
    for (int s = 0; s < 4; ++s) fa[s] = ATT_KF(0, s);
    ATT_SB();
#pragma unroll
    for (int s = 0; s < 4; ++s) fb[s] = ATT_KF(0, 4 + s);
#pragma unroll
    for (int s = 0; s < 4; ++s) S0 = MFMA32(ATT_BF(fa[s]), qf[s], S0);
    ATT_SB();
#pragma unroll
    for (int s = 0; s < 4; ++s) fa[s] = ATT_KF(1, s);
    ATT_SINIT(S1, 1);
#pragma unroll
    for (int s = 0; s < 4; ++s) S0 = MFMA32(ATT_BF(fb[s]), qf[4 + s], S0);
    ATT_SB();
#pragma unroll
    for (int s = 0; s < 4; ++s) fb[s] = ATT_KF(1, 4 + s);
#pragma unroll
    for (int s = 0; s < 4; ++s) S1 = MFMA32(ATT_BF(fa[s]), qf[s], S1);
    ATT_SB();
    fa[0] = ATT_VF(0, 0); fa[1] = ATT_VF(0, 1); fa[2] = ATT_VF(1, 0); fa[3] = ATT_VF(1, 1);
#pragma unroll
    for (int s = 0; s < 4; ++s) S1 = MFMA32(ATT_BF(fb[s]), qf[4 + s], S1);
    ATT_EXP(S0, 0, pb0);
    ATT_SB();
    fb[0] = ATT_VF(2, 0); fb[1] = ATT_VF(2, 1); fb[2] = ATT_VF(3, 0); fb[3] = ATT_VF(3, 1);
    O[0] = MFMA32(ATT_BF(fa[0]), pb0[0], O[0]); O[0] = MFMA32(ATT_BF(fa[1]), pb0[1], O[0]); O[1] = MFMA32(ATT_BF(fa[2]), pb0[0], O[1]); O[1] = MFMA32(ATT_BF(fa[3]), pb0[1], O[1]);
    ATT_EXP(S1, 1, pb1);
    ATT_SB();
    fa[0] = ATT_VF(0, 2); fa[1] = ATT_VF(0, 3); fa[2] = ATT_VF(1, 2); fa[3] = ATT_VF(1, 3);
    O[2] = MFMA32(ATT_BF(fb[0]), pb0[0], O[2]); O[2] = MFMA32(ATT_BF(fb[1]), pb0[1], O[2]); O[3] = MFMA32(ATT_BF(fb[2]), pb0[0], O[3]); O[3] = MFMA32(ATT_BF(fb[3]), pb0[1], O[3]);
    ATT_SB();
    fb[0] = ATT_VF(2, 2); fb[1] = ATT_VF(2, 3); fb[2] = ATT_VF(3, 2); fb[3] = ATT_VF(3, 3);
    O[0] = MFMA32(ATT_BF(fa[0]), pb1[0], O[0]); O[0] = MFMA32(ATT_BF(fa[1]), pb1[1], O[0]); O[1] = MFMA32(ATT_BF(fa[2]), pb1[0], O[1]); O[1] = MFMA32(ATT_BF(fa[3]), pb1[1], O[1]);
    ATT_SB();
    O[2] = MFMA32(ATT_BF(fb[0]), pb1[0], O[2]); O[2] = MFMA32(ATT_BF(fb[1]), pb1[1], O[2]); O[3] = MFMA32(ATT_BF(fb[2]), pb1[0], O[3]); O[3] = MFMA32(ATT_BF(fb[3]), pb1[1], O[3]);
    ATT_SB();
#undef ATT_KF
#undef ATT_VF
#undef ATT_BF
#undef ATT_EXP
#undef ATT_SINIT
}
template <int MODE> __device__ __forceinline__ void attn_branch(const bf16* __restrict__ Kbase, const bf16* __restrict__ VTbase, int kt_lo, int kt_hi, int tq0, int t, int h, int q, int tid, int wave,
                                                                unsigned long long selmask, const bf16x8 (&qf)[8], f32x16 (&O)[4], float& lsum) {
    extern __shared__ __attribute__((aligned(16))) unsigned char lds_dyn[];
    LAS unsigned char* ldsl = (LAS unsigned char*)lds_dyn;
    const unsigned kvo = (unsigned)(q * 256 + h * 16), vvo = (unsigned)(q * (SEQ * 2) + h * 16);
    auto dma = [&](int kt, int buf) {
        const char* kg = (const char*)Kbase + (size_t)kt * (64 * 128 * 2); const char* vg = (const char*)VTbase + kt * 128;
#pragma unroll
        for (int i = 0; i < 2; ++i) { const int n = 2 * wave + i;
            __builtin_amdgcn_global_load_lds((const unsigned*)(kg + ((n >> 3) * 8192 + (n & 7) * 32) + kvo), (LAS unsigned*)(ldsl + buf * ATT_BUF + n * 1024), 16, 0, 0);
            __builtin_amdgcn_global_load_lds((const unsigned*)(vg + ((size_t)(n >> 2) * (32 * SEQ * 2) + (n & 3) * 32) + vvo), (LAS unsigned*)(ldsl + buf * ATT_BUF + 16384 + n * 1024), 16, 0, 0); } };
    const int lane16 = (h * 32 + q) * 16;
    const int tlane = ATT_BTAB + ((0 - q) & 3) * (ATT_NEXT * 4) + 4 * (ATT_EOFF - ((0 - q) & 3));
    ATT_BAR();
    dma(kt_lo, 0);
    if (kt_lo < kt_hi) { dma(kt_lo + 1, 1); asm volatile("s_waitcnt vmcnt(4)" ::: "memory"); } else asm volatile("s_waitcnt vmcnt(0)" ::: "memory");
    ATT_BAR();
    int buf = 0;
    for (int kt = kt_lo; kt <= kt_hi; ++kt) {
        const bool more = kt + 2 <= kt_hi;
        if (more) dma(kt + 2, buf == 0 ? 2 : buf - 1);
        bool need = 64 * kt <= tq0 + 31;
        if (MODE == 1) need = need && (64 * kt + 63 >= tq0 - 511);
        const bool sel = MODE == 0 ? ((selmask >> kt) & 1ull) != 0ull : true;
        if (need && (MODE == 1 || __ballot(sel) != 0ull)) {
            const LAS unsigned char* fq = ldsl + buf * ATT_BUF + lane16;
            const int mind = tq0 - (64 * kt + 63), maxd = tq0 + 31 - 64 * kt;
            const float msk = sel ? 1.f : 0.f;
            const int d0 = t - 64 * kt - 4 * h;
            if (MODE == 0) {
                const int nearf = __builtin_amdgcn_readfirstlane(mind < 128 ? 1 : 0);
                attn_tile<MODE, 3>(fq, ldsl + tlane - 4 * d0, msk, nearf, qf, O, lsum);
            } else if (mind >= 128) {
                if (maxd <= 511) attn_tile<MODE, 0>(fq, ldsl, msk, 0, qf, O, lsum);
                else attn_tile<MODE, 2>(fq, ldsl, msk, d0 - 512, qf, O, lsum);
            } else attn_tile<MODE, 1>(fq, ldsl + tlane - 4 * d0, msk, 0, qf, O, lsum);
        }
        if (more) asm volatile("s_waitcnt vmcnt(4)" ::: "memory"); else asm volatile("s_waitcnt vmcnt(0)" ::: "memory");
        ATT_BAR();
        buf = buf == 2 ? 0 : buf + 1;
    }
}
__device__ __forceinline__ void ph_nsa_main(const bf16* __restrict__ NQ, const bf16* __restrict__ KS, const bf16* __restrict__ KW, const bf16* __restrict__ VST, const bf16* __restrict__ VWT,
                                            const unsigned long long* __restrict__ SELM, const bf16* __restrict__ OC, const float* __restrict__ small, const float* __restrict__ rel_bias, bf16* __restrict__ mix,
                                            unsigned* __restrict__ queue) {
    extern __shared__ __attribute__((aligned(16))) unsigned char lds_dyn[];
    float* btab = (float*)(lds_dyn + ATT_BTAB); volatile unsigned* qw = (volatile unsigned*)(lds_dyn + ATT_QW);
    for (;;) {
        const int tid = ltid();
        const int lane = tid & 63, wave = __builtin_amdgcn_readfirstlane(tid >> 6), q = lane & 31, h = lane >> 5;
        __syncthreads();
        if (tid == 0) *qw = __hip_atomic_fetch_add(queue, 1u, __ATOMIC_RELAXED, __HIP_MEMORY_SCOPE_AGENT);
        __syncthreads();
        const int u = __builtin_amdgcn_readfirstlane((int)*qw);
        if (u >= 768) break;
        const int qb = 15 - u / 48, rem = u % 48, r = rem % 3, bg = rem / 3, g = bg & 1, b = bg >> 1, head = g * 3 + r;
        { const float bfar = rel_bias[t5_bucket(127) * 6 + head];
          for (int e = tid; e < 4 * ATT_NEXT; e += NTHREADS) { const int c = e / ATT_NEXT, dist = ATT_EOFF - (e - c * ATT_NEXT) - c;
              btab[e] = dist < 0 ? -1e30f : (rel_bias[t5_bucket(dist > 127 ? 127 : dist) * 6 + head] - bfar) * LOG2E; } }
        const int t0 = qb * 256, tq0 = t0 + 32 * wave, t = tq0 + q; const size_t m = (size_t)b * SEQ + t;
        bf16x8 qf[8];
#pragma unroll
        for (int s = 0; s < 8; ++s) qf[s] = ld_frag(NQ + m * 768 + head * 128 + 16 * s + 8 * h);
        const unsigned long long selmask = SELM[(size_t)(b * 2 + g) * SEQ + t];
        f32x16 O[4]; float lsum = 0.f;
#pragma unroll
        for (int dt = 0; dt < 4; ++dt)
#pragma unroll
            for (int i = 0; i < 16; ++i) O[dt][i] = 0.f;
        attn_branch<0>(KS + (size_t)(b * 2 + g) * SEQ * 128, VST + (size_t)(b * 2 + g) * 128 * SEQ, 0, 4 * qb + 3, tq0, t, h, q, tid, wave, selmask, qf, O, lsum);
        { const float l = lsum + __shfl_xor(lsum, 32); const float sc = sigmoidf_(small[m * 32 + SM_GC + 6 + head]) / l;
#pragma unroll
          for (int dt = 0; dt < 4; ++dt)
#pragma unroll
              for (int gq = 0; gq < 4; ++gq) { const int d = 32 * dt + 8 * gq + 4 * h;
                  const u32x2 ocv = *(const u32x2*)(mix + m * D_MODEL + 1280 + head * 128 + d);
                  u32x2 w; w.x = cvt2(O[dt][4 * gq] * sc + bf2f((bf16)(ocv.x & 0xffff)), O[dt][4 * gq + 1] * sc + bf2f((bf16)(ocv.x >> 16)));
                  w.y = cvt2(O[dt][4 * gq + 2] * sc + bf2f((bf16)(ocv.y & 0xffff)), O[dt][4 * gq + 3] * sc + bf2f((bf16)(ocv.y >> 16)));
                  *(u32x2*)(mix + m * D_MODEL + 1280 + head * 128 + d) = w; }
#pragma unroll
          for (int dt = 0; dt < 4; ++dt)
#pragma unroll
              for (int i = 0; i < 16; ++i) O[dt][i] = 0.f; }
        lsum = 0.f;
        { const int lo = t0 - 512 > 0 ? (t0 - 512) >> 6 : 0;
          attn_branch<1>(KW + (size_t)(b * 2 + g) * SEQ * 128, VWT + (size_t)(b * 2 + g) * 128 * SEQ, lo, (t0 + 255) >> 6, tq0, t, h, q, tid, wave, 0ull, qf, O, lsum); }
        { const float l = lsum + __shfl_xor(lsum, 32); const float sc = sigmoidf_(small[m * 32 + SM_GC + 12 + head]) / l;
#pragma unroll
          for (int dt = 0; dt < 4; ++dt)
#pragma unroll
              for (int gq = 0; gq < 4; ++gq) { const int d = 32 * dt + 8 * gq + 4 * h;
                  u32x2* mp = (u32x2*)(mix + m * D_MODEL + 1280 + head * 128 + d); const u32x2 pv = *mp;
                  u32x2 w; w.x = cvt2(O[dt][4 * gq] * sc + bf2f((bf16)(pv.x & 0xffff)), O[dt][4 * gq + 1] * sc + bf2f((bf16)(pv.x >> 16)));
                  w.y = cvt2(O[dt][4 * gq + 2] * sc + bf2f((bf16)(pv.y & 0xffff)), O[dt][4 * gq + 3] * sc + bf2f((bf16)(pv.y >> 16)));
                  *mp = w; } }
    }
    __syncthreads();
}

constexpr int SL_KSTR = 272, SL_VSTR = 528;
constexpr int SL_K = 0, SL_V = 256 * SL_KSTR, SL_BT = SL_V + 128 * SL_VSTR;
static_assert(SL_BT + 3072 <= LDS_MISC, "selection phase LDS");
__device__ __forceinline__ void ph_nsa_select_fast(const bf16* __restrict__ NQ, const bf16* __restrict__ KCB, const bf16* __restrict__ VCT, const float* __restrict__ small, const float* __restrict__ rel_bias,
                                                   unsigned long long* __restrict__ SELM, bf16* __restrict__ mix) {
    extern __shared__ __attribute__((aligned(16))) unsigned char lds_dyn[];
    const int tid = ltid(); const int lane = tid & 63, wave = tid >> 6, q = lane & 31, h = lane >> 5;
    float* btab = (float*)(lds_dyn + SL_BT);
    __syncthreads();
    for (int i = tid; i < 768; i += NTHREADS) btab[i] = (rel_bias[t5_bucket(i & 127) * 6 + (i >> 7)] - rel_bias[t5_bucket(127) * 6 + (i >> 7)]) * LOG2E;
    for (int item = blockIdx.x; item < BATCH * 2 * 16; item += gridDim.x) {
        const int qb = item & 15, g = (item >> 4) & 1, b = item >> 5;
        const int qt = 8 * qb + wave, t0 = 32 * qt, t = t0 + q; const size_t m = (size_t)b * SEQ + t;
        const int nv = t >= 31 ? ((t - 31) >> 4) + 1 : 0;
        const int ntile = (qt + 16) >> 4;
        const int nt_blk = (8 * qb + 7 + 16) >> 4;
        const int t0u = __builtin_amdgcn_readfirstlane(t0);
        {
          const bf16* Kb = KCB + (size_t)(b * 2 + g) * 256 * 128; const bf16* Vb = VCT + (size_t)(b * 2 + g) * 128 * 256;
          __syncthreads();
          const int vch = nt_blk * 4;
          const int nbu = __builtin_amdgcn_readfirstlane(nt_blk);
          u32x4 kr[8], vr[8];
#pragma unroll
          for (int i = 0; i < 8; ++i) { const int c = tid + NTHREADS * (i < nbu ? i : 0); kr[i] = *(const u32x4*)(Kb + (size_t)c * 8);
              const int d = c / vch, part = c - d * vch; vr[i] = *(const u32x4*)(Vb + (size_t)d * 256 + part * 8); }
#pragma unroll
          for (int i = 0; i < 8; ++i) if (i < nbu) { const int c = tid + NTHREADS * i; *(u32x4*)(lds_dyn + SL_K + (c >> 4) * SL_KSTR + (c & 15) * 16) = kr[i];
              const int d = c / vch, part = c - d * vch; *(u32x4*)(lds_dyn + SL_V + d * SL_VSTR + part * 16) = vr[i]; }
          __syncthreads(); }
        float imp[32];
#pragma unroll
        for (int i = 0; i < 32; ++i) imp[i] = 0.f;
#pragma unroll 1
        for (int r = 0; r < 3; ++r) {
            const int head = g * 3 + r;
            int h_ = h, t_ = t, q_ = q; asm volatile("" : "+v"(h_), "+v"(t_), "+v"(q_));
            bf16x8 qf[8];
#pragma unroll
            for (int s = 0; s < 8; ++s) qf[s] = ld_frag(NQ + m * 768 + head * 128 + 16 * s + 8 * h_);
            const float* bt = btab + head * 128;
            const unsigned char* kl = lds_dyn + SL_K + q_ * SL_KSTR + 16 * h_; const unsigned char* vl = lds_dyn + SL_V + q_ * SL_VSTR + 16 * h_;
            f32x16 O[4]; float Uacc[32]; float lsum = 0.f, carry = 0.f;
#pragma unroll
            for (int dt = 0; dt < 4; ++dt)
#pragma unroll
                for (int i = 0; i < 16; ++i) O[dt][i] = 0.f;
#pragma unroll
            for (int i = 0; i < 32; ++i) Uacc[i] = 0.f;
#pragma unroll
            for (int kk = 0; kk < 8; ++kk) {
                if (kk < ntile) {
                    f32x16 S;
#pragma unroll
                    for (int i = 0; i < 16; ++i) S[i] = 0.f;
#pragma unroll
                    for (int s = 0; s < 8; ++s) S = MFMA32(__builtin_bit_cast(bf16x8, *(const u32x4*)(kl + kk * 32 * SL_KSTR + 32 * s)), qf[s], S);
                    float p[16];
                    if (512 * kk + 655 <= t0u) {
#pragma unroll
                        for (int i = 0; i < 16; ++i) { p[i] = __builtin_amdgcn_exp2f(S[i]); lsum += p[i]; }
                    } else {
#pragma unroll
                    for (int i = 0; i < 16; ++i) { const int n = 32 * kk + (i & 3) + 8 * (i >> 2) + 4 * h_; const int dist = t_ - 16 * n - 31;
                        const int bi = dist < 0 ? 0 : (dist > 127 ? 127 : dist);
                        const float e = __builtin_amdgcn_exp2f(S[i] + bt[bi]); p[i] = n < nv ? e : 0.f; lsum += p[i]; }
                    }
                    float G[4], Lp[4];
#pragma unroll
                    for (int gq = 0; gq < 4; ++gq) { G[gq] = (p[4 * gq] + p[4 * gq + 1]) + (p[4 * gq + 2] + p[4 * gq + 3]); Lp[gq] = __shfl_xor(p[4 * gq + 3], 32); }
#pragma unroll
                    for (int gq = 0; gq < 4; ++gq) { const float prev = gq > 0 ? Lp[gq > 0 ? gq - 1 : 0] : carry; Uacc[4 * kk + gq] += G[gq] + (h_ ? Lp[gq] : prev); }
                    carry = Lp[3];
#pragma unroll
                    for (int s2 = 0; s2 < 2; ++s2) { u32x4 w; w.x = cvt2(p[8 * s2], p[8 * s2 + 1]); w.y = cvt2(p[8 * s2 + 2], p[8 * s2 + 3]); w.z = cvt2(p[8 * s2 + 4], p[8 * s2 + 5]); w.w = cvt2(p[8 * s2 + 6], p[8 * s2 + 7]);
                        const bf16x8 pb = __builtin_bit_cast(bf16x8, w);
#pragma unroll
                        for (int dt = 0; dt < 4; ++dt) O[dt] = MFMA32(__builtin_bit_cast(bf16x8, *(const u32x4*)(vl + dt * 32 * SL_VSTR + (32 * kk + 16 * s2) * 2)), pb, O[dt]); }
                }
            }
            const float l = lsum + __shfl_xor(lsum, 32); const float inv = l > 0.f ? 1.0f / l : 0.f;
#pragma unroll
            for (int i = 0; i < 32; ++i) imp[i] += Uacc[i] * inv;
            const float sc = sigmoidf_(small[m * 32 + SM_GC + head]) * inv;
#pragma unroll
            for (int dt = 0; dt < 4; ++dt)
#pragma unroll
                for (int gq = 0; gq < 4; ++gq) { u32x2 w; w.x = cvt2(O[dt][4 * gq] * sc, O[dt][4 * gq + 1] * sc); w.y = cvt2(O[dt][4 * gq + 2] * sc, O[dt][4 * gq + 3] * sc);
                    *(u32x2*)(mix + m * D_MODEL + 1280 + head * 128 + 32 * dt + 8 * gq + 4 * h_) = w; }
        }
        const int cur = t >> 6;
        int hs = h; asm volatile("" : "+v"(hs));
        unsigned keys[32];
#pragma unroll
        for (int i = 0; i < 32; ++i) { const int j = 2 * i + hs; const bool causal = j <= cur, forced = (j == 0) || (j == cur) || (j == cur - 1);
            keys[i] = !causal ? 0u : (forced ? (0x7f000000u | (unsigned)(63 - j)) : ((__float_as_uint(imp[i]) & ~63u) | (unsigned)(63 - j))); }
        unsigned selbits = 0u;
#pragma unroll 1
        for (int round = 0; round < 16; ++round) {
            unsigned mx = keys[0];
#pragma unroll
            for (int i = 1; i < 32; ++i) mx = mx > keys[i] ? mx : keys[i];
            const unsigned pm = (unsigned)__shfl_xor((int)mx, 32); const unsigned gm = mx > pm ? mx : pm;
#pragma unroll
            for (int i = 0; i < 32; ++i) { const bool hit = keys[i] == gm && gm != 0u; selbits |= hit ? (1u << i) : 0u; keys[i] = hit ? 0u : keys[i]; }
        }
        unsigned long long x = selbits;
        x = (x | (x << 16)) & 0x0000FFFF0000FFFFull; x = (x | (x << 8)) & 0x00FF00FF00FF00FFull; x = (x | (x << 4)) & 0x0F0F0F0F0F0F0F0Full; x = (x | (x << 2)) & 0x3333333333333333ull; x = (x | (x << 1)) & 0x5555555555555555ull;
        x <<= h;
        const unsigned plo = (unsigned)__shfl_xor((int)(unsigned)x, 32), phi = (unsigned)__shfl_xor((int)(unsigned)(x >> 32), 32);
        x |= ((unsigned long long)phi << 32) | plo;
        if (h == 0) SELM[(size_t)(b * 2 + g) * SEQ + t] = x;
    }
    __syncthreads();
}

typedef float f32x4v __attribute__((ext_vector_type(4)));
#define MFMA16(a, b, c) __builtin_amdgcn_mfma_f32_16x16x32_bf16((a), (b), (c), 0, 0, 0)
__device__ __forceinline__ int gperm(int x) { return (x & ~31) | ((x & 12) << 1) | ((x & 16) >> 2) | (x & 3); }
constexpr int GP_STR = 136;
constexpr int GP_Q = 0, GP_K = 64 * GP_STR * 2, GP_V = 2 * 64 * GP_STR * 2, GP_L = 3 * 64 * GP_STR * 2, GP_LSTR = 68, GP_SC = GP_L + 64 * GP_LSTR * 4;
constexpr int GP_CHUNK = GP_SC + 320 * 4;
static_assert(2 * GP_CHUNK + 16 <= LDS_MISC, "two chunk images must fit below the frame's LDS words");
template <int STRIP> __device__ __forceinline__ void ph_gdn_prep_fast(const bf16* __restrict__ proj, const float* __restrict__ small, const float* __restrict__ conv_w, const float* __restrict__ a_log, const float* __restrict__ dt_bias,
                                                 bf16* __restrict__ UF, bf16* __restrict__ WP, bf16* __restrict__ QGP, bf16* __restrict__ KDT, bf16* __restrict__ AP, float* __restrict__ EGL, unsigned* __restrict__ queue) {
    extern __shared__ __attribute__((aligned(16))) unsigned char lds_dyn[];
    const int tid0 = ltid();
    volatile unsigned* qw = (volatile unsigned*)(lds_dyn + 2 * GP_CHUNK);
#define GP_BAR() asm volatile("s_waitcnt lgkmcnt(0)\n\ts_barrier" ::: "memory")
    for (;;) {
        int tid = tid0; asm volatile("" : "+v"(tid));
        __syncthreads();
        if (tid == 0) *qw = __hip_atomic_fetch_add(queue, 1u, __ATOMIC_RELAXED, __HIP_MEMORY_SCOPE_AGENT);
        __syncthreads();
        const int pair = (int)*qw;
        if (pair >= BATCH * 6 * 32) break;
        const int lane = tid & 63, wave = tid >> 6;
        const int bh = pair >> 5, b = bh / 6, h = bh % 6;
        GP_BAR();
        {
            const int cg = tid & 31, ts = tid >> 5;
            f32x4 cw[3][4];
#pragma unroll
            for (int which = 0; which < 3; ++which)
#pragma unroll
                for (int tap = 0; tap < 4; ++tap) cw[which][tap] = *(const f32x4*)(conv_w + tap * 2304 + which * 768 + h * 128 + 4 * cg);
#pragma unroll 1
            for (int cs = 0; cs < 2; ++cs) {
                const int n = 2 * (pair & 31) + cs; const size_t m0 = (size_t)b * SEQ + n * 64;
                unsigned char* L = lds_dyn + cs * GP_CHUNK;
                const int tb = n * 64 + 4 * ts - 3;
                u32x2 xr[3][7];
#pragma unroll
                for (int which = 0; which < 3; ++which)
#pragma unroll
                    for (int r = 0; r < 7; ++r) { const bool ok = tb + r >= 0; const bf16* src = proj + (m0 + 4 * ts - (ok ? 3 - r : 0)) * NPROJ + which * 768 + h * 128 + 4 * cg;
                        xr[which][r] = *(const u32x2*)src; if (!ok) xr[which][r] = (u32x2){0u, 0u}; }
#pragma unroll
                for (int which = 0; which < 3; ++which) {
                    float xf[7][4];
#pragma unroll
                    for (int r = 0; r < 7; ++r) { xf[r][0] = bf2f((bf16)(xr[which][r].x & 0xffff)); xf[r][1] = bf2f((bf16)(xr[which][r].x >> 16)); xf[r][2] = bf2f((bf16)(xr[which][r].y & 0xffff)); xf[r][3] = bf2f((bf16)(xr[which][r].y >> 16)); }
#pragma unroll
                    for (int j = 0; j < 4; ++j) { float y[4]; float ss = 0.f;
#pragma unroll
                        for (int e = 0; e < 4; ++e) { float v = cw[which][0][e] * xf[j][e]; v += cw[which][1][e] * xf[j + 1][e]; v += cw[which][2][e] * xf[j + 2][e]; v += cw[which][3][e] * xf[j + 3][e]; y[e] = siluf_(v); ss += y[e] * y[e]; }
                        float r = 1.f;
                        if (which < 2) { ss = row16_sum(ss); ss += __shfl_xor(ss, 16); r = rsqrtf(ss + NORM_EPS); if (which == 0) r *= 0.08838834764831845f; }
                        u32x2 o; o.x = cvt2(y[0] * r, y[1] * r); o.y = cvt2(y[2] * r, y[3] * r);
                        *(u32x2*)(L + which * (64 * GP_STR * 2) + ((4 * ts + j) * GP_STR + 4 * cg) * 2) = o; }
                }
            }
        }
        if (wave < 2) {
            const int cs = wave, n = 2 * (pair & 31) + cs, ci = 2 * pair + cs; const size_t m = (size_t)b * SEQ + n * 64 + lane;
            float* sgc = (float*)(lds_dyn + cs * GP_CHUNK + GP_SC);
            const float beta = sigmoidf_(small[m * 32 + SM_BA + h]);
            float g = -__expf(a_log[h]) * softplusf_(small[m * 32 + SM_AA + h] + dt_bias[h]);
#pragma unroll
            for (int o = 1; o < 64; o <<= 1) { const float up = __shfl_up(g, o); if (lane >= o) g += up; }
            const float gl = __shfl(g, 63);
            sgc[lane] = g; sgc[64 + lane] = beta; sgc[128 + lane] = __expf(g); sgc[192 + lane] = __expf(gl - g); sgc[256 + lane] = beta * __expf(g);
            if (lane == 0) EGL[ci] = __expf(gl);
        }
        GP_BAR();
        if (STRIP != 1) { const int r16 = lane & 15, a = lane >> 4;
          for (int tq = wave; tq < 52; tq += NWAVES) {
              const int cs = tq >= 26 ? 1 : 0, tl = tq - 26 * cs, ci = 2 * pair + cs;
              unsigned char* L = lds_dyn + cs * GP_CHUNK; const float* sgc = (const float*)(L + GP_SC); const float* sbeta = sgc + 64;
              const bool isA = tl >= 10; int ti, tj;
              if (!isA) { int k = tl; ti = 0; while (k > ti) { k -= ti + 1; ++ti; } tj = k; }
              else { ti = (tl - 10) >> 2; tj = (tl - 10) & 3; }
              f32x4v acc = {0.f, 0.f, 0.f, 0.f};
              if (tj <= ti) {
                  const unsigned char* xa = L + (isA ? GP_Q : GP_K) + ((16 * ti + r16) * GP_STR + 8 * a) * 2;
                  const unsigned char* xb = L + GP_K + ((16 * tj + r16) * GP_STR + 8 * a) * 2;
#pragma unroll
                  for (int s = 0; s < 4; ++s) acc = MFMA16(__builtin_bit_cast(bf16x8, *(const u32x4*)(xa + 64 * s)), __builtin_bit_cast(bf16x8, *(const u32x4*)(xb + 64 * s)), acc);
              }
              const int j = 16 * tj + r16; const float gj = sgc[j];
#pragma unroll
              for (int reg = 0; reg < 4; ++reg) { const int i = 16 * ti + 4 * a + reg; const float dec = __expf(sgc[i] - gj);
                  if (!isA) { ((float*)(L + GP_L))[i * GP_LSTR + j] = j < i ? sbeta[i] * acc[reg] * dec : 0.f; }
                  else __builtin_nontemporal_store(f2bf(j <= i ? acc[reg] * dec : 0.f), AP + ((size_t)ci * 64 + i) * 64 + gperm(j)); }
          } }
        GP_BAR();
        if (STRIP != 1 && STRIP != 2) {
            const int cs = wave >> 2, ci = 2 * pair + cs;
            unsigned char* L = lds_dyn + cs * GP_CHUNK; const float* sgc = (const float*)(L + GP_SC); const float* sbeta = sgc + 64; const float* segc = sgc + 128; const float* sekd = sgc + 192;
            const int c = (wave & 3) * 64 + lane; const bool isw = c >= 128; const int cc = c & 127;
            const unsigned char* xsrc = L + (isw ? GP_K : GP_V) + cc * 2;
            const float* Lm = (const float*)(L + GP_L);
            float U[64];
            const float* scl = isw ? (sgc + 256) : sbeta;
            f32x4 bA[16], bB[16]; float rA, rB = 0.f;
            rA = bf2f(*(const bf16*)xsrc) * scl[0];
#define GDN_LOADROW(buf, rr_, i_) do { _Pragma("unroll") for (int j4 = 0; j4 < ((i_) + 3) / 4; ++j4) buf[j4] = *(const f32x4*)(Lm + (i_) * GP_LSTR + 4 * j4); rr_ = bf2f(*(const bf16*)(xsrc + (i_) * GP_STR * 2)) * scl[i_]; } while (0)
#define GDN_ROW(buf, rr_, i_) do { float a0 = rr_, a1 = 0.f, a2 = 0.f, a3 = 0.f; _Pragma("unroll") for (int j4 = 0; j4 < ((i_) + 3) / 4; ++j4) { const f32x4 lv = buf[j4]; \
                    if (4 * j4 < (i_)) a0 -= lv.x * U[4 * j4]; if (4 * j4 + 1 < (i_)) a1 -= lv.y * U[4 * j4 + 1]; if (4 * j4 + 2 < (i_)) a2 -= lv.z * U[4 * j4 + 2]; if (4 * j4 + 3 < (i_)) a3 -= lv.w * U[4 * j4 + 3]; } \
                    U[i_] = (a0 + a1) + (a2 + a3); asm volatile("" ::: "memory"); } while (0)
#pragma unroll
            for (int i = 0; i < 64; i += 2) {
                GDN_LOADROW(bB, rB, i + 1);
                GDN_ROW(bA, rA, i);
                if (i + 2 < 64) GDN_LOADROW(bA, rA, i + 2);
                GDN_ROW(bB, rB, i + 1);
            }
#undef GDN_LOADROW
#undef GDN_ROW
            if (STRIP == 3) { if (U[63] == 12345.678f) EGL[ci] = U[5]; } else
            if (!isw) { const int v = cc >> 4, c15 = cc & 15; bf16* dst = UF + ((size_t)ci * 8 + v) * 64 * 16;
#pragma unroll
                for (int aa = 0; aa < 4; ++aa) { u32x4 w0, w1;
                    w0.x = cvt2(U[4 * aa], U[4 * aa + 1]); w0.y = cvt2(U[4 * aa + 2], U[4 * aa + 3]); w0.z = cvt2(U[16 + 4 * aa], U[16 + 4 * aa + 1]); w0.w = cvt2(U[16 + 4 * aa + 2], U[16 + 4 * aa + 3]);
                    w1.x = cvt2(U[32 + 4 * aa], U[32 + 4 * aa + 1]); w1.y = cvt2(U[32 + 4 * aa + 2], U[32 + 4 * aa + 3]); w1.z = cvt2(U[48 + 4 * aa], U[48 + 4 * aa + 1]); w1.w = cvt2(U[48 + 4 * aa + 2], U[48 + 4 * aa + 3]);
                    u32x4* p = (u32x4*)(dst + (16 * aa + c15) * 16); __builtin_nontemporal_store(w0, p); __builtin_nontemporal_store(w1, p + 1); } }
            else { bf16* dst = WP + (size_t)ci * 64 * 128 + gperm(cc);
#pragma unroll
                for (int i = 0; i < 64; ++i) __builtin_nontemporal_store(f2bf(U[i]), dst + i * 128); }
            const int t2 = tid & 255;
            if (STRIP != 3)
#pragma unroll
            for (int it = 0; it < 8; ++it) {
                const int pc = t2 + 256 * it, i = pc >> 5, pos = (pc & 31) * 4; const int s32 = pos & ~31, a = (pos >> 3) & 3, bb = (pos >> 2) & 1, dk = s32 + 16 * bb + 4 * a;
                const u32x2 qv = *(const u32x2*)(L + GP_Q + (i * GP_STR + dk) * 2); const float e = segc[i];
                u32x2 o; o.x = cvt2(bf2f((bf16)(qv.x & 0xffff)) * e, bf2f((bf16)(qv.x >> 16)) * e); o.y = cvt2(bf2f((bf16)(qv.y & 0xffff)) * e, bf2f((bf16)(qv.y >> 16)) * e);
                __builtin_nontemporal_store(o, (u32x2*)(QGP + ((size_t)ci * 64 + i) * 128 + pos)); }
            if (STRIP != 3)
#pragma unroll
            for (int it = 0; it < 8; ++it) {
                const int pc = t2 + 256 * it, dk = pc >> 4, pos = (pc & 15) * 4; const int s32 = pos & ~31, a = (pos >> 3) & 3, bb = (pos >> 2) & 1, i0 = s32 + 16 * bb + 4 * a;
                const unsigned char* ks = L + GP_K + (i0 * GP_STR + dk) * 2;
                const float k0 = bf2f(*(const bf16*)ks) * sekd[i0], k1 = bf2f(*(const bf16*)(ks + GP_STR * 2)) * sekd[i0 + 1], k2 = bf2f(*(const bf16*)(ks + 2 * GP_STR * 2)) * sekd[i0 + 2], k3 = bf2f(*(const bf16*)(ks + 3 * GP_STR * 2)) * sekd[i0 + 3];
                u32x2 o; o.x = cvt2(k0, k1); o.y = cvt2(k2, k3);
                __builtin_nontemporal_store(o, (u32x2*)(KDT + ((size_t)ci * 128 + dk) * 64 + pos)); }
        }
    }
#undef GP_BAR
    __syncthreads();
}

constexpr int GS_WSTR = 272, GS_TSTR = 144;
constexpr int GS_W = 0, GS_Q = 64 * GS_WSTR, GS_KD = 2 * 64 * GS_WSTR, GS_A = GS_KD + 128 * GS_TSTR, GS_STAGE = GS_A + 64 * GS_TSTR;
constexpr int GS_SSQ = 2 * GS_STAGE;
__device__ __forceinline__ void ph_gdn_scan_fast(const bf16* __restrict__ UF, const bf16* __restrict__ WP, const bf16* __restrict__ QGP, const bf16* __restrict__ KDT, const bf16* __restrict__ AP, const float* __restrict__ EGL,
                                                 const bf16* __restrict__ proj, const float* __restrict__ norm_g, bf16* __restrict__ mix, int nblk_scan) {
    extern __shared__ __attribute__((aligned(16))) unsigned char lds_dyn[];
    const int tid = ltid(); const int lane = tid & 63, wave = tid >> 6, r16 = lane & 15, a = lane >> 4;
    for (int bh = blockIdx.x; bh < BATCH * 6; bh += nblk_scan) {
        const int b = bh / 6, h = bh % 6;
        u32x4 st[7];
        auto gload = [&](int ci) {
            const u32x4* w = (const u32x4*)(WP + (size_t)ci * 64 * 128); const u32x4* q = (const u32x4*)(QGP + (size_t)ci * 64 * 128);
            const u32x4* k = (const u32x4*)(KDT + (size_t)ci * 128 * 64); const u32x4* ap = (const u32x4*)(AP + (size_t)ci * 64 * 64);
            st[0] = w[tid]; st[1] = w[tid + 512]; st[2] = q[tid]; st[3] = q[tid + 512]; st[4] = k[tid]; st[5] = k[tid + 512]; st[6] = ap[tid]; };
        auto lwrite = [&](int buf) {
            unsigned char* base = lds_dyn + buf * GS_STAGE;
            *(u32x4*)(base + GS_W + (tid >> 4) * GS_WSTR + (tid & 15) * 16) = st[0]; *(u32x4*)(base + GS_W + ((tid + 512) >> 4) * GS_WSTR + (tid & 15) * 16) = st[1];
            *(u32x4*)(base + GS_Q + (tid >> 4) * GS_WSTR + (tid & 15) * 16) = st[2]; *(u32x4*)(base + GS_Q + ((tid + 512) >> 4) * GS_WSTR + (tid & 15) * 16) = st[3];
            *(u32x4*)(base + GS_KD + (tid >> 3) * GS_TSTR + (tid & 7) * 16) = st[4]; *(u32x4*)(base + GS_KD + ((tid + 512) >> 3) * GS_TSTR + (tid & 7) * 16) = st[5];
            *(u32x4*)(base + GS_A + (tid >> 3) * GS_TSTR + (tid & 7) * 16) = st[6]; };
        f32x4v S[8];
#pragma unroll
        for (int i = 0; i < 8; ++i) S[i] = (f32x4v){0.f, 0.f, 0.f, 0.f};
        const int ci0 = bh * 64;
        __syncthreads();
        gload(ci0); lwrite(0);
        __syncthreads();
        gload(ci0 + 1);
        u32x4 ucur0, ucur1, unext0 = {0u, 0u, 0u, 0u}, unext1 = {0u, 0u, 0u, 0u}; float eglc, egln = 0.f;
        { const u32x4* up = (const u32x4*)(UF + (((size_t)ci0 * 8 + wave) * 64 + lane) * 16); ucur0 = up[0]; ucur1 = up[1]; eglc = EGL[ci0]; }
#define GDN_LDS_BARRIER() asm volatile("s_waitcnt lgkmcnt(0)\n\ts_barrier" ::: "memory")
#pragma unroll 1
        for (int n = 0; n < 64; ++n) {
            const int ci = ci0 + n, buf = n & 1;
            if (n < 63) {
                const u32x4* up = (const u32x4*)(UF + (((size_t)(ci + 1) * 8 + wave) * 64 + lane) * 16); unext0 = up[0]; unext1 = up[1]; egln = EGL[ci + 1]; }
            const unsigned char* base = lds_dyn + buf * GS_STAGE;
            const float egl = eglc;
            const unsigned uw[8] = {ucur0.x, ucur0.y, ucur0.z, ucur0.w, ucur1.x, ucur1.y, ucur1.z, ucur1.w};
            bf16x8 Sb[4];
#pragma unroll
            for (int s = 0; s < 4; ++s) { u32x4 w; w.x = cvt2(S[2 * s][0], S[2 * s][1]); w.y = cvt2(S[2 * s][2], S[2 * s][3]); w.z = cvt2(S[2 * s + 1][0], S[2 * s + 1][1]); w.w = cvt2(S[2 * s + 1][2], S[2 * s + 1][3]); Sb[s] = __builtin_bit_cast(bf16x8, w); }
#define GS_FRAG(off) __builtin_bit_cast(bf16x8, *(const u32x4*)(base + (off)))
#define GS_SB() __builtin_amdgcn_sched_barrier(0)
            bf16x8 fa[4], fb[4];
            f32x4v vn[4], o[4];
            fa[0] = GS_FRAG(GS_W + (16 * 0 + r16) * GS_WSTR + (32 * 0 + 8 * a) * 2); fa[1] = GS_FRAG(GS_W + (16 * 0 + r16) * GS_WSTR + (32 * 1 + 8 * a) * 2); fa[2] = GS_FRAG(GS_W + (16 * 0 + r16) * GS_WSTR + (32 * 2 + 8 * a) * 2); fa[3] = GS_FRAG(GS_W + (16 * 0 + r16) * GS_WSTR + (32 * 3 + 8 * a) * 2); GS_SB();
            fb[0] = GS_FRAG(GS_W + (16 * 1 + r16) * GS_WSTR + (32 * 0 + 8 * a) * 2); fb[1] = GS_FRAG(GS_W + (16 * 1 + r16) * GS_WSTR + (32 * 1 + 8 * a) * 2); fb[2] = GS_FRAG(GS_W + (16 * 1 + r16) * GS_WSTR + (32 * 2 + 8 * a) * 2); fb[3] = GS_FRAG(GS_W + (16 * 1 + r16) * GS_WSTR + (32 * 3 + 8 * a) * 2); GS_SB();
            { f32x4v acc = {0.f, 0.f, 0.f, 0.f}; acc = MFMA16(fa[0], Sb[0], acc); acc = MFMA16(fa[1], Sb[1], acc); acc = MFMA16(fa[2], Sb[2], acc); acc = MFMA16(fa[3], Sb[3], acc); vn[0] = acc; }GS_SB();
            fa[0] = GS_FRAG(GS_W + (16 * 2 + r16) * GS_WSTR + (32 * 0 + 8 * a) * 2); fa[1] = GS_FRAG(GS_W + (16 * 2 + r16) * GS_WSTR + (32 * 1 + 8 * a) * 2); fa[2] = GS_FRAG(GS_W + (16 * 2 + r16) * GS_WSTR + (32 * 2 + 8 * a) * 2); fa[3] = GS_FRAG(GS_W + (16 * 2 + r16) * GS_WSTR + (32 * 3 + 8 * a) * 2); GS_SB();
            { f32x4v acc = {0.f, 0.f, 0.f, 0.f}; acc = MFMA16(fb[0], Sb[0], acc); acc = MFMA16(fb[1], Sb[1], acc); acc = MFMA16(fb[2], Sb[2], acc); acc = MFMA16(fb[3], Sb[3], acc); vn[1] = acc; }GS_SB();
            fb[0] = GS_FRAG(GS_W + (16 * 3 + r16) * GS_WSTR + (32 * 0 + 8 * a) * 2); fb[1] = GS_FRAG(GS_W + (16 * 3 + r16) * GS_WSTR + (32 * 1 + 8 * a) * 2); fb[2] = GS_FRAG(GS_W + (16 * 3 + r16) * GS_WSTR + (32 * 2 + 8 * a) * 2); fb[3] = GS_FRAG(GS_W + (16 * 3 + r16) * GS_WSTR + (32 * 3 + 8 * a) * 2); GS_SB();
            { f32x4v acc = {0.f, 0.f, 0.f, 0.f}; acc = MFMA16(fa[0], Sb[0], acc); acc = MFMA16(fa[1], Sb[1], acc); acc = MFMA16(fa[2], Sb[2], acc); acc = MFMA16(fa[3], Sb[3], acc); vn[2] = acc; }GS_SB();
            fa[0] = GS_FRAG(GS_Q + (16 * 0 + r16) * GS_WSTR + (32 * 0 + 8 * a) * 2); fa[1] = GS_FRAG(GS_Q + (16 * 0 + r16) * GS_WSTR + (32 * 1 + 8 * a) * 2); fa[2] = GS_FRAG(GS_Q + (16 * 0 + r16) * GS_WSTR + (32 * 2 + 8 * a) * 2); fa[3] = GS_FRAG(GS_Q + (16 * 0 + r16) * GS_WSTR + (32 * 3 + 8 * a) * 2); GS_SB();
            { f32x4v acc = {0.f, 0.f, 0.f, 0.f}; acc = MFMA16(fb[0], Sb[0], acc); acc = MFMA16(fb[1], Sb[1], acc); acc = MFMA16(fb[2], Sb[2], acc); acc = MFMA16(fb[3], Sb[3], acc); vn[3] = acc; }GS_SB();
            fb[0] = GS_FRAG(GS_Q + (16 * 1 + r16) * GS_WSTR + (32 * 0 + 8 * a) * 2); fb[1] = GS_FRAG(GS_Q + (16 * 1 + r16) * GS_WSTR + (32 * 1 + 8 * a) * 2); fb[2] = GS_FRAG(GS_Q + (16 * 1 + r16) * GS_WSTR + (32 * 2 + 8 * a) * 2); fb[3] = GS_FRAG(GS_Q + (16 * 1 + r16) * GS_WSTR + (32 * 3 + 8 * a) * 2); GS_SB();
#pragma unroll
            for (int mt = 0; mt < 4; ++mt) { vn[mt][0] = bf2f((bf16)(uw[2 * mt] & 0xffff)) - vn[mt][0]; vn[mt][1] = bf2f((bf16)(uw[2 * mt] >> 16)) - vn[mt][1];
                vn[mt][2] = bf2f((bf16)(uw[2 * mt + 1] & 0xffff)) - vn[mt][2]; vn[mt][3] = bf2f((bf16)(uw[2 * mt + 1] >> 16)) - vn[mt][3]; }
            bf16x8 vb[2];
#pragma unroll
            for (int s2 = 0; s2 < 2; ++s2) { u32x4 w; w.x = cvt2(vn[2 * s2][0], vn[2 * s2][1]); w.y = cvt2(vn[2 * s2][2], vn[2 * s2][3]); w.z = cvt2(vn[2 * s2 + 1][0], vn[2 * s2 + 1][1]); w.w = cvt2(vn[2 * s2 + 1][2], vn[2 * s2 + 1][3]); vb[s2] = __builtin_bit_cast(bf16x8, w); }
            { f32x4v acc = {0.f, 0.f, 0.f, 0.f}; acc = MFMA16(fa[0], Sb[0], acc); acc = MFMA16(fa[1], Sb[1], acc); acc = MFMA16(fa[2], Sb[2], acc); acc = MFMA16(fa[3], Sb[3], acc); o[0] = acc; }GS_SB();
            fa[0] = GS_FRAG(GS_Q + (16 * 2 + r16) * GS_WSTR + (32 * 0 + 8 * a) * 2); fa[1] = GS_FRAG(GS_Q + (16 * 2 + r16) * GS_WSTR + (32 * 1 + 8 * a) * 2); fa[2] = GS_FRAG(GS_Q + (16 * 2 + r16) * GS_WSTR + (32 * 2 + 8 * a) * 2); fa[3] = GS_FRAG(GS_Q + (16 * 2 + r16) * GS_WSTR + (32 * 3 + 8 * a) * 2); GS_SB();
            { f32x4v acc = {0.f, 0.f, 0.f, 0.f}; acc = MFMA16(fb[0], Sb[0], acc); acc = MFMA16(fb[1], Sb[1], acc); acc = MFMA16(fb[2], Sb[2], acc); acc = MFMA16(fb[3], Sb[3], acc); o[1] = acc; }GS_SB();
            fb[0] = GS_FRAG(GS_Q + (16 * 3 + r16) * GS_WSTR + (32 * 0 + 8 * a) * 2); fb[1] = GS_FRAG(GS_Q + (16 * 3 + r16) * GS_WSTR + (32 * 1 + 8 * a) * 2); fb[2] = GS_FRAG(GS_Q + (16 * 3 + r16) * GS_WSTR + (32 * 2 + 8 * a) * 2); fb[3] = GS_FRAG(GS_Q + (16 * 3 + r16) * GS_WSTR + (32 * 3 + 8 * a) * 2); GS_SB();
            { f32x4v acc = {0.f, 0.f, 0.f, 0.f}; acc = MFMA16(fa[0], Sb[0], acc); acc = MFMA16(fa[1], Sb[1], acc); acc = MFMA16(fa[2], Sb[2], acc); acc = MFMA16(fa[3], Sb[3], acc); o[2] = acc; }GS_SB();
            fa[0] = GS_FRAG(GS_A + (16 * 0 + r16) * GS_TSTR + (32 * 0 + 8 * a) * 2); fa[1] = GS_FRAG(GS_A + (16 * 0 + r16) * GS_TSTR + (32 * 1 + 8 * a) * 2); fa[2] = GS_FRAG(GS_A + (16 * 1 + r16) * GS_TSTR + (32 * 0 + 8 * a) * 2); fa[3] = GS_FRAG(GS_A + (16 * 1 + r16) * GS_TSTR + (32 * 1 + 8 * a) * 2); GS_SB();
            { f32x4v acc = {0.f, 0.f, 0.f, 0.f}; acc = MFMA16(fb[0], Sb[0], acc); acc = MFMA16(fb[1], Sb[1], acc); acc = MFMA16(fb[2], Sb[2], acc); acc = MFMA16(fb[3], Sb[3], acc); o[3] = acc; }GS_SB();
            fb[0] = GS_FRAG(GS_A + (16 * 2 + r16) * GS_TSTR + (32 * 0 + 8 * a) * 2); fb[1] = GS_FRAG(GS_A + (16 * 2 + r16) * GS_TSTR + (32 * 1 + 8 * a) * 2); fb[2] = GS_FRAG(GS_A + (16 * 3 + r16) * GS_TSTR + (32 * 0 + 8 * a) * 2); fb[3] = GS_FRAG(GS_A + (16 * 3 + r16) * GS_TSTR + (32 * 1 + 8 * a) * 2); GS_SB();
            o[0] = MFMA16(fa[0], vb[0], o[0]); o[0] = MFMA16(fa[1], vb[1], o[0]); o[1] = MFMA16(fa[2], vb[0], o[1]); o[1] = MFMA16(fa[3], vb[1], o[1]); GS_SB();
            fa[0] = GS_FRAG(GS_KD + (16 * 0 + r16) * GS_TSTR + (32 * 0 + 8 * a) * 2); fa[1] = GS_FRAG(GS_KD + (16 * 0 + r16) * GS_TSTR + (32 * 1 + 8 * a) * 2); fa[2] = GS_FRAG(GS_KD + (16 * 1 + r16) * GS_TSTR + (32 * 0 + 8 * a) * 2); fa[3] = GS_FRAG(GS_KD + (16 * 1 + r16) * GS_TSTR + (32 * 1 + 8 * a) * 2); GS_SB();
            o[2] = MFMA16(fb[0], vb[0], o[2]); o[2] = MFMA16(fb[1], vb[1], o[2]); o[3] = MFMA16(fb[2], vb[0], o[3]); o[3] = MFMA16(fb[3], vb[1], o[3]); GS_SB();
            fb[0] = GS_FRAG(GS_KD + (16 * 2 + r16) * GS_TSTR + (32 * 0 + 8 * a) * 2); fb[1] = GS_FRAG(GS_KD + (16 * 2 + r16) * GS_TSTR + (32 * 1 + 8 * a) * 2); fb[2] = GS_FRAG(GS_KD + (16 * 3 + r16) * GS_TSTR + (32 * 0 + 8 * a) * 2); fb[3] = GS_FRAG(GS_KD + (16 * 3 + r16) * GS_TSTR + (32 * 1 + 8 * a) * 2); GS_SB();
            { f32x4v acc = S[0] * egl; acc = MFMA16(fa[0], vb[0], acc); acc = MFMA16(fa[1], vb[1], acc); S[0] = acc; } { f32x4v acc = S[1] * egl; acc = MFMA16(fa[2], vb[0], acc); acc = MFMA16(fa[3], vb[1], acc); S[1] = acc; } GS_SB();
            fa[0] = GS_FRAG(GS_KD + (16 * 4 + r16) * GS_TSTR + (32 * 0 + 8 * a) * 2); fa[1] = GS_FRAG(GS_KD + (16 * 4 + r16) * GS_TSTR + (32 * 1 + 8 * a) * 2); fa[2] = GS_FRAG(GS_KD + (16 * 5 + r16) * GS_TSTR + (32 * 0 + 8 * a) * 2); fa[3] = GS_FRAG(GS_KD + (16 * 5 + r16) * GS_TSTR + (32 * 1 + 8 * a) * 2); GS_SB();
            { f32x4v acc = S[2] * egl; acc = MFMA16(fb[0], vb[0], acc); acc = MFMA16(fb[1], vb[1], acc); S[2] = acc; } { f32x4v acc = S[3] * egl; acc = MFMA16(fb[2], vb[0], acc); acc = MFMA16(fb[3], vb[1], acc); S[3] = acc; } GS_SB();
            fb[0] = GS_FRAG(GS_KD + (16 * 6 + r16) * GS_TSTR + (32 * 0 + 8 * a) * 2); fb[1] = GS_FRAG(GS_KD + (16 * 6 + r16) * GS_TSTR + (32 * 1 + 8 * a) * 2); fb[2] = GS_FRAG(GS_KD + (16 * 7 + r16) * GS_TSTR + (32 * 0 + 8 * a) * 2); fb[3] = GS_FRAG(GS_KD + (16 * 7 + r16) * GS_TSTR + (32 * 1 + 8 * a) * 2); GS_SB();
            { f32x4v acc = S[4] * egl; acc = MFMA16(fa[0], vb[0], acc); acc = MFMA16(fa[1], vb[1], acc); S[4] = acc; } { f32x4v acc = S[5] * egl; acc = MFMA16(fa[2], vb[0], acc); acc = MFMA16(fa[3], vb[1], acc); S[5] = acc; } GS_SB();
            { f32x4v acc = S[6] * egl; acc = MFMA16(fb[0], vb[0], acc); acc = MFMA16(fb[1], vb[1], acc); S[6] = acc; } { f32x4v acc = S[7] * egl; acc = MFMA16(fb[2], vb[0], acc); acc = MFMA16(fb[3], vb[1], acc); S[7] = acc; } GS_SB();
#undef GS_FRAG
#undef GS_SB
            const size_t mrow = (size_t)b * SEQ + n * 64;
#pragma unroll
            for (int mt = 0; mt < 4; ++mt)
#pragma unroll
                for (int reg = 0; reg < 4; ++reg) mix[(mrow + 16 * mt + 4 * a + reg) * D_MODEL + h * 128 + 16 * wave + r16] = (bf16)(cvt2(o[mt][reg], 0.f) & 0xffffu);
            if (n < 63) lwrite(buf ^ 1);
            if (n < 62) gload(ci + 2);
            GDN_LDS_BARRIER();
            ucur0 = unext0; ucur1 = unext1; eglc = egln;
        }
        asm volatile("s_waitcnt vmcnt(0)" ::: "memory"); __syncthreads(); __builtin_amdgcn_fence(__ATOMIC_ACQUIRE, "agent");
        { const int c0 = (tid & 7) * 16; const float* ngp = norm_g + c0; float ngv[16];
#pragma unroll
          for (int e = 0; e < 16; ++e) ngv[e] = ngp[e];
#pragma unroll 2
          for (int tk = tid >> 3; tk < SEQ; tk += NTHREADS / 8) { const size_t m = (size_t)b * SEQ + tk;
              u32x4* op = (u32x4*)(mix + m * D_MODEL + h * 128 + c0); const u32x4* zp = (const u32x4*)(proj + m * NPROJ + PC_ZA + h * 128 + c0);
              const u32x4 o0 = op[0], o1 = op[1], z0 = zp[0], z1 = zp[1];
              const unsigned ow[8] = {o0.x, o0.y, o0.z, o0.w, o1.x, o1.y, o1.z, o1.w}, zw[8] = {z0.x, z0.y, z0.z, z0.w, z1.x, z1.y, z1.z, z1.w};
              float ov[16]; float ss = 0.f;
#pragma unroll
              for (int e = 0; e < 8; ++e) { ov[2 * e] = __uint_as_float(ow[e] << 16); ov[2 * e + 1] = __uint_as_float(ow[e] & 0xffff0000u); ss += ov[2 * e] * ov[2 * e] + ov[2 * e + 1] * ov[2 * e + 1]; }
              ss += __shfl_xor(ss, 1); ss += __shfl_xor(ss, 2); ss += __shfl_xor(ss, 4);
              const float rstd = rsqrtf(ss * (1.f / 128.f) + NORM_EPS);
              unsigned rw[8];
#pragma unroll
              for (int e = 0; e < 8; ++e) { const float za = __uint_as_float(zw[e] << 16), zb2 = __uint_as_float(zw[e] & 0xffff0000u);
                  rw[e] = cvt2(ov[2 * e] * rstd * ngv[2 * e] * siluf_(za), ov[2 * e + 1] * rstd * ngv[2 * e + 1] * siluf_(zb2)); }
              op[0] = (u32x4){rw[0], rw[1], rw[2], rw[3]}; op[1] = (u32x4){rw[4], rw[5], rw[6], rw[7]}; } }
#undef GDN_LDS_BARRIER
    }
}

constexpr int CP_STR = 272;
constexpr int CP_STAGE = 128 * CP_STR, CP_HID = 2 * CP_STAGE;
__device__ __forceinline__ float gelu_fast(float x) { const float u = 1.5957691216057308f * (x + 0.044715f * x * x * x); return x * __builtin_amdgcn_rcpf(1.0f + __expf(-u)); }
__device__ __forceinline__ void ph_cmp_c1(const float* __restrict__ pos, const float* __restrict__ w1, float* __restrict__ C1) {
    extern __shared__ __attribute__((aligned(16))) unsigned char lds_dyn[];
    const int tid = ltid(); float* red = (float*)lds_dyn;
    for (int o = blockIdx.x; o < 256; o += gridDim.x) { const int kv = o >> 7, j = o & 127; const float* p = pos + kv * 4096; const float* w = w1 + (size_t)kv * 4096 * 128 + j; float s = 0.f;
#pragma unroll
        for (int e = 0; e < 8; ++e) { const int i = tid * 8 + e; s += p[i] * w[(size_t)i * 128]; }
        s = wave_sum(s);
        __syncthreads();
        if ((tid & 63) == 0) red[tid >> 6] = s;
        __syncthreads();
        if (tid == 0) C1[o] = ((red[0] + red[1]) + (red[2] + red[3])) + ((red[4] + red[5]) + (red[6] + red[7])); }
    __syncthreads();
}
__device__ __forceinline__ void ph_nsa_compress_fast(const bf16* __restrict__ proj, const bf16* __restrict__ W1T, const bf16* __restrict__ W2T, const float* __restrict__ C1, const float* __restrict__ kg,
                                                     bf16* __restrict__ KCB, bf16* __restrict__ VCT) {
    extern __shared__ __attribute__((aligned(16))) unsigned char lds_dyn[];
    const int tid0 = ltid();
    for (int item = blockIdx.x; item < 64; item += gridDim.x) {
        int tid = tid0; asm volatile("" : "+v"(tid));
        const int lane = tid & 63, wave = tid >> 6, r16 = lane & 15, a = lane >> 4;
        const int half = item & 1, kv = (item >> 1) & 1, g = (item >> 2) & 1, b = item >> 3;
        const int mt = half * 8 + wave, n = 16 * mt + r16;
        const bf16* arow = proj + (size_t)b * SEQ * NPROJ + (kv ? PC_VCC : PC_KCC) + g * 128 + 8 * a;
        const bf16* w1t = W1T + (size_t)kv * 128 * 4096;
        u32x4 st[4];
        auto gload = [&](int l) {
#pragma unroll
            for (int i = 0; i < 4; ++i) { const int c = tid + 512 * i; st[i] = *(const u32x4*)(w1t + (size_t)(c >> 4) * 4096 + l * 128 + (c & 15) * 8); } };
        auto lwrite = [&](int buf) {
#pragma unroll
            for (int i = 0; i < 4; ++i) { const int c = tid + 512 * i; *(u32x4*)(lds_dyn + buf * CP_STAGE + (c >> 4) * CP_STR + (c & 15) * 16) = st[i]; } };
        f32x4v acc[8];
#pragma unroll
        for (int i = 0; i < 8; ++i) acc[i] = (f32x4v){0.f, 0.f, 0.f, 0.f};
        __syncthreads();
        gload(0); lwrite(0);
        __syncthreads();
#pragma unroll 1
        for (int l = 0; l < 32; ++l) {
            const int buf = l & 1;
            if (l < 31) gload(l + 1);
            const int tok = 16 * n + l < SEQ ? 16 * n + l : SEQ - 1;
            bf16x8 af[4];
#pragma unroll
            for (int s = 0; s < 4; ++s) af[s] = ld_frag(arow + (size_t)tok * NPROJ + 32 * s);
            const unsigned char* wb = lds_dyn + buf * CP_STAGE + r16 * CP_STR + 16 * a;
#pragma unroll
            for (int s = 0; s < 4; ++s)
#pragma unroll
                for (int nt = 0; nt < 8; ++nt) acc[nt] = MFMA16(af[s], __builtin_bit_cast(bf16x8, *(const u32x4*)(wb + nt * 16 * CP_STR + 64 * s)), acc[nt]);
            if (l < 31) lwrite(buf ^ 1);
            __syncthreads();
        }
        unsigned char* hs = lds_dyn + CP_HID + wave * 16 * CP_STR;
#pragma unroll
        for (int nt = 0; nt < 8; ++nt) { const float c1 = C1[kv * 128 + 16 * nt + r16];
#pragma unroll
            for (int reg = 0; reg < 4; ++reg) *(bf16*)(hs + (4 * a + reg) * CP_STR + (16 * nt + r16) * 2) = f2bf(gelu_fast(acc[nt][reg] + c1)); }
        __builtin_amdgcn_s_waitcnt(0); asm volatile("" ::: "memory");
        bf16x8 hf[4];
#pragma unroll
        for (int s = 0; s < 4; ++s) hf[s] = __builtin_bit_cast(bf16x8, *(const u32x4*)(hs + r16 * CP_STR + 64 * s + 16 * a));
        const bf16* w2t = W2T + (size_t)kv * 128 * 128 + (size_t)r16 * 128 + 8 * a;
        f32x4v o2[8];
#pragma unroll
        for (int nt = 0; nt < 8; ++nt) { f32x4v c = {0.f, 0.f, 0.f, 0.f};
#pragma unroll
            for (int s = 0; s < 4; ++s) c = MFMA16(hf[s], ld_frag(w2t + (size_t)nt * 16 * 128 + 32 * s), c);
            o2[nt] = c; }
        const size_t bg = (size_t)(b * 2 + g);
        if (kv == 0) {
            float rs[4];
#pragma unroll
            for (int reg = 0; reg < 4; ++reg) { float q2 = 0.f;
#pragma unroll
                for (int nt = 0; nt < 8; ++nt) q2 += o2[nt][reg] * o2[nt][reg];
                rs[reg] = rsqrtf(row16_sum(q2) * (1.f / 128.f) + NORM_EPS); }
#pragma unroll
            for (int nt = 0; nt < 8; ++nt) { const float gn = kg[16 * nt + r16];
#pragma unroll
                for (int reg = 0; reg < 4; ++reg) { const int nn = 16 * mt + 4 * a + reg; KCB[(bg * 256 + nn) * 128 + 16 * nt + r16] = f2bf(nn < N_CMP ? o2[nt][reg] * rs[reg] * gn : 0.f); } }
        } else {
#pragma unroll
            for (int nt = 0; nt < 8; ++nt) { const bool last = (mt == 15 && a == 3);
                u32x2 w; w.x = cvt2(o2[nt][0], o2[nt][1]); w.y = cvt2(o2[nt][2], last ? 0.f : o2[nt][3]);
                *(u32x2*)(VCT + (bg * 128 + 16 * nt + r16) * 256 + 16 * mt + 8 * (a & 1) + 4 * (a >> 1)) = w; }
        }
    }
    __syncthreads();
}

constexpr int SG_STR = 272;
__device__ __forceinline__ void ph_sgu_wprep(const float* __restrict__ sgu_w, bf16* __restrict__ WSG) {
    const int tid = ltid();
    for (int i = blockIdx.x * NTHREADS + tid; i < 4 * 128 * 128 / 2; i += gridDim.x * NTHREADS) { const int e = 2 * i, s = e & 127, t = (e >> 7) & 127;
        const f32x2 w = *(const f32x2*)(sgu_w + e); *(unsigned*)(WSG + e) = cvt2(s <= t ? w.x : 0.f, s + 1 <= t ? w.y : 0.f); }
}
__device__ __forceinline__ void ph_sgu_mix_fast(const bf16* __restrict__ proj, const bf16* __restrict__ VLN, const bf16* __restrict__ WSG, const float* __restrict__ sgu_b, bf16* __restrict__ mix, unsigned* __restrict__ queue) {
    extern __shared__ __attribute__((aligned(16))) unsigned char lds_dyn[];
    const int tid0 = ltid();
    volatile unsigned* qw = (volatile unsigned*)(lds_dyn + 128 * SG_STR);
    for (;;) {
        int tid = tid0; asm volatile("" : "+v"(tid));
        __syncthreads();
        if (tid == 0) *qw = __hip_atomic_fetch_add(queue, 1u, __ATOMIC_RELAXED, __HIP_MEMORY_SCOPE_AGENT);
        __syncthreads();
        const int item = (int)*qw;
        if (item >= BATCH * 32 * 4) break;
        const int lane = tid & 63, wave = tid >> 6, r16 = lane & 15, a = lane >> 4;
        const int g = item & 3, n = (item >> 2) & 31, b = item >> 7;
        const size_t m0 = (size_t)b * SEQ + n * 128;
        __syncthreads();
#pragma unroll
        for (int i = 0; i < 4; ++i) { const int c = tid + 512 * i, s = c >> 4, part = c & 15;
            *(u32x4*)(lds_dyn + s * SG_STR + part * 16) = *(const u32x4*)(VLN + (m0 + s) * 512 + g * 128 + part * 8); }
        const int nks = ((16 * wave + 15) >> 5) + 1;
        bf16x8 wf[4];
#pragma unroll
        for (int ks = 0; ks < 4; ++ks) wf[ks] = ld_frag(WSG + ((size_t)g * 128 + 16 * wave + r16) * 128 + 32 * ks + 8 * a);
        __syncthreads();
#pragma unroll 2
        for (int nt = 0; nt < 8; ++nt) {
            f32x4v acc = {0.f, 0.f, 0.f, 0.f};
#pragma unroll
            for (int ks = 0; ks < 4; ++ks) if (ks < nks) {
                const unsigned char* vp = lds_dyn + (32 * ks + 8 * a) * SG_STR + (16 * nt + r16) * 2;
                bf16x8 bfr;
#pragma unroll
                for (int j = 0; j < 8; ++j) bfr[j] = *(const short*)(vp + j * SG_STR);
                acc = MFMA16(bfr, wf[ks], acc);
            }
            { const int t = 16 * wave + r16, c = 16 * nt + 4 * a; const float bs = sgu_b[g * 128 + t];
              const u32x2 uu = *(const u32x2*)(proj + (m0 + t) * NPROJ + PC_UB + g * 128 + c);
              u32x2 w; w.x = cvt2(gelu_fast(bf2f((bf16)(uu.x & 0xffff))) * (acc[0] + bs), gelu_fast(bf2f((bf16)(uu.x >> 16))) * (acc[1] + bs));
              w.y = cvt2(gelu_fast(bf2f((bf16)(uu.y & 0xffff))) * (acc[2] + bs), gelu_fast(bf2f((bf16)(uu.y >> 16))) * (acc[3] + bs));
              *(u32x2*)(mix + (m0 + t) * D_MODEL + 768 + g * 128 + c) = w; }
        }
    }
    __syncthreads();
}

constexpr int N_SCAN_WG = 48;
__global__ void __launch_bounds__(NTHREADS, 2) mega(Params P) {
    extern __shared__ __attribute__((aligned(16))) unsigned char lds_dyn[];
    volatile LAS unsigned* st = (volatile LAS unsigned*)(lds_dyn + LDS_MISC);
    if (threadIdx.x == 0) { st[0] = 0u; st[1] = 0u; st[2] = 0u; st[3] = 0u;
        volatile LAS unsigned long long* tab = (volatile LAS unsigned long long*)(lds_dyn + LDS_PTAB);
#pragma unroll
        for (int i = 0; i < 21; ++i) tab[i] = (unsigned long long)P.in[i];
        tab[21] = (unsigned long long)P.out; tab[22] = (unsigned long long)P.ws; }
    __syncthreads();
    unsigned bar_x;
    { const XcdBarrier bar0 = xcd_barrier_post((unsigned*)(P.ws + WS_CTL), st); bar_x = bar0.x; }
#define GRID_BAR() do { XcdBarrier b_; b_.bar = (unsigned*)(gptr(22) + WS_CTL); b_.x = bar_x; b_.st = st; asm volatile("" : "+s"(b_.x)); xcd_barrier(b_); } while (0)
#define WSP() (gptr(22))
#define OUTP() ((float*)gptr(21))
    const int G = (int)gridDim.x;
#pragma unroll 1
    for (int l = 0; l < DEPTH; ++l) {
        { unsigned char* ws = WSP();
        ph_transpose<1>(in_ptr(I_W_IN) + (size_t)l * D_MODEL * NPROJ_ORIG, D_MODEL, NPROJ_ORIG, (bf16*)(ws + WS_WIN), NPROJ, in_ptr(I_ATTN_NORM) + l * D_MODEL);
        ph_transpose<0>(in_ptr(I_W_OUT) + (size_t)l * D_MODEL * D_MODEL, D_MODEL, D_MODEL, (bf16*)(ws + WS_WOUT), D_MODEL);
        ph_transpose<0>(in_ptr(I_W_UP) + (size_t)l * D_MODEL * D_FF, D_MODEL, D_FF, (bf16*)(ws + WS_WUP), D_FF, in_ptr(I_MLP_NORM) + l * D_MODEL);
        ph_transpose<0>(in_ptr(I_W_DOWN) + (size_t)l * D_FF * D_MODEL, D_FF, D_MODEL, (bf16*)(ws + WS_WDN), D_MODEL);
        ph_transpose<0>(in_ptr(I_CMP_W1) + (size_t)l * 2 * 4096 * 128, 4096, 128, (bf16*)(ws + WS_W1T), 128);
        ph_transpose<0>(in_ptr(I_CMP_W1) + (size_t)(l * 2 + 1) * 4096 * 128, 4096, 128, (bf16*)(ws + WS_W1T) + 128 * 4096, 128);
        ph_transpose<0>(in_ptr(I_CMP_W2) + (size_t)l * 2 * 128 * 128, 128, 128, (bf16*)(ws + WS_W2T), 128);
        ph_transpose<0>(in_ptr(I_CMP_W2) + (size_t)(l * 2 + 1) * 128 * 128, 128, 128, (bf16*)(ws + WS_W2T) + 128 * 128, 128);
        ph_sgu_wprep(in_ptr(I_SGU_W) + (size_t)l * 4 * 128 * 128, (bf16*)(ws + WS_WSG));
        ph_cmp_c1(in_ptr(I_CMP_POS) + (size_t)l * 2 * 4096, in_ptr(I_CMP_W1) + (size_t)l * 2 * 4096 * 128, (float*)(ws + WS_C1));
        if (l == 0) ph_xg0(in_ptr(I_X), in_ptr(I_ATTN_NORM), (bf16*)OUTP(), (float*)(ws + WS_RSQ1));
        else ph_rowsq_reduce((const float*)(ws + WS_RSP), (float*)(ws + WS_RSQ1)); }
        GRID_BAR();
        { unsigned char* ws = WSP(); pg8::Gemm g{(bf16*)OUTP(), (bf16*)(ws + WS_WIN), M, NPROJ, D_MODEL, 0}; pg8::EpiProj E{(bf16*)(ws + WS_PROJ), (float*)(ws + WS_SMALL), (const float*)(ws + WS_RSQ1), NPROJ, PC_SMALL / 256}; pg8::StaticOrder S; S.init(M, NPROJ, G, (int)blockIdx.x);
          pg8::gemm_phase<pg8::EpiProj, pg8::StaticOrder, true, true>((PG8_LAS unsigned char*)lds_dyn, g, S, E); }
        GRID_BAR();
        { unsigned char* ws = WSP(); ph_nsa_compress_fast((bf16*)(ws + WS_PROJ), (bf16*)(ws + WS_W1T), (bf16*)(ws + WS_W2T), (float*)(ws + WS_C1), in_ptr(I_NSA_KN) + l * 128, (bf16*)(ws + WS_KCB), (bf16*)(ws + WS_VCT)); }
        { unsigned char* ws = WSP(); ph_gdn_prep_fast<0>((bf16*)(ws + WS_PROJ), (float*)(ws + WS_SMALL), in_ptr(I_CONV_A) + (size_t)l * 4 * 2304, in_ptr(I_A_LOG) + l * 6, in_ptr(I_DT_BIAS) + l * 6,
                                                      (bf16*)(ws + WS_UF), (bf16*)(ws + WS_WP), (bf16*)(ws + WS_QGP), (bf16*)(ws + WS_KDT), (bf16*)(ws + WS_AP), (float*)(ws + WS_EGL), (unsigned*)(ws + WS_CTL + CTL_QUEUE) + 64 * (8 + l)); }
        { unsigned char* ws = WSP(); ph_sgu_prep((bf16*)(ws + WS_PROJ), in_ptr(I_SGU_LN_G) + l * 512, in_ptr(I_SGU_LN_B) + l * 512, (bf16*)(ws + WS_VLN)); }
        { unsigned char* ws = WSP(); ph_nsa_prep2((bf16*)(ws + WS_PROJ), in_ptr(I_NSA_QN) + l * 128, in_ptr(I_NSA_KN) + l * 128, (bf16*)(ws + WS_NQ), (bf16*)(ws + WS_NKS), (bf16*)(ws + WS_NKW), (bf16*)(ws + WS_VST), (bf16*)(ws + WS_VWT)); }
        GRID_BAR();
        { unsigned char* ws = WSP(); ph_nsa_select_fast((bf16*)(ws + WS_NQ), (bf16*)(ws + WS_KCB), (bf16*)(ws + WS_VCT), (float*)(ws + WS_SMALL), in_ptr(I_REL_BIAS), (unsigned long long*)(ws + WS_SELM), (bf16*)(ws + WS_HB)); }
        { unsigned char* ws = WSP(); ph_sgu_mix_fast((bf16*)(ws + WS_PROJ), (bf16*)(ws + WS_VLN), (bf16*)(ws + WS_WSG), in_ptr(I_SGU_B) + l * 512, (bf16*)(ws + WS_HB), (unsigned*)(ws + WS_CTL + CTL_QUEUE) + 64 * (4 + l)); }
        GRID_BAR();
        if ((int)blockIdx.x < N_SCAN_WG) { unsigned char* ws = WSP(); ph_gdn_scan_fast((bf16*)(ws + WS_UF), (bf16*)(ws + WS_WP), (bf16*)(ws + WS_QGP), (bf16*)(ws + WS_KDT), (bf16*)(ws + WS_AP), (float*)(ws + WS_EGL), (bf16*)(ws + WS_PROJ), in_ptr(I_GDN_NORM) + l * 128, (bf16*)(ws + WS_HB), N_SCAN_WG); }
        { unsigned char* ws = WSP(); ph_nsa_main((bf16*)(ws + WS_NQ), (bf16*)(ws + WS_NKS), (bf16*)(ws + WS_NKW), (bf16*)(ws + WS_VST), (bf16*)(ws + WS_VWT), (unsigned long long*)(ws + WS_SELM), (bf16*)(ws + WS_HB),
                                                 (float*)(ws + WS_SMALL), in_ptr(I_REL_BIAS), (bf16*)(ws + WS_HB), (unsigned*)(ws + WS_CTL + CTL_QUEUE) + 64 * l); }
        GRID_BAR();
        { unsigned char* ws = WSP(); float* out = OUTP(); pg8::Gemm g{(bf16*)(ws + WS_HB), (bf16*)(ws + WS_WOUT), M, D_MODEL, D_MODEL, 0}; pg8::EpiRes E{(const bf16*)out, (bf16*)(ws + WS_XG2), nullptr, (float*)(ws + WS_RSP), D_MODEL, 0}; pg8::StaticOrder S; S.init(M, D_MODEL, G, (int)blockIdx.x);
          pg8::gemm_phase<pg8::EpiRes, pg8::StaticOrder, true, true>((PG8_LAS unsigned char*)lds_dyn, g, S, E); }
        GRID_BAR();
        { unsigned char* ws = WSP(); ph_rowsq_reduce((const float*)(ws + WS_RSP), (float*)(ws + WS_RSQ2)); }
        GRID_BAR();
        { unsigned char* ws = WSP(); pg8::Gemm g{(bf16*)(ws + WS_XG2), (bf16*)(ws + WS_WUP), M, D_FF, D_MODEL, 0}; pg8::EpiRelu2 E{(bf16*)(ws + WS_HID), (const float*)(ws + WS_RSQ2), D_FF, 0}; pg8::StaticOrder S; S.init(M, D_FF, G, (int)blockIdx.x);
          pg8::gemm_phase<pg8::EpiRelu2, pg8::StaticOrder, true, true>((PG8_LAS unsigned char*)lds_dyn, g, S, E); }
        GRID_BAR();
        { unsigned char* ws = WSP(); float* out = OUTP(); pg8::Gemm g{(bf16*)(ws + WS_HID), (bf16*)(ws + WS_WDN), M, D_MODEL, D_FF, 0}; pg8::EpiRes E{(const bf16*)(ws + WS_XG2), (bf16*)out, l + 1 < DEPTH ? nullptr : out, (float*)(ws + WS_RSP), D_MODEL, 0}; pg8::StaticOrder S; S.init(M, D_MODEL, G, (int)blockIdx.x);
          pg8::gemm_phase<pg8::EpiRes, pg8::StaticOrder, true, true>((PG8_LAS unsigned char*)lds_dyn, g, S, E); }
        GRID_BAR();
    }
}

extern "C" void kernel_launch(void* const* d_in, const int* in_sizes, int n_in, void* d_out, int out_size, void* d_ws, size_t ws_size, hipStream_t stream) {
    static int grid = 0;
    if (grid == 0) {
        if (n_in != 21 || in_sizes[0] != M * D_MODEL || out_size != M * D_MODEL || ws_size < WS_END) {
            fprintf(stderr, "kernel_launch: unexpected shapes: n_in %d in0 %d out %d ws %zu (need %zu)\n", n_in, n_in > 0 ? in_sizes[0] : -1, out_size, ws_size, (size_t)WS_END); grid = -1; return; }
        int dev = 0, cus = 0, per_cu = 0; (void)hipGetDevice(&dev); (void)hipDeviceGetAttribute(&cus, hipDeviceAttributeMultiprocessorCount, dev);
        if (hipFuncSetAttribute((const void*)mega, hipFuncAttributeMaxDynamicSharedMemorySize, LDS_BYTES) != hipSuccess) { fprintf(stderr, "kernel_launch: hipFuncSetAttribute failed\n"); grid = -1; return; }
        if (hipOccupancyMaxActiveBlocksPerMultiprocessor(&per_cu, (const void*)mega, NTHREADS, LDS_BYTES) != hipSuccess || per_cu < 1) fprintf(stderr, "kernel_launch: occupancy query says %d\n", per_cu);
        (void)hipGetLastError();
        grid = cus > 0 ? cus : 256;
    }
    if (grid < 0) return;
    (void)hipMemsetAsync((char*)d_ws + WS_CTL, 0, 65536, stream);
    Params p{};
    for (int i = 0; i < 21; ++i) p.in[i] = (const float*)d_in[i];
    p.out = (float*)d_out; p.ws = (unsigned char*)d_ws;
    hipLaunchKernelGGL(mega, dim3(grid), dim3(NTHREADS), LDS_BYTES, stream, p);
}
```

```cpp
#include <hip/hip_runtime.h>
#include <cstdio>
#include <cstdint>
namespace pg8 {
#define PG8_LAS __attribute__((address_space(3)))
typedef unsigned short bf16_t;
typedef short bf16x8 __attribute__((ext_vector_type(8)));
typedef float f32x4 __attribute__((ext_vector_type(4)));
typedef unsigned u32x4 __attribute__((ext_vector_type(4)));
constexpr int BM = 256, BK = 64, HALF = 128, HTB = HALF * BK * 2  , STAGE_BYTES = 8 * HTB, NXCD = 8, WGM = 4;

__host__ __device__ __forceinline__ int lds_byte(int r, int c) { const int st = (r >> 4) * 2 + (c >> 5), rr = r & 15, cc = c & 31, ob = rr * 64 + cc * 2; return st * 1024 + (ob ^ (((ob >> 9) & 1) << 5)); }
__host__ __device__ __forceinline__ void stage_rc(int b, int& R, int& C) { const int st = b / 1024, sb = b % 1024, swz = sb ^ (((sb >> 9) & 1) << 5); R = (st >> 1) * 16 + swz / 64; C = (st & 1) * 32 + (swz % 64) / 2; }
__host__ __device__ __forceinline__ int perm32(int rho) { const int n = rho >> 4, i = rho & 15; return 8 * (i >> 2) + 4 * n + (i & 3); }

struct Unit { int pm, pn; };
struct Gemm { const bf16_t* A; const bf16_t* Bt; int M, N, K, pad; };

struct StaticOrder {
    int nM, nN, nwg, G, c;
    __host__ __device__ void init(int M, int N, int G_, int c_) { nM = M / BM; nN = N / BM; nwg = nM * nN; G = G_; c = c_; }
    __host__ __device__ bool next(int i, Unit& u) const {
        const long L = (long)i * G + c; if (L >= nwg) return false;
        int wgid = (int)L; { const int q = nwg / NXCD, r = nwg % NXCD, xcd = wgid % NXCD, off = wgid / NXCD; wgid = (xcd < r ? xcd * (q + 1) : r * (q + 1) + (xcd - r) * q) + off; }
        const int nig = WGM * nN, gid = wgid / nig, fm = gid * WGM, gsz = (nM - fm) < WGM ? (nM - fm) : WGM;
        u.pm = fm + ((wgid % nig) % gsz); u.pn = (wgid % nig) / gsz; return true;
    }
    __device__ __forceinline__ void a_ready(const Unit&) const {}
    __device__ __forceinline__ void done(const Unit&) const {}
};
__device__ __forceinline__ unsigned cvt_pk_bf16(float lo, float hi) { unsigned r; asm volatile("v_cvt_pk_bf16_f32 %0, %1, %2" : "=v"(r) : "v"(lo), "v"(hi)); return r; }

struct EpiProj {
    static constexpr bool PERM = true, AFTER_DRAIN = false;
    bf16_t* O; float* small; const float* rowsq; int ldc; int small_pn;
    __device__ __forceinline__ void operator()(const f32x4 (&acc)[2][2][4][2], const Unit& u, int wr, int wc, int fr, int fq) const {
        const int row0 = u.pm * BM + wr * 64 + fr;
        float rs[2][4];
#pragma unroll
        for (int ai = 0; ai < 2; ++ai)
#pragma unroll
            for (int m = 0; m < 4; ++m) rs[ai][m] = rsqrtf(rowsq[row0 + ai * HALF + m * 16] * (1.0f / 2048.0f) + 1e-6f);
        if (u.pn == small_pn) {
            if (wc == 0) {
#pragma unroll
                for (int ai = 0; ai < 2; ++ai)
#pragma unroll
                    for (int m = 0; m < 4; ++m) { float* p = small + (size_t)(row0 + ai * HALF + m * 16) * 32 + 8 * fq;
                        *(f32x4*)p = acc[ai][0][m][0] * rs[ai][m]; *(f32x4*)(p + 4) = acc[ai][0][m][1] * rs[ai][m]; }
            }
            return;
        }
        const int col0 = u.pn * BM + wc * 32 + 8 * fq;
#pragma unroll
        for (int ai = 0; ai < 2; ++ai)
#pragma unroll
            for (int m = 0; m < 4; ++m) { bf16_t* rowp = O + (size_t)(row0 + ai * HALF + m * 16) * ldc + col0;
#pragma unroll
                for (int bj = 0; bj < 2; ++bj) { const f32x4 v0 = acc[ai][bj][m][0] * rs[ai][m], v1 = acc[ai][bj][m][1] * rs[ai][m];
                    u32x4 w; w.x = cvt_pk_bf16(v0[0], v0[1]); w.y = cvt_pk_bf16(v0[2], v0[3]); w.z = cvt_pk_bf16(v1[0], v1[1]); w.w = cvt_pk_bf16(v1[2], v1[3]);
                    *(u32x4*)(rowp + bj * HALF) = w; } }
    }
};
struct EpiRelu2 {
    static constexpr bool PERM = true, AFTER_DRAIN = false;
    bf16_t* O; const float* rowsq; int ldc; int pad;
    __device__ __forceinline__ void operator()(const f32x4 (&acc)[2][2][4][2], const Unit& u, int wr, int wc, int fr, int fq) const {
        const int row0 = u.pm * BM + wr * 64 + fr;
        const int col0 = u.pn * BM + wc * 32 + 8 * fq;
#pragma unroll
        for (int ai = 0; ai < 2; ++ai)
#pragma unroll
            for (int m = 0; m < 4; ++m) { bf16_t* rowp = O + (size_t)(row0 + ai * HALF + m * 16) * ldc + col0;
                const float r2 = 1.0f / (rowsq[row0 + ai * HALF + m * 16] * (1.0f / 2048.0f) + 1e-6f);
#pragma unroll
                for (int bj = 0; bj < 2; ++bj) { f32x4 v0 = acc[ai][bj][m][0], v1 = acc[ai][bj][m][1];
#pragma unroll
                    for (int j = 0; j < 4; ++j) { const float a = fmaxf(v0[j], 0.f), b = fmaxf(v1[j], 0.f); v0[j] = a * a * r2; v1[j] = b * b * r2; }
                    u32x4 w; w.x = cvt_pk_bf16(v0[0], v0[1]); w.y = cvt_pk_bf16(v0[2], v0[3]); w.z = cvt_pk_bf16(v1[0], v1[1]); w.w = cvt_pk_bf16(v1[2], v1[3]);
                    __builtin_nontemporal_store(w, (u32x4*)(rowp + bj * HALF)); } }
    }
};
struct EpiRes {
    static constexpr bool PERM = true, AFTER_DRAIN = false;
    const bf16_t* base; bf16_t* xb; float* outf; float* rowsq; int ldc; int pad;
    __device__ __forceinline__ void operator()(const f32x4 (&acc)[2][2][4][2], const Unit& u, int wr, int wc, int fr, int fq) const {
        const int row0 = u.pm * BM + wr * 64 + fr, col0 = u.pn * BM + wc * 32 + 8 * fq;
#pragma unroll
        for (int ai = 0; ai < 2; ++ai) {
            u32x4 t[4][2];
#pragma unroll
            for (int m = 0; m < 4; ++m)
#pragma unroll
                for (int bj = 0; bj < 2; ++bj) t[m][bj] = *(const u32x4*)(base + (size_t)(row0 + ai * HALF + m * 16) * ldc + col0 + bj * HALF);
#pragma unroll
            for (int m = 0; m < 4; ++m) { const int row = row0 + ai * HALF + m * 16; const size_t off = (size_t)row * ldc + col0; float ss = 0.f;
#pragma unroll
                for (int bj = 0; bj < 2; ++bj) { const u32x4 b = t[m][bj]; const f32x4 a0 = acc[ai][bj][m][0], a1 = acc[ai][bj][m][1];
                    f32x4 o0, o1;
                    o0[0] = __builtin_bit_cast(float, b.x << 16) + a0[0]; o0[1] = __builtin_bit_cast(float, b.x & 0xffff0000u) + a0[1]; o0[2] = __builtin_bit_cast(float, b.y << 16) + a0[2]; o0[3] = __builtin_bit_cast(float, b.y & 0xffff0000u) + a0[3];
                    o1[0] = __builtin_bit_cast(float, b.z << 16) + a1[0]; o1[1] = __builtin_bit_cast(float, b.z & 0xffff0000u) + a1[1]; o1[2] = __builtin_bit_cast(float, b.w << 16) + a1[2]; o1[3] = __builtin_bit_cast(float, b.w & 0xffff0000u) + a1[3];
                    ss += ((o0[0] * o0[0] + o0[1] * o0[1]) + (o0[2] * o0[2] + o0[3] * o0[3])) + ((o1[0] * o1[0] + o1[1] * o1[1]) + (o1[2] * o1[2] + o1[3] * o1[3]));
                    if (outf) { *(f32x4*)(outf + off + bj * HALF) = o0; *(f32x4*)(outf + off + bj * HALF + 4) = o1; }
                    else { u32x4 w; w.x = cvt_pk_bf16(o0[0], o0[1]); w.y = cvt_pk_bf16(o0[2], o0[3]); w.z = cvt_pk_bf16(o1[0], o1[1]); w.w = cvt_pk_bf16(o1[2], o1[3]); *(u32x4*)(xb + off + bj * HALF) = w; } }
                ss += __shfl_xor(ss, 16); ss += __shfl_xor(ss, 32);
                if (fq == 0) rowsq[(size_t)row * 32 + u.pn * 4 + wc] = ss; }
            asm volatile("" ::: "memory");
        }
    }
};
template <class Epi, class Sched, bool ALIGN_EPI = false, bool SP2 = false>
__device__ __forceinline__ void gemm_phase(PG8_LAS unsigned char* lds, const Gemm g, const Sched& S, const Epi& E) {
    int tid_ = threadIdx.x; asm volatile("" : "+v"(tid_));
    const int tid = tid_, wid = __builtin_amdgcn_readfirstlane(tid >> 6), lane = tid & 63, wr = wid >> 2, wc = wid & 3, fr = lane & 15, fq = lane >> 4;
    const int K = g.K, nt = K / BK;
    unsigned voffA[2], voffB[2];
#pragma unroll
    for (int i = 0; i < 2; ++i) { int R, C; stage_rc(tid * 16 + i * 8192, R, C); const int Rb = Epi::PERM ? ((R & ~31) + perm32(R & 31)) : R;
        voffA[i] = (unsigned)(R * K + C) * 2u; voffB[i] = (unsigned)(Rb * K + C) * 2u; }
    const size_t kstep = (size_t)(BK * 2);
    const size_t hstep = (size_t)HALF * K * 2;
    const size_t tstep = 2 * hstep;
    const unsigned ldsw = (unsigned)wid * 1024u;
    const int aoff = lds_byte(wr * 64 + fr, fq * 8), boff = lds_byte(wc * 32 + fr, fq * 8);
#define PG8_SA(b, h) (((b) * 2 + (h)) * HTB)
#define PG8_SB(b, h) ((4 + (b) * 2 + (h)) * HTB)
#define PG8_STAGE(bufoff, gbase, voff) do { _Pragma("unroll") for (int _i = 0; _i < 2; ++_i) \
        __builtin_amdgcn_global_load_lds((const unsigned*)((const char*)(gbase) + (voff)[_i]), (PG8_LAS unsigned*)(lds + (bufoff) + ldsw + _i * 8192), 16, 0, 0); } while (0)
#define PG8_LDA(dst, b, h) do { _Pragma("unroll") for (int m = 0; m < 4; ++m) _Pragma("unroll") for (int k = 0; k < 2; ++k) dst[m][k] = *(const PG8_LAS bf16x8*)(lds + PG8_SA(b, h) + aoff + m * 2048 + k * 1024); } while (0)
#define PG8_LDB(dst, b, h) do { _Pragma("unroll") for (int n = 0; n < 2; ++n) _Pragma("unroll") for (int k = 0; k < 2; ++k) dst[n][k] = *(const PG8_LAS bf16x8*)(lds + PG8_SB(b, h) + boff + n * 2048 + k * 1024); } while (0)
#define PG8_MMA(ai, bj, At, Bt) do { __builtin_amdgcn_s_setprio(1); _Pragma("unroll") for (int m = 0; m < 4; ++m) _Pragma("unroll") for (int n = 0; n < 2; ++n) _Pragma("unroll") for (int k = 0; k < 2; ++k) \
        acc[ai][bj][m][n] = __builtin_amdgcn_mfma_f32_16x16x32_bf16(Bt[n][k], At[m][k], acc[ai][bj][m][n], 0, 0, 0); __builtin_amdgcn_s_setprio(0); } while (0)
#define PG8_WAIT_V(n) asm volatile("s_waitcnt vmcnt(" #n ")" ::: "memory")
#define PG8_WAIT_L(n) asm volatile("s_waitcnt lgkmcnt(" #n ")" ::: "memory")
#define PG8_BAR __builtin_amdgcn_s_barrier()
#define PG8_SCHED __builtin_amdgcn_sched_barrier(0)
    Unit cur, nxt; int ui = 0;
    if (!S.next(0, cur)) return;
    f32x4 acc[2][2][4][2];
#pragma unroll
    for (int a = 0; a < 2; ++a)
#pragma unroll
        for (int b = 0; b < 2; ++b)
#pragma unroll
            for (int m = 0; m < 4; ++m)
#pragma unroll
                for (int n = 0; n < 2; ++n) acc[a][b][m][n] = (f32x4){0.f, 0.f, 0.f, 0.f};
    bf16x8 At[4][2], B0[2][2], B1[2][2];
    const char* cA = (const char*)g.A + (size_t)cur.pm * tstep; const char* cB = (const char*)g.Bt + (size_t)cur.pn * tstep;
    S.a_ready(cur);
    if constexpr (SP2) {
        PG8_STAGE(PG8_SB(0, 0), cB, voffB); PG8_STAGE(PG8_SB(0, 1), cB + hstep, voffB); PG8_STAGE(PG8_SA(0, 0), cA, voffA); PG8_STAGE(PG8_SA(0, 1), cA + hstep, voffA);
        if (wr == 1) PG8_BAR;
        PG8_WAIT_V(2); PG8_BAR;
        PG8_STAGE(PG8_SB(1, 0), cB + kstep, voffB); PG8_STAGE(PG8_SA(1, 0), cA + kstep, voffA); PG8_STAGE(PG8_SB(1, 1), cB + hstep + kstep, voffB);
        PG8_WAIT_V(6); PG8_BAR;
    } else {
        PG8_STAGE(PG8_SB(0, 0), cB, voffB); PG8_STAGE(PG8_SA(0, 0), cA, voffA); PG8_STAGE(PG8_SB(0, 1), cB + hstep, voffB); PG8_STAGE(PG8_SA(0, 1), cA + hstep, voffA);
        if (wr == 1) PG8_BAR;
        PG8_WAIT_V(4); PG8_BAR;
        PG8_STAGE(PG8_SB(1, 0), cB + kstep, voffB); PG8_STAGE(PG8_SA(1, 0), cA + kstep, voffA); PG8_STAGE(PG8_SB(1, 1), cB + hstep + kstep, voffB);
        PG8_WAIT_V(6); PG8_BAR;
    }
    for (;;) {
        const bool has_next = S.next(ui + 1, nxt);
        const char* nA = has_next ? (const char*)g.A + (size_t)nxt.pm * tstep : cA; const char* nB = has_next ? (const char*)g.Bt + (size_t)nxt.pn * tstep : cB;
        for (int t = 0; t < nt; t += 2) {
            const bool last = (t == nt - 2);
            const char* a1 = cA + (size_t)(t + 1) * kstep;
            const char* a2 = last ? nA : cA + (size_t)(t + 2) * kstep; const char* b2 = last ? nB : cB + (size_t)(t + 2) * kstep;
            const char* a3 = a2 + kstep; const char* b3 = b2 + kstep;
            if (last && has_next) S.a_ready(nxt);
            if constexpr (SP2) {
            PG8_LDB(B0, 0, 0); PG8_LDB(B1, 0, 1); PG8_SCHED; PG8_LDA(At, 0, 0); PG8_STAGE(PG8_SA(1, 1), a1 + hstep, voffA);
            PG8_WAIT_V(8); PG8_WAIT_L(0); PG8_BAR; PG8_MMA(0, 0, At, B0); PG8_MMA(0, 1, At, B1); PG8_BAR; PG8_SCHED;
            PG8_LDA(At, 0, 1); PG8_STAGE(PG8_SB(0, 0), b2, voffB); PG8_STAGE(PG8_SB(0, 1), b2 + hstep, voffB); PG8_STAGE(PG8_SA(0, 0), a2, voffA);
            PG8_WAIT_V(8); PG8_WAIT_L(0); PG8_BAR; PG8_MMA(1, 0, At, B0); PG8_MMA(1, 1, At, B1); PG8_BAR; PG8_SCHED;
            PG8_LDB(B0, 1, 0); PG8_LDB(B1, 1, 1); PG8_SCHED; PG8_LDA(At, 1, 0); PG8_STAGE(PG8_SA(0, 1), a2 + hstep, voffA);
            PG8_WAIT_V(8); PG8_WAIT_L(0); PG8_BAR; PG8_MMA(0, 0, At, B0); PG8_MMA(0, 1, At, B1); PG8_BAR; PG8_SCHED;
            PG8_LDA(At, 1, 1); PG8_STAGE(PG8_SB(1, 0), b3, voffB); PG8_STAGE(PG8_SB(1, 1), b3 + hstep, voffB); PG8_STAGE(PG8_SA(1, 0), a3, voffA);
            PG8_WAIT_V(8); PG8_WAIT_L(0); PG8_BAR; PG8_MMA(1, 0, At, B0); PG8_MMA(1, 1, At, B1); PG8_BAR; PG8_SCHED;
            } else {
            PG8_LDB(B0, 0, 0); PG8_SCHED; PG8_LDA(At, 0, 0); PG8_STAGE(PG8_SA(1, 1), a1 + hstep, voffA);
            PG8_WAIT_L(8); PG8_BAR; PG8_WAIT_L(0); PG8_MMA(0, 0, At, B0); PG8_BAR; PG8_SCHED;
            PG8_LDB(B1, 0, 1); PG8_STAGE(PG8_SB(0, 0), b2, voffB);
            PG8_BAR; PG8_WAIT_L(0); PG8_MMA(0, 1, At, B1); PG8_BAR;
            PG8_LDA(At, 0, 1); PG8_STAGE(PG8_SA(0, 0), a2, voffA);
            PG8_BAR; PG8_WAIT_L(0); PG8_MMA(1, 0, At, B0); PG8_BAR; PG8_SCHED;
            PG8_STAGE(PG8_SB(0, 1), b2 + hstep, voffB);
            PG8_WAIT_V(6); PG8_BAR; PG8_MMA(1, 1, At, B1); PG8_BAR;
            PG8_LDB(B0, 1, 0); PG8_SCHED; PG8_LDA(At, 1, 0); PG8_STAGE(PG8_SA(0, 1), a2 + hstep, voffA);
            PG8_WAIT_L(8); PG8_BAR; PG8_WAIT_L(0); PG8_MMA(0, 0, At, B0); PG8_BAR; PG8_SCHED;
            PG8_LDB(B1, 1, 1); PG8_STAGE(PG8_SB(1, 0), b3, voffB);
            PG8_BAR; PG8_WAIT_L(0); PG8_MMA(0, 1, At, B1); PG8_BAR;
            PG8_LDA(At, 1, 1); PG8_STAGE(PG8_SA(1, 0), a3, voffA);
            PG8_BAR; PG8_WAIT_L(0); PG8_MMA(1, 0, At, B0); PG8_BAR; PG8_SCHED;
            PG8_STAGE(PG8_SB(1, 1), b3 + hstep, voffB);
            PG8_WAIT_V(6); PG8_BAR; PG8_MMA(1, 1, At, B1); PG8_BAR;
            }
        }
        if constexpr (ALIGN_EPI) { if (wr == 0) PG8_BAR; }
        if constexpr (!Epi::AFTER_DRAIN) { E(acc, cur, wr, wc, fr, fq); S.done(cur); }
        if (!has_next) break;
#pragma unroll
        for (int a = 0; a < 2; ++a)
#pragma unroll
            for (int b = 0; b < 2; ++b)
#pragma unroll
                for (int m = 0; m < 4; ++m)
#pragma unroll
                    for (int n = 0; n < 2; ++n) acc[a][b][m][n] = (f32x4){0.f, 0.f, 0.f, 0.f};
        cur = nxt; cA = nA; cB = nB; ++ui;
        if constexpr (ALIGN_EPI) { if (wr == 1) PG8_BAR; }
    }
    PG8_WAIT_V(0);
    if constexpr (!ALIGN_EPI) { if (wr == 0) PG8_BAR; }
    PG8_BAR;
    if constexpr (Epi::AFTER_DRAIN) { E.fused(acc, cur, wr, wc, fr, fq, lds, wid, lane); S.done(cur); }
#undef PG8_SA
#undef PG8_SB
#undef PG8_STAGE
#undef PG8_LDA
#undef PG8_LDB
#undef PG8_MMA
#undef PG8_WAIT_V
#undef PG8_WAIT_L
#undef PG8_BAR
#undef PG8_SCHED
}
}

typedef unsigned short bf16;
typedef float f32x4 __attribute__((ext_vector_type(4)));
typedef float f32x2 __attribute__((ext_vector_type(2)));
typedef unsigned u32x4 __attribute__((ext_vector_type(4)));
typedef unsigned u32x2 __attribute__((ext_vector_type(2)));
constexpr int D_MODEL = 2048, BATCH = 8, SEQ = 4096, DEPTH = 4, HD = 128, D_FF = 8192;
constexpr int M = BATCH * SEQ;
constexpr int NPROJ_ORIG = 6430, NPROJ = 6656;
constexpr int PC_QA = 0, PC_KA = 768, PC_VA = 1536, PC_ZA = 2304, PC_UB = 3072, PC_VB = 3584, PC_QC = 4096, PC_KCC = 4864, PC_VCC = 5120,
              PC_KSL = 5376, PC_VSL = 5632, PC_KWN = 5888, PC_VWN = 6144, PC_SMALL = 6400;
constexpr int SM_BA = 0, SM_AA = 6, SM_GC = 12;
constexpr int N_CMP = 255;
constexpr float NORM_EPS = 1e-6f;
__host__ __device__ __forceinline__ int win_map(int n) {
    if (n < 3072) return n;
    if (n < 4096) return 3084 + (n - 3072);
    if (n < 6400) return 4108 + (n - 4096);
    if (n < 6412) return 3072 + (n - 6400);
    if (n < 6430) return n;
    return -1;
}
constexpr size_t MiB = 1u << 20;
constexpr size_t WS_CTL = 0;
constexpr size_t WS_WIN = 1 * MiB, WS_WOUT = 27 * MiB, WS_WUP = 35 * MiB, WS_WDN = 67 * MiB;
constexpr size_t WS_HB = 100 * MiB;
constexpr size_t WS_R1 = 228 * MiB;
constexpr size_t WS_PROJ = WS_R1, WS_SMALL = 644 * MiB, WS_NQ = 648 * MiB, WS_NKS = 696 * MiB, WS_NKW = 712 * MiB;
constexpr size_t WS_KCB = 728 * MiB, WS_VCT = 729 * MiB, WS_SELM = 730 * MiB, WS_EGL = 731 * MiB, WS_W1T = 732 * MiB, WS_W2T = 734 * MiB, WS_C1 = 735 * MiB, WS_WSG = 735 * MiB + 65536, WS_RSQ1 = 956 * MiB, WS_RSQ2 = 956 * MiB + 131072;
constexpr size_t WS_RSP = 1020 * MiB;
constexpr size_t WS_XG2 = 740 * MiB;
constexpr size_t WS_HID = WS_R1;
constexpr size_t WS_UF = 740 * MiB, WS_WP = 788 * MiB, WS_QGP = 836 * MiB, WS_KDT = 884 * MiB, WS_AP = 932 * MiB;
constexpr size_t WS_VLN = 956 * MiB, WS_VST = 988 * MiB, WS_VWT = 1004 * MiB, WS_KC = 1020 * MiB, WS_VC = 1022 * MiB, WS_END = 1024 * MiB;
constexpr size_t CTL_QUEUE = 32768;

__device__ __forceinline__ float bf2f(bf16 v) { return __uint_as_float(((unsigned)v) << 16); }
typedef __bf16 bf16x2_hw __attribute__((ext_vector_type(2)));
__device__ __forceinline__ unsigned pk2(float lo, float hi) { f32x2 v = {lo, hi}; return __builtin_bit_cast(unsigned, __builtin_convertvector(v, bf16x2_hw)); }
__device__ __forceinline__ bf16 f2bf(float f) { return (bf16)(pk2(f, 0.f) & 0xffffu); }
__device__ __forceinline__ float row16_sum(float x) {
    x += __builtin_bit_cast(float, __builtin_amdgcn_update_dpp(0, __builtin_bit_cast(int, x), 0x128, 0xf, 0xf, false));
    x += __builtin_bit_cast(float, __builtin_amdgcn_update_dpp(0, __builtin_bit_cast(int, x), 0x124, 0xf, 0xf, false));
    x += __builtin_bit_cast(float, __builtin_amdgcn_update_dpp(0, __builtin_bit_cast(int, x), 0x122, 0xf, 0xf, false));
    x += __builtin_bit_cast(float, __builtin_amdgcn_update_dpp(0, __builtin_bit_cast(int, x), 0x121, 0xf, 0xf, false));
    return x;
}
__device__ __forceinline__ float wave_sum(float v) {
    v = row16_sum(v);
    const float s0 = __builtin_bit_cast(float, __builtin_amdgcn_readlane(__builtin_bit_cast(int, v), 0)), s1 = __builtin_bit_cast(float, __builtin_amdgcn_readlane(__builtin_bit_cast(int, v), 16));
    const float s2 = __builtin_bit_cast(float, __builtin_amdgcn_readlane(__builtin_bit_cast(int, v), 32)), s3 = __builtin_bit_cast(float, __builtin_amdgcn_readlane(__builtin_bit_cast(int, v), 48));
    return (s0 + s1) + (s2 + s3);
}
__device__ __forceinline__ float wave_max(float v) {
#pragma unroll
    for (int o = 1; o < 64; o <<= 1) v = fmaxf(v, __shfl_xor(v, o));
    return v;
}
__device__ __forceinline__ float sigmoidf_(float x) { return 1.0f / (1.0f + __expf(-x)); }
__device__ __forceinline__ float siluf_(float x) { return x * sigmoidf_(x); }
__device__ __forceinline__ float gelu_tanh(float x) { const float u = 1.5957691216057308f * (x + 0.044715f * x * x * x); return x * __builtin_amdgcn_rcpf(1.0f + __expf(-u)); }
__device__ __forceinline__ float softplusf_(float x) { const float e = __expf(-fabsf(x)); const float lp = e < 0.01f ? e * (1.f - e * (0.5f - e * 0.33333334f)) : __logf(1.f + e); return fmaxf(x, 0.f) + lp; }
__device__ __forceinline__ int t5_bucket(int dist) {
    const int n = dist > 0 ? dist : 0;
    if (n < 16) return n;
    const float lr = logf((float)n / 16.0f) / 2.0794415416798357f;
    const int large = 16 + (int)(lr * 16.0f);
    return large < 31 ? large : 31;
}

#define XB_TMO      128
#define XB_XCNT(j)  (256  + 64 * (j))
#define XB_XSUB(j)  (1280 + 64 * (j))
#define XB_XGEN(j)  (2304 + 64 * (j))
#define XB_TOP      3328
#define XB_TOPGEN   3392
#define XCD_BAR_WORDS 3456
#define XB_SPIN_CAP (1u << 18)
#define LAS __attribute__((address_space(3)))

__device__ __forceinline__ unsigned xb_ld(unsigned* p)              { return __hip_atomic_load(p, __ATOMIC_RELAXED, __HIP_MEMORY_SCOPE_AGENT); }
__device__ __forceinline__ unsigned xb_add(unsigned* p, unsigned v) { return __hip_atomic_fetch_add(p, v, __ATOMIC_RELAXED, __HIP_MEMORY_SCOPE_AGENT); }
__device__ __forceinline__ unsigned xb_xcc_id() { return (unsigned)__builtin_amdgcn_s_getreg((3 << 11) | 20) & 0xFu; }
#define XB_SPIN(cond, bar) do { unsigned _sp = 0; while (cond) { __builtin_amdgcn_s_sleep(1); \
    if ((++_sp & 255u) == 0u) { if (xb_ld(&(bar)[XB_TMO])) break; if (_sp > XB_SPIN_CAP) { atomicAdd(&(bar)[XB_TMO], 1u); break; } } } } while (0)

struct XcdBarrier {
    unsigned* bar; unsigned x;
    volatile LAS unsigned* st;
};

__device__ __forceinline__ XcdBarrier xcd_barrier_post(unsigned* bar, volatile LAS unsigned* st) {
    XcdBarrier b; b.bar = bar; b.x = xb_xcc_id(); b.st = st;
    if (threadIdx.x == 0) (void)xb_add(&bar[XB_XCNT(b.x)], 1u);
    return b;
}
__device__ __forceinline__ void xcd_barrier_complete(unsigned* bar, unsigned x, unsigned& nloc, unsigned& nx) {
    const unsigned G = gridDim.x * gridDim.y * gridDim.z;
    unsigned sum, cnt, mine, sp = 0u;
    for (;;) {
        sum = 0u; cnt = 0u; mine = 0u;
#pragma unroll
        for (unsigned j = 0; j < 16; ++j) { const unsigned c = xb_ld(&bar[XB_XCNT(j)]); sum += c; cnt += (c > 0u) ? 1u : 0u; mine = (j == x) ? c : mine; }
        if (sum == G) break;
        __builtin_amdgcn_s_sleep(1);
        if ((++sp & 255u) == 0u) { if (xb_ld(&bar[XB_TMO])) break; if (sp > XB_SPIN_CAP) { atomicAdd(&bar[XB_TMO], 1u); break; } }
    }
    nloc = mine > 0u ? mine : 1u; nx = cnt > 0u ? cnt : 1u;
}

__device__ __forceinline__ void xcd_barrier(const XcdBarrier& b) {
    asm volatile("s_waitcnt vmcnt(0)" ::: "memory");
    __syncthreads();
    if (threadIdx.x == 0) {
        unsigned* bar = b.bar;
        __builtin_amdgcn_s_waitcnt(0);
        unsigned nloc = b.st[0], nx = b.st[1];
        if (nloc == 0u) { xcd_barrier_complete(bar, b.x, nloc, nx); b.st[0] = nloc; b.st[1] = nx; }
        const unsigned old = xb_add(&bar[XB_XSUB(b.x)], 1u);
        const unsigned gen = old / nloc;
        if (old + 1u == (gen + 1u) * nloc) {
            __builtin_amdgcn_fence(__ATOMIC_RELEASE, "agent");
            asm volatile("s_waitcnt vmcnt(0)" ::: "memory");
            const unsigned og = xb_add(&bar[XB_TOP], 1u);
            const unsigned tg = og / nx;
            if (og + 1u == (tg + 1u) * nx) xb_add(&bar[XB_TOPGEN], 1u);
            else XB_SPIN(xb_ld(&bar[XB_TOPGEN]) == tg, bar);
            __builtin_amdgcn_fence(__ATOMIC_ACQUIRE, "agent");
            xb_add(&bar[XB_XGEN(b.x)], 1u);
            asm volatile("s_waitcnt vmcnt(0)" ::: "memory");
        } else {
            XB_SPIN(xb_ld(&bar[XB_XGEN(b.x)]) == gen, bar);
            __builtin_amdgcn_fence(__ATOMIC_ACQUIRE, "agent");
            asm volatile("s_waitcnt vmcnt(0)" ::: "memory");
        }
    }
    __syncthreads();
}

#define LAS __attribute__((address_space(3)))
constexpr int NWAVES = 8, NTHREADS = 512;
constexpr int LDS_BYTES = 147456;
constexpr int LDS_MISC = LDS_BYTES - 256;
struct Params { const float* in[21]; float* out; unsigned char* ws; };
constexpr int LDS_PTAB = LDS_MISC + 16;
__device__ __forceinline__ int ltid() { int t = threadIdx.x; asm volatile("" : "+v"(t)); return t; }
__device__ __forceinline__ unsigned long long lds_ptr_raw(int i) {
    extern __shared__ __attribute__((aligned(16))) unsigned char lds_dyn[];
    const volatile LAS unsigned long long* tab = (const volatile LAS unsigned long long*)(lds_dyn + LDS_PTAB);
    int ii = i; asm volatile("" : "+v"(ii));
    const unsigned long long v = tab[ii];
    const unsigned lo = __builtin_amdgcn_readfirstlane((unsigned)v), hi = __builtin_amdgcn_readfirstlane((unsigned)(v >> 32));
    return ((unsigned long long)hi << 32) | lo;
}
#define GAS __attribute__((address_space(1)))
__device__ __forceinline__ unsigned char* gptr(int i) { return (unsigned char*)(GAS unsigned char*)lds_ptr_raw(i); }
__device__ __forceinline__ const float* in_ptr(int i) { return (const float*)gptr(i); }
enum { I_X = 0, I_ATTN_NORM, I_W_IN, I_CONV_A, I_A_LOG, I_DT_BIAS, I_GDN_NORM, I_SGU_LN_G, I_SGU_LN_B, I_SGU_W, I_SGU_B, I_NSA_QN, I_NSA_KN, I_CMP_POS, I_CMP_W1, I_CMP_W2, I_REL_BIAS, I_W_OUT, I_MLP_NORM, I_W_UP, I_W_DOWN };

template <int MAP> __device__ __forceinline__ void ph_transpose(const float* __restrict__ W, int K, int N_orig, bf16* __restrict__ WT, int N_out, const float* __restrict__ kscale = nullptr) {
    extern __shared__ __attribute__((aligned(16))) unsigned char lds_dyn[];
    const int tid = ltid(); const int lane = tid & 63, wave = tid >> 6;
    float* scr = (float*)lds_dyn + wave * (64 * 65);
    const int nblk = N_out / 64, nitems = (K / 64) * nblk;
    const int ksub = lane >> 4, n4 = (lane & 15) * 4;
    for (int it = blockIdx.x * NWAVES + wave; it < nitems; it += gridDim.x * NWAVES) {
        const int kb = it / nblk, nb = it % nblk, k0 = 64 * kb, n0 = 64 * nb;
        const int ng = n0 + n4; const int no = MAP ? win_map(ng) : ng;
        const bool vec = MAP ? (no >= 0 && win_map(ng + 3) == no + 3) : true;
        f32x4 v[16];
        if (vec) {
#pragma unroll
            for (int i = 0; i < 16; ++i) { const float* p = W + (size_t)(k0 + 4 * i + ksub) * N_orig + no; if (MAP) { const f32x2 a0 = *(const f32x2*)p, a1 = *(const f32x2*)(p + 2); v[i] = (f32x4){a0.x, a0.y, a1.x, a1.y}; }
                else v[i] = *(const f32x4*)p; }
        } else {
#pragma unroll
            for (int i = 0; i < 16; ++i) { const float* p = W + (size_t)(k0 + 4 * i + ksub) * N_orig;
#pragma unroll
                for (int e = 0; e < 4; ++e) { const int ne = MAP ? win_map(ng + e) : ng + e; v[i][e] = ne >= 0 ? p[ne] : 0.f; } }
        }
        if (kscale) {
#pragma unroll
            for (int i = 0; i < 16; ++i) v[i] *= kscale[k0 + 4 * i + ksub]; }
#pragma unroll
        for (int i = 0; i < 16; ++i) { float* d = scr + (4 * i + ksub) * 65 + n4; d[0] = v[i].x; d[1] = v[i].y; d[2] = v[i].z; d[3] = v[i].w; }
        __builtin_amdgcn_s_waitcnt(0); asm volatile("" ::: "memory");
        const int c = lane & 7;
#pragma unroll
        for (int j = 0; j < 8; ++j) { const int nn = (lane >> 3) + 8 * j; const float* sp = scr + (8 * c) * 65 + nn;
            u32x4 o; o.x = pk2(sp[0 * 65], sp[1 * 65]); o.y = pk2(sp[2 * 65], sp[3 * 65]); o.z = pk2(sp[4 * 65], sp[5 * 65]); o.w = pk2(sp[6 * 65], sp[7 * 65]);
            *(u32x4*)(WT + (size_t)(n0 + nn) * K + k0 + 8 * c) = o; }
        __builtin_amdgcn_s_waitcnt(0); asm volatile("" ::: "memory");
    }
}

__device__ __forceinline__ void ph_rmsnorm(const float* __restrict__ x, const float* __restrict__ gain, bf16* __restrict__ out) {
    const int tid = ltid(); const int lane = tid & 63; const int gw = blockIdx.x * NWAVES + (tid >> 6), ngw = gridDim.x * NWAVES;
    for (int m = gw; m < M; m += ngw) {
        const f32x4* xr = (const f32x4*)(x + (size_t)m * D_MODEL) + lane; f32x4 v[8]; float s = 0.f;
#pragma unroll
        for (int j = 0; j < 8; ++j) { v[j] = xr[64 * j]; s += (v[j].x * v[j].x + v[j].y * v[j].y) + (v[j].z * v[j].z + v[j].w * v[j].w); }
        const float rstd = rsqrtf(wave_sum(s) * (1.f / D_MODEL) + NORM_EPS);
        u32x2* o = (u32x2*)(out + (size_t)m * D_MODEL) + lane;
#pragma unroll
        for (int j = 0; j < 8; ++j) { const f32x4 g = ((const f32x4*)gain)[64 * j + lane]; u32x2 w; w.x = pk2(v[j].x * rstd * g.x, v[j].y * rstd * g.y); w.y = pk2(v[j].z * rstd * g.z, v[j].w * rstd * g.w); o[64 * j] = w; }
    }
}

__device__ __forceinline__ void ph_xg0(const float* __restrict__ x, const float* __restrict__ gain, bf16* __restrict__ xg, float* __restrict__ rowsq) {
    const int tid = ltid(); const int lane = tid & 63; const int gw = blockIdx.x * NWAVES + (tid >> 6), ngw = gridDim.x * NWAVES;
    for (int m = gw; m < M; m += ngw) {
        const f32x4* xr = (const f32x4*)(x + (size_t)m * D_MODEL) + lane; f32x4 v[8]; float s = 0.f;
#pragma unroll
        for (int j = 0; j < 8; ++j) { v[j] = xr[64 * j]; s += (v[j].x * v[j].x + v[j].y * v[j].y) + (v[j].z * v[j].z + v[j].w * v[j].w); }
        s = wave_sum(s); if (lane == 0) rowsq[m] = s;
        u32x2* o = (u32x2*)(xg + (size_t)m * D_MODEL) + lane;
#pragma unroll
        for (int j = 0; j < 8; ++j) { u32x2 w; w.x = pk2(v[j].x, v[j].y); w.y = pk2(v[j].z, v[j].w); o[64 * j] = w; }
    }
}
__device__ __forceinline__ void ph_rowsq_reduce(const float* __restrict__ part, float* __restrict__ rowsq) {
    const int tid = ltid();
    for (int r = blockIdx.x * NTHREADS + tid; r < M; r += gridDim.x * NTHREADS) { const f32x4* p = (const f32x4*)(part + (size_t)r * 32); float s = 0.f;
#pragma unroll
        for (int j = 0; j < 8; ++j) { const f32x4 v = p[j]; s += (v.x + v.y) + (v.z + v.w); }
        rowsq[r] = s; }
}
__device__ __forceinline__ void ph_zero_f32(float* __restrict__ p, int n) { const int tid = ltid(); for (int i = blockIdx.x * NTHREADS + tid; i < n; i += gridDim.x * NTHREADS) p[i] = 0.f; }
__device__ __forceinline__ void ph_gdn_prep(const bf16* __restrict__ proj, const float* __restrict__ small, const float* __restrict__ conv_w, const float* __restrict__ a_log,
                                            const float* __restrict__ dt_bias, bf16* __restrict__ GQ, float* __restrict__ BG) {
    const int tid = ltid(); const int lane = tid & 63; const int gw = blockIdx.x * NWAVES + (tid >> 6), ngw = gridDim.x * NWAVES;
    for (int p = gw; p < M * 18; p += ngw) {
        const int m = p / 18, j = p % 18, t = m & (SEQ - 1), c = j * 128 + lane * 2;
        float y0 = 0.f, y1 = 0.f;
#pragma unroll
        for (int tap = 0; tap < 4; ++tap) { const int tt = t - 3 + tap; if (tt >= 0) { const unsigned pr = *(const unsigned*)(proj + (size_t)(m - 3 + tap) * NPROJ + c);
            y0 += conv_w[tap * 2304 + c] * bf2f((bf16)(pr & 0xffff)); y1 += conv_w[tap * 2304 + c + 1] * bf2f((bf16)(pr >> 16)); } }
        y0 = siluf_(y0); y1 = siluf_(y1);
        if (j < 12) { const float ss = wave_sum(y0 * y0 + y1 * y1); float r = rsqrtf(ss + NORM_EPS); if (j < 6) r *= 0.08838834764831845f; y0 *= r; y1 *= r; }
        *(unsigned*)(GQ + (size_t)m * 2304 + c) = pk2(y0, y1);
    }
    for (int i = blockIdx.x * NTHREADS + tid; i < M * 6; i += gridDim.x * NTHREADS) { const int m = i / 6, h = i % 6;
        BG[(size_t)m * 12 + h] = sigmoidf_(small[(size_t)m * 32 + SM_BA + h]);
        BG[(size_t)m * 12 + 6 + h] = -__expf(a_log[h]) * softplusf_(small[(size_t)m * 32 + SM_AA + h] + dt_bias[h]); }
}
__device__ __forceinline__ void ph_gdn_scan(const bf16* __restrict__ GQ, const float* __restrict__ BG, const bf16* __restrict__ proj, const float* __restrict__ norm_g, bf16* __restrict__ mix, int nblk_scan) {
    extern __shared__ __attribute__((aligned(16))) unsigned char lds_dyn[];
    float (*sq)[144] = (float (*)[144])lds_dyn; float (*sk)[144] = (float (*)[144])(lds_dyn + 8 * 144 * 4);
    float (*sv)[128] = (float (*)[128])(lds_dyn + 16 * 144 * 4); float (*osh)[128] = (float (*)[128])(lds_dyn + 16 * 144 * 4 + 8 * 128 * 4);
    float (*sc)[2] = (float (*)[2])(lds_dyn + 16 * 144 * 4 + 16 * 128 * 4);
    const int tid = ltid(); const int c = tid >> 2, p = tid & 3, lane = tid & 63, wave = tid >> 6;
    for (int bh = blockIdx.x; bh < BATCH * 6; bh += nblk_scan) {
        const int b = bh / 6, h = bh % 6;
        float S[32];
#pragma unroll
        for (int j = 0; j < 32; ++j) S[j] = 0.f;
        for (int t0 = 0; t0 < SEQ; t0 += 8) {
            for (int i = tid; i < 8 * 384; i += NTHREADS) { const int tt = i / 384, r = i % 384, which = r >> 7, d = r & 127;
                const float v = bf2f(GQ[(size_t)(b * SEQ + t0 + tt) * 2304 + which * 768 + h * 128 + d]);
                if (which == 0) sq[tt][(d >> 5) * 36 + (d & 31)] = v; else if (which == 1) sk[tt][(d >> 5) * 36 + (d & 31)] = v; else sv[tt][d] = v; }
            if (tid < 8) { const size_t m = (size_t)b * SEQ + t0 + tid; sc[tid][0] = BG[m * 12 + h]; sc[tid][1] = __expf(BG[m * 12 + 6 + h]); }
            __syncthreads();
#pragma unroll 1
            for (int tt = 0; tt < 8; ++tt) {
                const float beta = sc[tt][0], eg = sc[tt][1];
                float kS = 0.f;
#pragma unroll
                for (int j = 0; j < 32; ++j) kS += sk[tt][p * 36 + j] * S[j];
                kS += __shfl_xor(kS, 1); kS += __shfl_xor(kS, 2);
                const float coef = beta * (sv[tt][c] - eg * kS);
                float o = 0.f;
#pragma unroll
                for (int j = 0; j < 32; ++j) { S[j] = eg * S[j] + sk[tt][p * 36 + j] * coef; o += sq[tt][p * 36 + j] * S[j]; }
                o += __shfl_xor(o, 1); o += __shfl_xor(o, 2);
                if (p == 0) osh[tt][c] = o;
            }
            __syncthreads();
            { const int tt = wave; const size_t m = (size_t)b * SEQ + t0 + tt; const int c0 = lane * 2;
              const float o0 = osh[tt][c0], o1 = osh[tt][c0 + 1]; const float rstd = rsqrtf(wave_sum(o0 * o0 + o1 * o1) * (1.f / 128.f) + NORM_EPS);
              const unsigned zz = *(const unsigned*)(proj + m * NPROJ + PC_ZA + h * 128 + c0);
              const float r0 = o0 * rstd * norm_g[c0] * siluf_(bf2f((bf16)(zz & 0xffff))), r1 = o1 * rstd * norm_g[c0 + 1] * siluf_(bf2f((bf16)(zz >> 16)));
              *(unsigned*)(mix + m * D_MODEL + h * 128 + c0) = pk2(r0, r1); }
            __syncthreads();
        }
    }
}

__device__ __forceinline__ void ph_sgu_prep(const bf16* __restrict__ proj, const float* __restrict__ ln_g, const float* __restrict__ ln_b, bf16* __restrict__ VLN) {
    const int tid = ltid(); const int lane = tid & 63; const int gw = blockIdx.x * NWAVES + (tid >> 6), ngw = gridDim.x * NWAVES;
    float lg[8], lb[8];
#pragma unroll
    for (int j = 0; j < 8; ++j) { lg[j] = ln_g[lane * 8 + j]; lb[j] = ln_b[lane * 8 + j]; }
    for (int m0 = gw; m0 < M; m0 += 4 * ngw) {
        u32x4 raw4[4];
#pragma unroll
        for (int k = 0; k < 4; ++k) { const int m = m0 + k * ngw < M ? m0 + k * ngw : m0; raw4[k] = *(const u32x4*)(proj + (size_t)m * NPROJ + PC_VB + lane * 8); }
#pragma unroll
        for (int k = 0; k < 4; ++k) { const int m = m0 + k * ngw;
            if (m < M) {
                float v[8]; const unsigned rw[4] = {raw4[k].x, raw4[k].y, raw4[k].z, raw4[k].w};
                float s = 0.f;
#pragma unroll
                for (int j = 0; j < 4; ++j) { v[2 * j] = gelu_tanh(bf2f((bf16)(rw[j] & 0xffff))); v[2 * j + 1] = gelu_tanh(bf2f((bf16)(rw[j] >> 16))); s += v[2 * j] + v[2 * j + 1]; }
                const float mu = wave_sum(s) * (1.f / 512.f); float q = 0.f;
#pragma unroll
                for (int j = 0; j < 8; ++j) { v[j] -= mu; q += v[j] * v[j]; }
                const float rstd = rsqrtf(wave_sum(q) * (1.f / 512.f) + NORM_EPS);
                u32x4 o; unsigned ow[4];
#pragma unroll
                for (int j = 0; j < 4; ++j) ow[j] = pk2(v[2 * j] * rstd * lg[2 * j] + lb[2 * j], v[2 * j + 1] * rstd * lg[2 * j + 1] + lb[2 * j + 1]);
                o.x = ow[0]; o.y = ow[1]; o.z = ow[2]; o.w = ow[3];
                *(u32x4*)(VLN + (size_t)m * 512 + lane * 8) = o;
            } }
    }
}
__device__ __forceinline__ void ph_sgu_mix(const bf16* __restrict__ proj, const bf16* __restrict__ VLN, const float* __restrict__ sgu_w, const float* __restrict__ sgu_b, bf16* __restrict__ mix, int first, int count) {
    extern __shared__ __attribute__((aligned(16))) unsigned char lds_dyn[];
    bf16 (*vs)[128] = (bf16 (*)[128])lds_dyn;
    const int tid = ltid();
    if ((int)blockIdx.x < first) return;
    for (int item = blockIdx.x - first; item < BATCH * 32 * 4; item += count) {
        const int g = item & 3, n = (item >> 2) & 31, b = item >> 7;
        const size_t m0 = (size_t)b * SEQ + n * 128;
        __syncthreads();
        for (int i = tid; i < 128 * 128; i += NTHREADS) { const int s = i >> 7, c = i & 127; vs[s][c] = VLN[(m0 + s) * 512 + g * 128 + c]; }
        __syncthreads();
        const int c = tid & 127, tq = tid >> 7;
        for (int t = tq * 32; t < tq * 32 + 32; ++t) {
            const float* wr = sgu_w + ((size_t)g * 128 + t) * 128; float acc = 0.f;
            for (int s = 0; s <= t; ++s) acc += wr[s] * bf2f(vs[s][c]);
            const float u = gelu_tanh(bf2f(proj[(m0 + t) * NPROJ + PC_UB + g * 128 + c]));
            mix[(m0 + t) * D_MODEL + 768 + g * 128 + c] = f2bf(u * (acc + sgu_b[g * 128 + t]));
        }
    }
    __syncthreads();
}

__device__ __forceinline__ void ph_nsa_prep(const bf16* __restrict__ proj, const float* __restrict__ qg, const float* __restrict__ kg, bf16* __restrict__ NQ, bf16* __restrict__ NKS, bf16* __restrict__ NKW) {
    const int tid = ltid(); const int lane = tid & 63; const int gw = blockIdx.x * NWAVES + (tid >> 6), ngw = gridDim.x * NWAVES;
    for (int p = gw; p < M * 10; p += ngw) {
        const int m = p / 10, j = p % 10, c0 = lane * 2;
        const int src = j < 6 ? PC_QC + j * 128 : (j < 8 ? PC_KSL + (j - 6) * 128 : PC_KWN + (j - 8) * 128);
        const unsigned pr = *(const unsigned*)(proj + (size_t)m * NPROJ + src + c0);
        float y0 = bf2f((bf16)(pr & 0xffff)), y1 = bf2f((bf16)(pr >> 16));
        float r = rsqrtf(wave_sum(y0 * y0 + y1 * y1) * (1.f / 128.f) + NORM_EPS);
        const float* gn = j < 6 ? qg : kg; if (j < 6) r *= 0.08838834764831845f;
        const unsigned o = pk2(y0 * r * gn[c0], y1 * r * gn[c0 + 1]);
        if (j < 6) *(unsigned*)(NQ + (size_t)m * 768 + j * 128 + c0) = o;
        else if (j < 8) *(unsigned*)(NKS + (size_t)m * 256 + (j - 6) * 128 + c0) = o;
        else *(unsigned*)(NKW + (size_t)m * 256 + (j - 8) * 128 + c0) = o;
    }
}
__device__ __forceinline__ void ph_nsa_compress(const bf16* __restrict__ proj, const float* __restrict__ pos, const float* __restrict__ w1, const float* __restrict__ w2, const float* __restrict__ kg,
                                                bf16* __restrict__ KCB, bf16* __restrict__ VCT) {
    extern __shared__ __attribute__((aligned(16))) unsigned char lds_dyn[];
    bf16 (*tok)[128] = (bf16 (*)[128])lds_dyn;
    float (*posl)[128] = (float (*)[128])(lds_dyn + 144 * 128 * 2);
    float (*hid)[128] = (float (*)[128])(lds_dyn + 144 * 128 * 2 + 32 * 128 * 4);
    float (*red)[2] = (float (*)[2])(lds_dyn + 144 * 128 * 2 + 32 * 128 * 4 + 8 * 128 * 4);
    const int tid = ltid(); const int j = tid & 127, q4 = tid >> 7;
    for (int item = blockIdx.x; item < 1024; item += gridDim.x) {
        const int kv = item & 1, grp = (item >> 1) & 31, g = (item >> 6) & 1, b = item >> 7, n0 = grp * 8;
        const int col = (kv == 0 ? PC_KCC : PC_VCC) + g * 128;
        __syncthreads();
        for (int i = tid; i < 144 * 128; i += NTHREADS) { const int tk = i >> 7, d = i & 127; const int t = 16 * n0 + tk; tok[tk][d] = t < SEQ ? proj[(size_t)(b * SEQ + t) * NPROJ + col + d] : (bf16)0; }
        for (int i = tid; i < 32 * 128; i += NTHREADS) posl[i >> 7][i & 127] = pos[(size_t)kv * 4096 + i];
        __syncthreads();
        float acc0 = 0.f, acc1 = 0.f;
        const float* w1p = w1 + (size_t)kv * 4096 * 128 + j;
        for (int l = 0; l < 32; ++l)
#pragma unroll 4
            for (int d = 0; d < 128; ++d) { const float w = w1p[(size_t)(l * 128 + d) * 128]; const float pp = posl[l][d];
                acc0 += (bf2f(tok[16 * (2 * q4) + l][d]) + pp) * w; acc1 += (bf2f(tok[16 * (2 * q4 + 1) + l][d]) + pp) * w; }
        hid[2 * q4][j] = gelu_tanh(acc0); hid[2 * q4 + 1][j] = gelu_tanh(acc1);
        __syncthreads();
        float out0 = 0.f, out1 = 0.f;
        const float* w2p = w2 + (size_t)kv * 128 * 128 + j;
        for (int i = 0; i < 128; ++i) { const float w = w2p[(size_t)i * 128]; out0 += hid[2 * q4][i] * w; out1 += hid[2 * q4 + 1][i] * w; }
        if (kv == 0) {
            const float s0 = wave_sum(out0 * out0), s1 = wave_sum(out1 * out1);
            if ((tid & 63) == 0) { red[2 * q4][(tid >> 6) & 1] = s0; red[2 * q4 + 1][(tid >> 6) & 1] = s1; }
            __syncthreads();
            out0 *= rsqrtf((red[2 * q4][0] + red[2 * q4][1]) * (1.f / 128.f) + NORM_EPS) * kg[j];
            out1 *= rsqrtf((red[2 * q4 + 1][0] + red[2 * q4 + 1][1]) * (1.f / 128.f) + NORM_EPS) * kg[j];
        }
#pragma unroll
        for (int e = 0; e < 2; ++e) { const int n = n0 + 2 * q4 + e; const float o = n < N_CMP ? (e ? out1 : out0) : 0.f;
            if (kv == 0) KCB[((size_t)(b * 2 + g) * 256 + n) * 128 + j] = f2bf(o);
            else VCT[((size_t)(b * 2 + g) * 128 + j) * 256 + (n & ~15) + ((n & 3) | ((n & 4) << 1) | ((n & 8) >> 1))] = f2bf(o); }
    }
    __syncthreads();
}
__device__ __forceinline__ void ph_nsa_attn(const bf16* __restrict__ NQ, const bf16* __restrict__ NKS, const bf16* __restrict__ NKW, const bf16* __restrict__ proj,
                                            const float* __restrict__ KC, const float* __restrict__ VC, const float* __restrict__ small, const float* __restrict__ rel_bias, bf16* __restrict__ mix, int first, int count) {
    extern __shared__ __attribute__((aligned(16))) unsigned char lds_dyn[];
    const int tid = ltid(); const int lane = tid & 63, wave = tid >> 6;
    if ((int)blockIdx.x < first) return;
    float (*bias_s)[6] = (float (*)[6])(lds_dyn + 8 * 16896);
    __syncthreads();
    for (int i = tid; i < 192; i += NTHREADS) bias_s[i / 6][i % 6] = rel_bias[i];
    __syncthreads();
    float (*qs)[128] = (float (*)[128])(lds_dyn + wave * 16896); float (*pc)[256] = (float (*)[256])(lds_dyn + wave * 16896 + 1536); float (*sc)[1024] = (float (*)[1024])(lds_dyn + wave * 16896 + 4608);
    for (int idx = (blockIdx.x - first) * NWAVES + wave; idx < M * 2; idx += count * NWAVES) {
    const int t = idx & (SEQ - 1), g = (idx >> 12) & 1, b = idx >> 13;
    const size_t m = (size_t)b * SEQ + t;
    for (int i = lane; i < 384; i += 64) qs[i >> 7][i & 127] = bf2f(NQ[m * 768 + g * 384 + i]);
    __builtin_amdgcn_s_waitcnt(0); asm volatile("" ::: "memory");
    const int hb = g * 3;
    float oc[3][2], os[3][2], ow[3][2];
    const int nvalid = t >= 31 ? ((t - 31) >> 4) + 1 : 0;
    {
        float mx[3] = {-3.0e38f, -3.0e38f, -3.0e38f};
        for (int base = 0; base < 256; base += 64) { const int n = base + lane; float s[3] = {-3.0e38f, -3.0e38f, -3.0e38f};
            if (n < nvalid) { const f32x4* kr = (const f32x4*)(KC + ((size_t)(b * 2 + g) * N_CMP + n) * 128); float a0 = 0.f, a1 = 0.f, a2 = 0.f;
#pragma unroll 2
                for (int d = 0; d < 32; ++d) { const f32x4 kk = kr[d]; const f32x4 q0 = *(const f32x4*)&qs[0][4 * d], q1 = *(const f32x4*)&qs[1][4 * d], q2 = *(const f32x4*)&qs[2][4 * d];
                    a0 += kk.x * q0.x + kk.y * q0.y + kk.z * q0.z + kk.w * q0.w; a1 += kk.x * q1.x + kk.y * q1.y + kk.z * q1.z + kk.w * q1.w; a2 += kk.x * q2.x + kk.y * q2.y + kk.z * q2.z + kk.w * q2.w; }
                const int bk = t5_bucket(t - (16 * n + 31)); s[0] = a0 + bias_s[bk][hb]; s[1] = a1 + bias_s[bk][hb + 1]; s[2] = a2 + bias_s[bk][hb + 2]; }
#pragma unroll
            for (int r = 0; r < 3; ++r) { pc[r][n] = s[r]; mx[r] = fmaxf(mx[r], s[r]); } }
#pragma unroll
        for (int r = 0; r < 3; ++r) { mx[r] = wave_max(mx[r]); float sum = 0.f;
            for (int base = 0; base < 256; base += 64) { const int n = base + lane; const float e = n < nvalid ? __expf(pc[r][n] - mx[r]) : 0.f; pc[r][n] = e; sum += e; }
            sum = wave_sum(sum); const float inv = 1.0f / fmaxf(sum, 1e-30f);
            for (int base = 0; base < 256; base += 64) pc[r][base + lane] *= inv; }
        __builtin_amdgcn_s_waitcnt(0); asm volatile("" ::: "memory");
#pragma unroll
        for (int r = 0; r < 3; ++r) { oc[r][0] = 0.f; oc[r][1] = 0.f; }
        for (int n = 0; n < nvalid; ++n) { const f32x2 vv = *(const f32x2*)(VC + ((size_t)(b * 2 + g) * N_CMP + n) * 128 + 2 * lane);
#pragma unroll
            for (int r = 0; r < 3; ++r) { const float p = pc[r][n]; oc[r][0] += p * vv.x; oc[r][1] += p * vv.y; } }
    }
    unsigned long long mask;
    {
        const int j = lane, cur = t >> 6; float imp = 0.f;
        for (int n = 4 * j - 1; n <= 4 * j + 3; ++n) if (n >= 0 && n < N_CMP) imp += pc[0][n] + pc[1][n] + pc[2][n];
        const bool forced = (j == 0) || (j == cur) || (j == cur - 1);
        const float score = forced ? 1e9f : (j <= cur ? imp : -1e30f);
        int rank = 0;
        for (int i = 0; i < 64; ++i) { const float si = __shfl(score, i); rank += (si > score || (si == score && i < j)) ? 1 : 0; }
        mask = __ballot(rank < 16 && j <= cur);
    }
    {
        float mx[3] = {-3.0e38f, -3.0e38f, -3.0e38f}; int slot = 0;
        for (unsigned long long mm = mask; mm; mm &= mm - 1, ++slot) { const int blk = __builtin_ctzll(mm); const int kpos = blk * 64 + lane; float s[3] = {-3.0e38f, -3.0e38f, -3.0e38f};
            if (kpos <= t) { const u32x4* kr = (const u32x4*)(NKS + ((size_t)b * SEQ + kpos) * 256 + g * 128); float a0 = 0.f, a1 = 0.f, a2 = 0.f;
#pragma unroll 2
                for (int d = 0; d < 16; ++d) { const u32x4 kk = kr[d]; const unsigned kw[4] = {kk.x, kk.y, kk.z, kk.w};
#pragma unroll
                    for (int e = 0; e < 4; ++e) { const float k0 = bf2f((bf16)(kw[e] & 0xffff)), k1 = bf2f((bf16)(kw[e] >> 16)); const int dd = 8 * d + 2 * e;
                        a0 += k0 * qs[0][dd] + k1 * qs[0][dd + 1]; a1 += k0 * qs[1][dd] + k1 * qs[1][dd + 1]; a2 += k0 * qs[2][dd] + k1 * qs[2][dd + 1]; } }
                const int bk = t5_bucket(t - kpos); s[0] = a0 + bias_s[bk][hb]; s[1] = a1 + bias_s[bk][hb + 1]; s[2] = a2 + bias_s[bk][hb + 2]; }
#pragma unroll
            for (int r = 0; r < 3; ++r) { sc[r][slot * 64 + lane] = s[r]; mx[r] = fmaxf(mx[r], s[r]); } }
        const int nslot = slot; float inv[3];
#pragma unroll
        for (int r = 0; r < 3; ++r) { mx[r] = wave_max(mx[r]); float sum = 0.f;
            for (int i = lane; i < nslot * 64; i += 64) { const float sv = sc[r][i]; const float e = sv > -1.0e38f ? __expf(sv - mx[r]) : 0.f; sc[r][i] = e; sum += e; }
            sum = wave_sum(sum); inv[r] = 1.0f / fmaxf(sum, 1e-30f); }
        __builtin_amdgcn_s_waitcnt(0); asm volatile("" ::: "memory");
#pragma unroll
        for (int r = 0; r < 3; ++r) { os[r][0] = 0.f; os[r][1] = 0.f; }
        slot = 0;
        for (unsigned long long mm = mask; mm; mm &= mm - 1, ++slot) { const int blk = __builtin_ctzll(mm); const int kmax = (t - blk * 64) < 63 ? (t - blk * 64) : 63;
            for (int kk = 0; kk <= kmax; ++kk) { const unsigned vv = *(const unsigned*)(proj + ((size_t)b * SEQ + blk * 64 + kk) * NPROJ + PC_VSL + g * 128 + 2 * lane);
                const float v0 = bf2f((bf16)(vv & 0xffff)), v1 = bf2f((bf16)(vv >> 16));
#pragma unroll
                for (int r = 0; r < 3; ++r) { const float p = sc[r][slot * 64 + kk]; os[r][0] += p * v0; os[r][1] += p * v1; } } }
#pragma unroll
        for (int r = 0; r < 3; ++r) { os[r][0] *= inv[r]; os[r][1] *= inv[r]; }
    }
    {
        const int lo = t - 511 > 0 ? t - 511 : 0, nk = t - lo + 1; float mx[3] = {-3.0e38f, -3.0e38f, -3.0e38f};
        for (int base = 0; base < nk; base += 64) { const int kpos = lo + base + lane; float s[3] = {-3.0e38f, -3.0e38f, -3.0e38f};
            if (kpos <= t) { const u32x4* kr = (const u32x4*)(NKW + ((size_t)b * SEQ + kpos) * 256 + g * 128); float a0 = 0.f, a1 = 0.f, a2 = 0.f;
#pragma unroll 2
                for (int d = 0; d < 16; ++d) { const u32x4 kk = kr[d]; const unsigned kw[4] = {kk.x, kk.y, kk.z, kk.w};
#pragma unroll
                    for (int e = 0; e < 4; ++e) { const float k0 = bf2f((bf16)(kw[e] & 0xffff)), k1 = bf2f((bf16)(kw[e] >> 16)); const int dd = 8 * d + 2 * e;
                        a0 += k0 * qs[0][dd] + k1 * qs[0][dd + 1]; a1 += k0 * qs[1][dd] + k1 * qs[1][dd + 1]; a2 += k0 * qs[2][dd] + k1 * qs[2][dd + 1]; } }
                const int bk = t5_bucket(t - kpos); s[0] = a0 + bias_s[bk][hb]; s[1] = a1 + bias_s[bk][hb + 1]; s[2] = a2 + bias_s[bk][hb + 2]; }
#pragma unroll
            for (int r = 0; r < 3; ++r) { sc[r][base + lane] = s[r]; mx[r] = fmaxf(mx[r], s[r]); } }
        const int ntot = (nk + 63) & ~63; float inv[3];
#pragma unroll
        for (int r = 0; r < 3; ++r) { mx[r] = wave_max(mx[r]); float sum = 0.f;
            for (int i = lane; i < ntot; i += 64) { const float sv = sc[r][i]; const float e = sv > -1.0e38f ? __expf(sv - mx[r]) : 0.f; sc[r][i] = e; sum += e; }
            sum = wave_sum(sum); inv[r] = 1.0f / fmaxf(sum, 1e-30f); }
        __builtin_amdgcn_s_waitcnt(0); asm volatile("" ::: "memory");
#pragma unroll
        for (int r = 0; r < 3; ++r) { ow[r][0] = 0.f; ow[r][1] = 0.f; }
        for (int kk = 0; kk < nk; ++kk) { const unsigned vv = *(const unsigned*)(proj + ((size_t)b * SEQ + lo + kk) * NPROJ + PC_VWN + g * 128 + 2 * lane);
            const float v0 = bf2f((bf16)(vv & 0xffff)), v1 = bf2f((bf16)(vv >> 16));
#pragma unroll
            for (int r = 0; r < 3; ++r) { const float p = sc[r][kk]; ow[r][0] += p * v0; ow[r][1] += p * v1; } }
#pragma unroll
        for (int r = 0; r < 3; ++r) { ow[r][0] *= inv[r]; ow[r][1] *= inv[r]; }
    }
#pragma unroll
    for (int r = 0; r < 3; ++r) { const float* gp = small + m * 32 + SM_GC + hb + r;
        const float g0 = sigmoidf_(gp[0]), g1 = sigmoidf_(gp[6]), g2 = sigmoidf_(gp[12]);
        *(unsigned*)(mix + m * D_MODEL + 1280 + (hb + r) * 128 + 2 * lane) = pk2(g0 * oc[r][0] + g1 * os[r][0] + g2 * ow[r][0], g0 * oc[r][1] + g1 * os[r][1] + g2 * ow[r][1]); }
    }
    __syncthreads();
}

typedef short bf16x8 __attribute__((ext_vector_type(8)));
typedef float f32x16 __attribute__((ext_vector_type(16)));
typedef __bf16 bf16x2_t __attribute__((ext_vector_type(2)));
#define MFMA32(a, b, c) __builtin_amdgcn_mfma_f32_32x32x16_bf16((a), (b), (c), 0, 0, 0)
constexpr float LOG2E = 1.4426950408889634f, LN2 = 0.6931471805599453f;
__device__ __forceinline__ unsigned cvt2(float lo, float hi) { f32x2 v = {lo, hi}; return __builtin_bit_cast(unsigned, __builtin_convertvector(v, bf16x2_t)); }
__device__ __forceinline__ int perm16(int k) { return (k & 3) | ((k & 4) << 1) | ((k & 8) >> 1); }
__device__ __forceinline__ bf16x8 ld_frag(const bf16* p) { return __builtin_bit_cast(bf16x8, *(const u32x4*)p); }

__device__ __forceinline__ void ph_nsa_prep2(const bf16* __restrict__ proj, const float* __restrict__ qg, const float* __restrict__ kg, bf16* __restrict__ NQ, bf16* __restrict__ KS, bf16* __restrict__ KW,
                                             bf16* __restrict__ VST, bf16* __restrict__ VWT) {
    const int tid = ltid(); const int lane = tid & 63; const int gw = blockIdx.x * NWAVES + (tid >> 6), ngw = gridDim.x * NWAVES;
    {
        const int c0 = (lane & 15) * 8;
        const f32x4 qg0 = *(const f32x4*)(qg + c0), qg1 = *(const f32x4*)(qg + c0 + 4), kg0 = *(const f32x4*)(kg + c0), kg1 = *(const f32x4*)(kg + c0 + 4);
        const int pstep = ngw * 4;
        for (int p0 = gw * 4 + (lane >> 4); p0 < M * 10; p0 += 4 * pstep) {
            u32x4 prr[4];
#pragma unroll
            for (int k = 0; k < 4; ++k) { const int p = p0 + k * pstep; const int pc = p < M * 10 ? p : p0; const int m = pc / 10, j = pc % 10;
                const int src = j < 6 ? PC_QC + j * 128 : (j < 8 ? PC_KSL + (j - 6) * 128 : PC_KWN + (j - 8) * 128);
                prr[k] = *(const u32x4*)(proj + (size_t)m * NPROJ + src + c0); }
#pragma unroll
            for (int k = 0; k < 4; ++k) { const int p = p0 + k * pstep;
                if (p < M * 10) {
                    const int m = p / 10, j = p % 10;
                    const unsigned pw[4] = {prr[k].x, prr[k].y, prr[k].z, prr[k].w};
                    float y[8]; float ss = 0.f;
#pragma unroll
                    for (int e = 0; e < 4; ++e) { y[2 * e] = bf2f((bf16)(pw[e] & 0xffff)); y[2 * e + 1] = bf2f((bf16)(pw[e] >> 16)); ss += y[2 * e] * y[2 * e] + y[2 * e + 1] * y[2 * e + 1]; }
                    float r = rsqrtf(row16_sum(ss) * (1.f / 128.f) + NORM_EPS);
                    if (j < 6) r *= 0.08838834764831845f * LOG2E;
                    const f32x4 g0 = j < 6 ? qg0 : kg0, g1 = j < 6 ? qg1 : kg1;
                    u32x4 o; o.x = cvt2(y[0] * r * g0.x, y[1] * r * g0.y); o.y = cvt2(y[2] * r * g0.z, y[3] * r * g0.w); o.z = cvt2(y[4] * r * g1.x, y[5] * r * g1.y); o.w = cvt2(y[6] * r * g1.z, y[7] * r * g1.w);
                    const int b = m >> 12, t = m & (SEQ - 1);
                    if (j < 6) *(u32x4*)(NQ + (size_t)m * 768 + j * 128 + c0) = o;
                    else if (j < 8) *(u32x4*)(KS + ((size_t)(b * 2 + (j - 6)) * SEQ + t) * 128 + c0) = o;
                    else *(u32x4*)(KW + ((size_t)(b * 2 + (j - 8)) * SEQ + t) * 128 + c0) = o;
                } }
        }
    }
    for (int task = gw; task < BATCH * 2 * 2 * 64; task += ngw) {
        const int tile = task & 63, which = (task >> 6) & 1, g = (task >> 7) & 1, b = task >> 8;
        const int t = tile * 64 + lane;
        const bf16* src = proj + (size_t)(b * SEQ + t) * NPROJ + (which ? PC_VWN : PC_VSL) + g * 128;
        bf16* dst = (which ? VWT : VST) + (size_t)(b * 2 + g) * 128 * SEQ + (t & ~15) + perm16(t & 15);
        u32x4 vv[16];
#pragma unroll
        for (int c = 0; c < 16; ++c) vv[c] = *(const u32x4*)(src + 8 * c);
#pragma unroll
        for (int c = 0; c < 16; ++c) { const unsigned w[4] = {vv[c].x, vv[c].y, vv[c].z, vv[c].w};
#pragma unroll
            for (int e = 0; e < 4; ++e) { dst[(size_t)(8 * c + 2 * e) * SEQ] = (bf16)(w[e] & 0xffff); dst[(size_t)(8 * c + 2 * e + 1) * SEQ] = (bf16)(w[e] >> 16); } }
    }
}

__device__ __forceinline__ void ph_nsa_select_naive(const bf16* __restrict__ NQ, const float* __restrict__ KC, const float* __restrict__ VC, const float* __restrict__ small, const float* __restrict__ rel_bias,
                                                    unsigned long long* __restrict__ SELM, bf16* __restrict__ OC) {
    extern __shared__ __attribute__((aligned(16))) unsigned char lds_dyn[];
    const int tid = ltid(); const int lane = tid & 63, wave = tid >> 6;
    float (*bias_s)[6] = (float (*)[6])(lds_dyn + 8 * 4608);
    __syncthreads();
    for (int i = tid; i < 192; i += NTHREADS) bias_s[i / 6][i % 6] = rel_bias[i];
    __syncthreads();
    float (*qs)[128] = (float (*)[128])(lds_dyn + wave * 4608); float (*pc)[256] = (float (*)[256])(lds_dyn + wave * 4608 + 1536);
    for (int idx = blockIdx.x * NWAVES + wave; idx < M * 2; idx += gridDim.x * NWAVES) {
        const int t = idx & (SEQ - 1), g = (idx >> 12) & 1, b = idx >> 13;
        const size_t m = (size_t)b * SEQ + t;
        for (int i = lane; i < 384; i += 64) qs[i >> 7][i & 127] = bf2f(NQ[m * 768 + g * 384 + i]) * LN2;
        __builtin_amdgcn_s_waitcnt(0); asm volatile("" ::: "memory");
        const int hb = g * 3;
        float oc[3][2];
        const int nvalid = t >= 31 ? ((t - 31) >> 4) + 1 : 0;
        float mx[3] = {-3.0e38f, -3.0e38f, -3.0e38f};
        for (int base = 0; base < 256; base += 64) { const int n = base + lane; float s[3] = {-3.0e38f, -3.0e38f, -3.0e38f};
            if (n < nvalid) { const f32x4* kr = (const f32x4*)(KC + ((size_t)(b * 2 + g) * N_CMP + n) * 128); float a0 = 0.f, a1 = 0.f, a2 = 0.f;
#pragma unroll 2
                for (int d = 0; d < 32; ++d) { const f32x4 kk = kr[d]; const f32x4 q0 = *(const f32x4*)&qs[0][4 * d], q1 = *(const f32x4*)&qs[1][4 * d], q2 = *(const f32x4*)&qs[2][4 * d];
                    a0 += kk.x * q0.x + kk.y * q0.y + kk.z * q0.z + kk.w * q0.w; a1 += kk.x * q1.x + kk.y * q1.y + kk.z * q1.z + kk.w * q1.w; a2 += kk.x * q2.x + kk.y * q2.y + kk.z * q2.z + kk.w * q2.w; }
                const int bk = t5_bucket(t - (16 * n + 31)); s[0] = a0 + bias_s[bk][hb]; s[1] = a1 + bias_s[bk][hb + 1]; s[2] = a2 + bias_s[bk][hb + 2]; }
#pragma unroll
            for (int r = 0; r < 3; ++r) { pc[r][n] = s[r]; mx[r] = fmaxf(mx[r], s[r]); } }
#pragma unroll
        for (int r = 0; r < 3; ++r) { mx[r] = wave_max(mx[r]); float sum = 0.f;
            for (int base = 0; base < 256; base += 64) { const int n = base + lane; const float e = n < nvalid ? __expf(pc[r][n] - mx[r]) : 0.f; pc[r][n] = e; sum += e; }
            sum = wave_sum(sum); const float inv = 1.0f / fmaxf(sum, 1e-30f);
            for (int base = 0; base < 256; base += 64) pc[r][base + lane] *= inv; }
        __builtin_amdgcn_s_waitcnt(0); asm volatile("" ::: "memory");
#pragma unroll
        for (int r = 0; r < 3; ++r) { oc[r][0] = 0.f; oc[r][1] = 0.f; }
        for (int n = 0; n < nvalid; ++n) { const f32x2 vv = *(const f32x2*)(VC + ((size_t)(b * 2 + g) * N_CMP + n) * 128 + 2 * lane);
#pragma unroll
            for (int r = 0; r < 3; ++r) { const float p = pc[r][n]; oc[r][0] += p * vv.x; oc[r][1] += p * vv.y; } }
        { const int j = lane, cur = t >> 6; float imp = 0.f;
          for (int n = 4 * j - 1; n <= 4 * j + 3; ++n) if (n >= 0 && n < N_CMP) imp += pc[0][n] + pc[1][n] + pc[2][n];
          const bool forced = (j == 0) || (j == cur) || (j == cur - 1);
          const float score = forced ? 1e9f : (j <= cur ? imp : -1e30f);
          int rank = 0;
          for (int i = 0; i < 64; ++i) { const float si = __shfl(score, i); rank += (si > score || (si == score && i < j)) ? 1 : 0; }
          const unsigned long long mask = __ballot(rank < 16 && j <= cur);
          if (lane == 0) SELM[(size_t)(b * 2 + g) * SEQ + t] = mask; }
#pragma unroll
        for (int r = 0; r < 3; ++r) { const float g0 = sigmoidf_(small[m * 32 + SM_GC + hb + r]);
            *(unsigned*)(OC + m * D_MODEL + 1280 + (hb + r) * 128 + 2 * lane) = cvt2(g0 * oc[r][0], g0 * oc[r][1]); }
    }
    __syncthreads();
}

constexpr int ATT_BUF = 32768, ATT_NBUF = 3;
constexpr int ATT_NEXT = 328, ATT_EOFF = 224;
constexpr int ATT_BTAB = ATT_NBUF * ATT_BUF, ATT_QW = ATT_BTAB + 4 * ATT_NEXT * 4;
#define ATT_SB() __builtin_amdgcn_sched_barrier(0)
#define ATT_BAR() asm volatile("s_waitcnt lgkmcnt(0)\n\ts_barrier" ::: "memory")
template <int MODE, int KIND> __device__ __forceinline__ void attn_tile(const LAS unsigned char* fq, const LAS unsigned char* tb, float msk, int dlim, const bf16x8 (&qf)[8], f32x16 (&O)[4], float& lsum) {
#define ATT_KF(kk_, s_) (*(const LAS u32x4*)(fq + ((kk_) * 8 + (s_)) * 1024))
#define ATT_VF(dt_, c_) (*(const LAS u32x4*)(fq + 16384 + ((dt_) * 4 + (c_)) * 1024))
#define ATT_BF(x_) __builtin_bit_cast(bf16x8, x_)
#define ATT_EXP(S_, half_, pb_) do { \
        if (KIND == 3 && dlim != 0) { _Pragma("unroll") for (int gq = 0; gq < 4; ++gq) { const f32x4 bv = *(const LAS f32x4*)(tb + 4 * (8 * gq + 32 * (half_))); \
            S_[4 * gq] += bv[0]; S_[4 * gq + 1] += bv[1]; S_[4 * gq + 2] += bv[2]; S_[4 * gq + 3] += bv[3]; } }     \
        _Pragma("unroll") for (int i = 0; i < 16; ++i) { float e = __builtin_amdgcn_exp2f(S_[i]); \
            if (KIND == 2) e = ((i & 3) + 8 * (i >> 2) + 32 * (half_) > dlim) ? e : 0.f; \
            if (MODE == 0) e *= msk; \
            S_[i] = e; lsum += e; } \
        _Pragma("unroll") for (int s2 = 0; s2 < 2; ++s2) { u32x4 w; w.x = cvt2(S_[8 * s2], S_[8 * s2 + 1]); w.y = cvt2(S_[8 * s2 + 2], S_[8 * s2 + 3]); w.z = cvt2(S_[8 * s2 + 4], S_[8 * s2 + 5]); w.w = cvt2(S_[8 * s2 + 6], S_[8 * s2 + 7]); pb_[s2] = ATT_BF(w); } } while (0)
#define ATT_SINIT(S_, half_) do { if (KIND == 1) { _Pragma("unroll") for (int gq = 0; gq < 4; ++gq) { const f32x4 bv = *(const LAS f32x4*)(tb + 4 * (8 * gq + 32 * (half_))); \
            S_[4 * gq] = bv[0]; S_[4 * gq + 1] = bv[1]; S_[4 * gq + 2] = bv[2]; S_[4 * gq + 3] = bv[3]; } } else { _Pragma("unroll") for (int i = 0; i < 16; ++i) S_[i] = 0.f; } } while (0)
    u32x4 fa[4], fb[4]; f32x16 S0, S1; bf16x8 pb0[2], pb1[2];
    ATT_SINIT(S0, 0);
#pragma unroll
    for (int s = 0; s < 4; ++s) fa[s] = ATT_KF(0, s);
    ATT_SB();
#pragma unroll
    for (int s = 0; s < 4; ++s) fb[s] = ATT_KF(0, 4 + s);
#pragma unroll
    for (int s = 0; s < 4; ++s) S0 = MFMA32(ATT_BF(fa[s]), qf[s], S0);
    ATT_SB();
#pragma unroll
    for (int s = 0; s < 4; ++s) fa[s] = ATT_KF(1, s);
    ATT_SINIT(S1, 1);
#pragma unroll
    for (int s = 0; s < 4; ++s) S0 = MFMA32(ATT_BF(fb[s]), qf[4 + s], S0);
    ATT_SB();
#pragma unroll
    for (int s = 0; s < 4; ++s) fb[s] = ATT_KF(1, 4 + s);
#pragma unroll
    for (int s = 0; s < 4; ++s) S1 = MFMA32(ATT_BF(fa[s]), qf[s], S1);
    ATT_SB();
    fa[0] = ATT_VF(0, 0); fa[1] = ATT_VF(0, 1); fa[2] = ATT_VF(1, 0); fa[3] = ATT_VF(1, 1);
#pragma unroll
    for (int s = 0; s < 4; ++s) S1 = MFMA32(ATT_BF(fb[s]), qf[4 + s], S1);
    ATT_EXP(S0, 0, pb0);
    ATT_SB();
    fb[0] = ATT_VF(2, 0); fb[1] = ATT_VF(2, 1); fb[2] = ATT_VF(3, 0); fb[3] = ATT_VF(3, 1);
    O[0] = MFMA32(ATT_BF(fa[0]), pb0[0], O[0]); O[0] = MFMA32(ATT_BF(fa[1]), pb0[1], O[0]); O[1] = MFMA32(ATT_BF(fa[2]), pb0[0], O[1]); O[1] = MFMA32(ATT_BF(fa[3]), pb0[1], O[1]);
    ATT_EXP(S1, 1, pb1);
    ATT_SB();
    fa[0] = ATT_VF(0, 2); fa[1] = ATT_VF(0, 3); fa[2] = ATT_VF(1, 2); fa[3] = ATT_VF(1, 3);
    O[2] = MFMA32(ATT_BF(fb[0]), pb0[0], O[2]); O[2] = MFMA32(ATT_BF(fb[1]), pb0[1], O[2]); O[3] = MFMA32(ATT_BF(fb[2]), pb0[0], O[3]); O[3] = MFMA32(ATT_BF(fb[3]), pb0[1], O[3]);
    ATT_SB();
    fb[0] = ATT_VF(2, 2); fb[1] = ATT_VF(2, 3); fb[2] = ATT_VF(3, 2); fb[3] = ATT_VF(3, 3);
    O[0] = MFMA32(ATT_BF(fa[0]), pb1[0], O[0]); O[0] = MFMA32(ATT_BF(fa[1]), pb1[1], O[0]); O[1] = MFMA32(ATT_BF(fa[2]), pb1[0], O[1]); O[1] = MFMA32(ATT_BF(fa[3]), pb1[1], O[1]);
    ATT_SB();
    O[2] = MFMA32(ATT_BF(fb[0]), pb1[0], O[2]); O[2] = MFMA32(ATT_BF(fb[1]), pb1[1], O[2]); O[3] = MFMA32(ATT_BF(fb[2]), pb1[0], O[3]); O[3] = MFMA32(ATT_BF(fb[3]), pb1[1], O[3]);
    ATT_SB();
#undef ATT_KF
#undef ATT_VF
#undef ATT_BF
#undef ATT_EXP
#undef ATT_SINIT
}
template <int MODE> __device__ __forceinline__ void attn_branch(const bf16* __restrict__ Kbase, const bf16* __restrict__ VTbase, int kt_lo, int kt_hi, int tq0, int t, int h, int q, int tid, int wave,
                                                                unsigned long long selmask, const bf16x8 (&qf)[8], f32x16 (&O)[4], float& lsum) {
    extern __shared__ __attribute__((aligned(16))) unsigned char lds_dyn[];
    LAS unsigned char* ldsl = (LAS unsigned char*)lds_dyn;
    const unsigned kvo = (unsigned)(q * 256 + h * 16), vvo = (unsigned)(q * (SEQ * 2) + h * 16);
    auto dma = [&](int kt, int buf) {
        const char* kg = (const char*)Kbase + (size_t)kt * (64 * 128 * 2); const char* vg = (const char*)VTbase + kt * 128;
#pragma unroll
        for (int i = 0; i < 2; ++i) { const int n = 2 * wave + i;
            __builtin_amdgcn_global_load_lds((const unsigned*)(kg + ((n >> 3) * 8192 + (n & 7) * 32) + kvo), (LAS unsigned*)(ldsl + buf * ATT_BUF + n * 1024), 16, 0, 0);
            __builtin_amdgcn_global_load_lds((const unsigned*)(vg + ((size_t)(n >> 2) * (32 * SEQ * 2) + (n & 3) * 32) + vvo), (LAS unsigned*)(ldsl + buf * ATT_BUF + 16384 + n * 1024), 16, 0, 0); } };
    const int lane16 = (h * 32 + q) * 16;
    const int tlane = ATT_BTAB + ((0 - q) & 3) * (ATT_NEXT * 4) + 4 * (ATT_EOFF - ((0 - q) & 3));
    ATT_BAR();
    dma(kt_lo, 0);
    if (kt_lo < kt_hi) { dma(kt_lo + 1, 1); asm volatile("s_waitcnt vmcnt(4)" ::: "memory"); } else asm volatile("s_waitcnt vmcnt(0)" ::: "memory");
    ATT_BAR();
    int buf = 0;
    for (int kt = kt_lo; kt <= kt_hi; ++kt) {
        const bool more = kt + 2 <= kt_hi;
        if (more) dma(kt + 2, buf == 0 ? 2 : buf - 1);
        bool need = 64 * kt <= tq0 + 31;
        if (MODE == 1) need = need && (64 * kt + 63 >= tq0 - 511);
        const bool sel = MODE == 0 ? ((selmask >> kt) & 1ull) != 0ull : true;
        if (need && (MODE == 1 || __ballot(sel) != 0ull)) {
            const LAS unsigned char* fq = ldsl + buf * ATT_BUF + lane16;
            const int mind = tq0 - (64 * kt + 63), maxd = tq0 + 31 - 64 * kt;
            const float msk = sel ? 1.f : 0.f;
            const int d0 = t - 64 * kt - 4 * h;
            if (MODE == 0) {
                const int nearf = __builtin_amdgcn_readfirstlane(mind < 128 ? 1 : 0);
                attn_tile<MODE, 3>(fq, ldsl + tlane - 4 * d0, msk, nearf, qf, O, lsum);
            } else if (mind >= 128) {
                if (maxd <= 511) attn_tile<MODE, 0>(fq, ldsl, msk, 0, qf, O, lsum);
                else attn_tile<MODE, 2>(fq, ldsl, msk, d0 - 512, qf, O, lsum);
            } else attn_tile<MODE, 1>(fq, ldsl + tlane - 4 * d0, msk, 0, qf, O, lsum);
        }
        if (more) asm volatile("s_waitcnt vmcnt(4)" ::: "memory"); else asm volatile("s_waitcnt vmcnt(0)" ::: "memory");
        ATT_BAR();
        buf = buf == 2 ? 0 : buf + 1;
    }
}
__device__ __forceinline__ void ph_nsa_main(const bf16* __restrict__ NQ, const bf16* __restrict__ KS, const bf16* __restrict__ KW, const bf16* __restrict__ VST, const bf16* __restrict__ VWT,
                                            const unsigned long long* __restrict__ SELM, const bf16* __restrict__ OC, const float* __restrict__ small, const float* __restrict__ rel_bias, bf16* __restrict__ mix,
                                            unsigned* __restrict__ queue) {
    extern __shared__ __attribute__((aligned(16))) unsigned char lds_dyn[];
    float* btab = (float*)(lds_dyn + ATT_BTAB); volatile unsigned* qw = (volatile unsigned*)(lds_dyn + ATT_QW);
    for (;;) {
        const int tid = ltid();
        const int lane = tid & 63, wave = __builtin_amdgcn_readfirstlane(tid >> 6), q = lane & 31, h = lane >> 5;
        __syncthreads();
        if (tid == 0) *qw = __hip_atomic_fetch_add(queue, 1u, __ATOMIC_RELAXED, __HIP_MEMORY_SCOPE_AGENT);
        __syncthreads();
        const int u = __builtin_amdgcn_readfirstlane((int)*qw);
        if (u >= 768) break;
        const int qb = 15 - u / 48, rem = u % 48, r = rem % 3, bg = rem / 3, g = bg & 1, b = bg >> 1, head = g * 3 + r;
        { const float bfar = rel_bias[t5_bucket(127) * 6 + head];
          for (int e = tid; e < 4 * ATT_NEXT; e += NTHREADS) { const int c = e / ATT_NEXT, dist = ATT_EOFF - (e - c * ATT_NEXT) - c;
              btab[e] = dist < 0 ? -1e30f : (rel_bias[t5_bucket(dist > 127 ? 127 : dist) * 6 + head] - bfar) * LOG2E; } }
        const int t0 = qb * 256, tq0 = t0 + 32 * wave, t = tq0 + q; const size_t m = (size_t)b * SEQ + t;
        bf16x8 qf[8];
#pragma unroll
        for (int s = 0; s < 8; ++s) qf[s] = ld_frag(NQ + m * 768 + head * 128 + 16 * s + 8 * h);
        const unsigned long long selmask = SELM[(size_t)(b * 2 + g) * SEQ + t];
        f32x16 O[4]; float lsum = 0.f;
#pragma unroll
        for (int dt = 0; dt < 4; ++dt)
#pragma unroll
            for (int i = 0; i < 16; ++i) O[dt][i] = 0.f;
        attn_branch<0>(KS + (size_t)(b * 2 + g) * SEQ * 128, VST + (size_t)(b * 2 + g) * 128 * SEQ, 0, 4 * qb + 3, tq0, t, h, q, tid, wave, selmask, qf, O, lsum);
        { const float l = lsum + __shfl_xor(lsum, 32); const float sc = sigmoidf_(small[m * 32 + SM_GC + 6 + head]) / l;
#pragma unroll
          for (int dt = 0; dt < 4; ++dt)
#pragma unroll
              for (int gq = 0; gq < 4; ++gq) { const int d = 32 * dt + 8 * gq + 4 * h;
                  const u32x2 ocv = *(const u32x2*)(mix + m * D_MODEL + 1280 + head * 128 + d);
                  u32x2 w; w.x = cvt2(O[dt][4 * gq] * sc + bf2f((bf16)(ocv.x & 0xffff)), O[dt][4 * gq + 1] * sc + bf2f((bf16)(ocv.x >> 16)));
                  w.y = cvt2(O[dt][4 * gq + 2] * sc + bf2f((bf16)(ocv.y & 0xffff)), O[dt][4 * gq + 3] * sc + bf2f((bf16)(ocv.y >> 16)));
                  *(u32x2*)(mix + m * D_MODEL + 1280 + head * 128 + d) = w; }
#pragma unroll
          for (int dt = 0; dt < 4; ++dt)
#pragma unroll
              for (int i = 0; i < 16; ++i) O[dt][i] = 0.f; }
        lsum = 0.f;
        { const int lo = t0 - 512 > 0 ? (t0 - 512) >> 6 : 0;
          attn_branch<1>(KW + (size_t)(b * 2 + g) * SEQ * 128, VWT + (size_t)(b * 2 + g) * 128 * SEQ, lo, (t0 + 255) >> 6, tq0, t, h, q, tid, wave, 0ull, qf, O, lsum); }
        { const float l = lsum + __shfl_xor(lsum, 32); const float sc = sigmoidf_(small[m * 32 + SM_GC + 12 + head]) / l;
#pragma unroll
          for (int dt = 0; dt < 4; ++dt)
#pragma unroll
              for (int gq = 0; gq < 4; ++gq) { const int d = 32 * dt + 8 * gq + 4 * h;
                  u32x2* mp = (u32x2*)(mix + m * D_MODEL + 1280 + head * 128 + d); const u32x2 pv = *mp;
                  u32x2 w; w.x = cvt2(O[dt][4 * gq] * sc + bf2f((bf16)(pv.x & 0xffff)), O[dt][4 * gq + 1] * sc + bf2f((bf16)(pv.x >> 16)));
                  w.y = cvt2(O[dt][4 * gq + 2] * sc + bf2f((bf16)(pv.y & 0xffff)), O[dt][4 * gq + 3] * sc + bf2f((bf16)(pv.y >> 16)));
                  *mp = w; } }
    }
    __syncthreads();
}

constexpr int SL_KSTR = 272, SL_VSTR = 528;
constexpr int SL_K = 0, SL_V = 256 * SL_KSTR, SL_BT = SL_V + 128 * SL_VSTR;
static_assert(SL_BT + 3072 <= LDS_MISC, "selection phase LDS");
__device__ __forceinline__ void ph_nsa_select_fast(const bf16* __restrict__ NQ, const bf16* __restrict__ KCB, const bf16* __restrict__ VCT, const float* __restrict__ small, const float* __restrict__ rel_bias,
                                                   unsigned long long* __restrict__ SELM, bf16* __restrict__ mix) {
    extern __shared__ __attribute__((aligned(16))) unsigned char lds_dyn[];
    const int tid = ltid(); const int lane = tid & 63, wave = tid >> 6, q = lane & 31, h = lane >> 5;
    float* btab = (float*)(lds_dyn + SL_BT);
    __syncthreads();
    for (int i = tid; i < 768; i += NTHREADS) btab[i] = (rel_bias[t5_bucket(i & 127) * 6 + (i >> 7)] - rel_bias[t5_bucket(127) * 6 + (i >> 7)]) * LOG2E;
    for (int item = blockIdx.x; item < BATCH * 2 * 16; item += gridDim.x) {
        const int qb = item & 15, g = (item >> 4) & 1, b = item >> 5;
        const int qt = 8 * qb + wave, t0 = 32 * qt, t = t0 + q; const size_t m = (size_t)b * SEQ + t;
        const int nv = t >= 31 ? ((t - 31) >> 4) + 1 : 0;
        const int ntile = (qt + 16) >> 4;
        const int nt_blk = (8 * qb + 7 + 16) >> 4;
        const int t0u = __builtin_amdgcn_readfirstlane(t0);
        {
          const bf16* Kb = KCB + (size_t)(b * 2 + g) * 256 * 128; const bf16* Vb = VCT + (size_t)(b * 2 + g) * 128 * 256;
          __syncthreads();
          const int vch = nt_blk * 4;
          const int nbu = __builtin_amdgcn_readfirstlane(nt_blk);
          u32x4 kr[8], vr[8];
#pragma unroll
          for (int i = 0; i < 8; ++i) { const int c = tid + NTHREADS * (i < nbu ? i : 0); kr[i] = *(const u32x4*)(Kb + (size_t)c * 8);
              const int d = c / vch, part = c - d * vch; vr[i] = *(const u32x4*)(Vb + (size_t)d * 256 + part * 8); }
#pragma unroll
          for (int i = 0; i < 8; ++i) if (i < nbu) { const int c = tid + NTHREADS * i; *(u32x4*)(lds_dyn + SL_K + (c >> 4) * SL_KSTR + (c & 15) * 16) = kr[i];
              const int d = c / vch, part = c - d * vch; *(u32x4*)(lds_dyn + SL_V + d * SL_VSTR + part * 16) = vr[i]; }
          __syncthreads(); }
        float imp[32];
#pragma unroll
        for (int i = 0; i < 32; ++i) imp[i] = 0.f;
#pragma unroll 1
        for (int r = 0; r < 3; ++r) {
            const int head = g * 3 + r;
            int h_ = h, t_ = t, q_ = q; asm volatile("" : "+v"(h_), "+v"(t_), "+v"(q_));
            bf16x8 qf[8];
#pragma unroll
            for (int s = 0; s < 8; ++s) qf[s] = ld_frag(NQ + m * 768 + head * 128 + 16 * s + 8 * h_);
            const float* bt = btab + head * 128;
            const unsigned char* kl = lds_dyn + SL_K + q_ * SL_KSTR + 16 * h_; const unsigned char* vl = lds_dyn + SL_V + q_ * SL_VSTR + 16 * h_;
            f32x16 O[4]; float Uacc[32]; float lsum = 0.f, carry = 0.f;
#pragma unroll
            for (int dt = 0; dt < 4; ++dt)
#pragma unroll
                for (int i = 0; i < 16; ++i) O[dt][i] = 0.f;
#pragma unroll
            for (int i = 0; i < 32; ++i) Uacc[i] = 0.f;
#pragma unroll
            for (int kk = 0; kk < 8; ++kk) {
                if (kk < ntile) {
                    f32x16 S;
#pragma unroll
                    for (int i = 0; i < 16; ++i) S[i] = 0.f;
#pragma unroll
                    for (int s = 0; s < 8; ++s) S = MFMA32(__builtin_bit_cast(bf16x8, *(const u32x4*)(kl + kk * 32 * SL_KSTR + 32 * s)), qf[s], S);
                    float p[16];
                    if (512 * kk + 655 <= t0u) {
#pragma unroll
                        for (int i = 0; i < 16; ++i) { p[i] = __builtin_amdgcn_exp2f(S[i]); lsum += p[i]; }
                    } else {
#pragma unroll
                    for (int i = 0; i < 16; ++i) { const int n = 32 * kk + (i & 3) + 8 * (i >> 2) + 4 * h_; const int dist = t_ - 16 * n - 31;
                        const int bi = dist < 0 ? 0 : (dist > 127 ? 127 : dist);
                        const float e = __builtin_amdgcn_exp2f(S[i] + bt[bi]); p[i] = n < nv ? e : 0.f; lsum += p[i]; }
                    }
                    float G[4], Lp[4];
#pragma unroll
                    for (int gq = 0; gq < 4; ++gq) { G[gq] = (p[4 * gq] + p[4 * gq + 1]) + (p[4 * gq + 2] + p[4 * gq + 3]); Lp[gq] = __shfl_xor(p[4 * gq + 3], 32); }
#pragma unroll
                    for (int gq = 0; gq < 4; ++gq) { const float prev = gq > 0 ? Lp[gq > 0 ? gq - 1 : 0] : carry; Uacc[4 * kk + gq] += G[gq] + (h_ ? Lp[gq] : prev); }
                    carry = Lp[3];
#pragma unroll
                    for (int s2 = 0; s2 < 2; ++s2) { u32x4 w; w.x = cvt2(p[8 * s2], p[8 * s2 + 1]); w.y = cvt2(p[8 * s2 + 2], p[8 * s2 + 3]); w.z = cvt2(p[8 * s2 + 4], p[8 * s2 + 5]); w.w = cvt2(p[8 * s2 + 6], p[8 * s2 + 7]);
                        const bf16x8 pb = __builtin_bit_cast(bf16x8, w);
#pragma unroll
                        for (int dt = 0; dt < 4; ++dt) O[dt] = MFMA32(__builtin_bit_cast(bf16x8, *(const u32x4*)(vl + dt * 32 * SL_VSTR + (32 * kk + 16 * s2) * 2)), pb, O[dt]); }
                }
            }
            const float l = lsum + __shfl_xor(lsum, 32); const float inv = l > 0.f ? 1.0f / l : 0.f;
#pragma unroll
            for (int i = 0; i < 32; ++i) imp[i] += Uacc[i] * inv;
            const float sc = sigmoidf_(small[m * 32 + SM_GC + head]) * inv;
#pragma unroll
            for (int dt = 0; dt < 4; ++dt)
#pragma unroll
                for (int gq = 0; gq < 4; ++gq) { u32x2 w; w.x = cvt2(O[dt][4 * gq] * sc, O[dt][4 * gq + 1] * sc); w.y = cvt2(O[dt][4 * gq + 2] * sc, O[dt][4 * gq + 3] * sc);
                    *(u32x2*)(mix + m * D_MODEL + 1280 + head * 128 + 32 * dt + 8 * gq + 4 * h_) = w; }
        }
        const int cur = t >> 6;
        int hs = h; asm volatile("" : "+v"(hs));
        unsigned keys[32];
#pragma unroll
        for (int i = 0; i < 32; ++i) { const int j = 2 * i + hs; const bool causal = j <= cur, forced = (j == 0) || (j == cur) || (j == cur - 1);
            keys[i] = !causal ? 0u : (forced ? (0x7f000000u | (unsigned)(63 - j)) : ((__float_as_uint(imp[i]) & ~63u) | (unsigned)(63 - j))); }
        unsigned selbits = 0u;
#pragma unroll 1
        for (int round = 0; round < 16; ++round) {
            unsigned mx = keys[0];
#pragma unroll
            for (int i = 1; i < 32; ++i) mx = mx > keys[i] ? mx : keys[i];
            const unsigned pm = (unsigned)__shfl_xor((int)mx, 32); const unsigned gm = mx > pm ? mx : pm;
#pragma unroll
            for (int i = 0; i < 32; ++i) { const bool hit = keys[i] == gm && gm != 0u; selbits |= hit ? (1u << i) : 0u; keys[i] = hit ? 0u : keys[i]; }
        }
        unsigned long long x = selbits;
        x = (x | (x << 16)) & 0x0000FFFF0000FFFFull; x = (x | (x << 8)) & 0x00FF00FF00FF00FFull; x = (x | (x << 4)) & 0x0F0F0F0F0F0F0F0Full; x = (x | (x << 2)) & 0x3333333333333333ull; x = (x | (x << 1)) & 0x5555555555555555ull;
        x <<= h;
        const unsigned plo = (unsigned)__shfl_xor((int)(unsigned)x, 32), phi = (unsigned)__shfl_xor((int)(unsigned)(x >> 32), 32);
        x |= ((unsigned long long)phi << 32) | plo;
        if (h == 0) SELM[(size_t)(b * 2 + g) * SEQ + t] = x;
    }
    __syncthreads();
}

typedef float f32x4v __attribute__((ext_vector_type(4)));
#define MFMA16(a, b, c) __builtin_amdgcn_mfma_f32_16x16x32_bf16((a), (b), (c), 0, 0, 0)
__device__ __forceinline__ int gperm(int x) { return (x & ~31) | ((x & 12) << 1) | ((x & 16) >> 2) | (x & 3); }
constexpr int GP_STR = 136;
constexpr int GP_Q = 0, GP_K = 64 * GP_STR * 2, GP_V = 2 * 64 * GP_STR * 2, GP_L = 3 * 64 * GP_STR * 2, GP_LSTR = 68, GP_SC = GP_L + 64 * GP_LSTR * 4;
constexpr int GP_CHUNK = GP_SC + 320 * 4;
static_assert(2 * GP_CHUNK + 16 <= LDS_MISC, "two chunk images must fit below the frame's LDS words");
template <int STRIP> __device__ __forceinline__ void ph_gdn_prep_fast(const bf16* __restrict__ proj, const float* __restrict__ small, const float* __restrict__ conv_w, const float* __restrict__ a_log, const float* __restrict__ dt_bias,
                                                 bf16* __restrict__ UF, bf16* __restrict__ WP, bf16* __restrict__ QGP, bf16* __restrict__ KDT, bf16* __restrict__ AP, float* __restrict__ EGL, unsigned* __restrict__ queue) {
    extern __shared__ __attribute__((aligned(16))) unsigned char lds_dyn[];
    const int tid0 = ltid();
    volatile unsigned* qw = (volatile unsigned*)(lds_dyn + 2 * GP_CHUNK);
#define GP_BAR() asm volatile("s_waitcnt lgkmcnt(0)\n\ts_barrier" ::: "memory")
    for (;;) {
        int tid = tid0; asm volatile("" : "+v"(tid));
        __syncthreads();
        if (tid == 0) *qw = __hip_atomic_fetch_add(queue, 1u, __ATOMIC_RELAXED, __HIP_MEMORY_SCOPE_AGENT);
        __syncthreads();
        const int pair = (int)*qw;
        if (pair >= BATCH * 6 * 32) break;
        const int lane = tid & 63, wave = tid >> 6;
        const int bh = pair >> 5, b = bh / 6, h = bh % 6;
        GP_BAR();
        {
            const int cg = tid & 31, ts = tid >> 5;
            f32x4 cw[3][4];
#pragma unroll
            for (int which = 0; which < 3; ++which)
#pragma unroll
                for (int tap = 0; tap < 4; ++tap) cw[which][tap] = *(const f32x4*)(conv_w + tap * 2304 + which * 768 + h * 128 + 4 * cg);
#pragma unroll 1
            for (int cs = 0; cs < 2; ++cs) {
                const int n = 2 * (pair & 31) + cs; const size_t m0 = (size_t)b * SEQ + n * 64;
                unsigned char* L = lds_dyn + cs * GP_CHUNK;
                const int tb = n * 64 + 4 * ts - 3;
                u32x2 xr[3][7];
#pragma unroll
                for (int which = 0; which < 3; ++which)
#pragma unroll
                    for (int r = 0; r < 7; ++r) { const bool ok = tb + r >= 0; const bf16* src = proj + (m0 + 4 * ts - (ok ? 3 - r : 0)) * NPROJ + which * 768 + h * 128 + 4 * cg;
                        xr[which][r] = *(const u32x2*)src; if (!ok) xr[which][r] = (u32x2){0u, 0u}; }
#pragma unroll
                for (int which = 0; which < 3; ++which) {
                    float xf[7][4];
#pragma unroll
                    for (int r = 0; r < 7; ++r) { xf[r][0] = bf2f((bf16)(xr[which][r].x & 0xffff)); xf[r][1] = bf2f((bf16)(xr[which][r].x >> 16)); xf[r][2] = bf2f((bf16)(xr[which][r].y & 0xffff)); xf[r][3] = bf2f((bf16)(xr[which][r].y >> 16)); }
#pragma unroll
                    for (int j = 0; j < 4; ++j) { float y[4]; float ss = 0.f;
#pragma unroll
                        for (int e = 0; e < 4; ++e) { float v = cw[which][0][e] * xf[j][e]; v += cw[which][1][e] * xf[j + 1][e]; v += cw[which][2][e] * xf[j + 2][e]; v += cw[which][3][e] * xf[j + 3][e]; y[e] = siluf_(v); ss += y[e] * y[e]; }
                        float r = 1.f;
                        if (which < 2) { ss = row16_sum(ss); ss += __shfl_xor(ss, 16); r = rsqrtf(ss + NORM_EPS); if (which == 0) r *= 0.08838834764831845f; }
                        u32x2 o; o.x = cvt2(y[0] * r, y[1] * r); o.y = cvt2(y[2] * r, y[3] * r);
                        *(u32x2*)(L + which * (64 * GP_STR * 2) + ((4 * ts + j) * GP_STR + 4 * cg) * 2) = o; }
                }
            }
        }
        if (wave < 2) {
            const int cs = wave, n = 2 * (pair & 31) + cs, ci = 2 * pair + cs; const size_t m = (size_t)b * SEQ + n * 64 + lane;
            float* sgc = (float*)(lds_dyn + cs * GP_CHUNK + GP_SC);
            const float beta = sigmoidf_(small[m * 32 + SM_BA + h]);
            float g = -__expf(a_log[h]) * softplusf_(small[m * 32 + SM_AA + h] + dt_bias[h]);
#pragma unroll
            for (int o = 1; o < 64; o <<= 1) { const float up = __shfl_up(g, o); if (lane >= o) g += up; }
            const float gl = __shfl(g, 63);
            sgc[lane] = g; sgc[64 + lane] = beta; sgc[128 + lane] = __expf(g); sgc[192 + lane] = __expf(gl - g); sgc[256 + lane] = beta * __expf(g);
            if (lane == 0) EGL[ci] = __expf(gl);
        }
        GP_BAR();
        if (STRIP != 1) { const int r16 = lane & 15, a = lane >> 4;
          for (int tq = wave; tq < 52; tq += NWAVES) {
              const int cs = tq >= 26 ? 1 : 0, tl = tq - 26 * cs, ci = 2 * pair + cs;
              unsigned char* L = lds_dyn + cs * GP_CHUNK; const float* sgc = (const float*)(L + GP_SC); const float* sbeta = sgc + 64;
              const bool isA = tl >= 10; int ti, tj;
              if (!isA) { int k = tl; ti = 0; while (k > ti) { k -= ti + 1; ++ti; } tj = k; }
              else { ti = (tl - 10) >> 2; tj = (tl - 10) & 3; }
              f32x4v acc = {0.f, 0.f, 0.f, 0.f};
              if (tj <= ti) {
                  const unsigned char* xa = L + (isA ? GP_Q : GP_K) + ((16 * ti + r16) * GP_STR + 8 * a) * 2;
                  const unsigned char* xb = L + GP_K + ((16 * tj + r16) * GP_STR + 8 * a) * 2;
#pragma unroll
                  for (int s = 0; s < 4; ++s) acc = MFMA16(__builtin_bit_cast(bf16x8, *(const u32x4*)(xa + 64 * s)), __builtin_bit_cast(bf16x8, *(const u32x4*)(xb + 64 * s)), acc);
              }
              const int j = 16 * tj + r16; const float gj = sgc[j];
#pragma unroll
              for (int reg = 0; reg < 4; ++reg) { const int i = 16 * ti + 4 * a + reg; const float dec = __expf(sgc[i] - gj);
                  if (!isA) { ((float*)(L + GP_L))[i * GP_LSTR + j] = j < i ? sbeta[i] * acc[reg] * dec : 0.f; }
                  else __builtin_nontemporal_store(f2bf(j <= i ? acc[reg] * dec : 0.f), AP + ((size_t)ci * 64 + i) * 64 + gperm(j)); }
          } }
        GP_BAR();
        if (STRIP != 1 && STRIP != 2) {
            const int cs = wave >> 2, ci = 2 * pair + cs;
            unsigned char* L = lds_dyn + cs * GP_CHUNK; const float* sgc = (const float*)(L + GP_SC); const float* sbeta = sgc + 64; const float* segc = sgc + 128; const float* sekd = sgc + 192;
            const int c = (wave & 3) * 64 + lane; const bool isw = c >= 128; const int cc = c & 127;
            const unsigned char* xsrc = L + (isw ? GP_K : GP_V) + cc * 2;
            const float* Lm = (const float*)(L + GP_L);
            float U[64];
            const float* scl = isw ? (sgc + 256) : sbeta;
            f32x4 bA[16], bB[16]; float rA, rB = 0.f;
            rA = bf2f(*(const bf16*)xsrc) * scl[0];
#define GDN_LOADROW(buf, rr_, i_) do { _Pragma("unroll") for (int j4 = 0; j4 < ((i_) + 3) / 4; ++j4) buf[j4] = *(const f32x4*)(Lm + (i_) * GP_LSTR + 4 * j4); rr_ = bf2f(*(const bf16*)(xsrc + (i_) * GP_STR * 2)) * scl[i_]; } while (0)
#define GDN_ROW(buf, rr_, i_) do { float a0 = rr_, a1 = 0.f, a2 = 0.f, a3 = 0.f; _Pragma("unroll") for (int j4 = 0; j4 < ((i_) + 3) / 4; ++j4) { const f32x4 lv = buf[j4]; \
                    if (4 * j4 < (i_)) a0 -= lv.x * U[4 * j4]; if (4 * j4 + 1 < (i_)) a1 -= lv.y * U[4 * j4 + 1]; if (4 * j4 + 2 < (i_)) a2 -= lv.z * U[4 * j4 + 2]; if (4 * j4 + 3 < (i_)) a3 -= lv.w * U[4 * j4 + 3]; } \
                    U[i_] = (a0 + a1) + (a2 + a3); asm volatile("" ::: "memory"); } while (0)
#pragma unroll
            for (int i = 0; i < 64; i += 2) {
                GDN_LOADROW(bB, rB, i + 1);
                GDN_ROW(bA, rA, i);
                if (i + 2 < 64) GDN_LOADROW(bA, rA, i + 2);
                GDN_ROW(bB, rB, i + 1);
            }
#undef GDN_LOADROW
#undef GDN_ROW
            if (STRIP == 3) { if (U[63] == 12345.678f) EGL[ci] = U[5]; } else
            if (!isw) { const int v = cc >> 4, c15 = cc & 15; bf16* dst = UF + ((size_t)ci * 8 + v) * 64 * 16;
#pragma unroll
                for (int aa = 0; aa < 4; ++aa) { u32x4 w0, w1;
                    w0.x = cvt2(U[4 * aa], U[4 * aa + 1]); w0.y = cvt2(U[4 * aa + 2], U[4 * aa + 3]); w0.z = cvt2(U[16 + 4 * aa], U[16 + 4 * aa + 1]); w0.w = cvt2(U[16 + 4 * aa + 2], U[16 + 4 * aa + 3]);
                    w1.x = cvt2(U[32 + 4 * aa], U[32 + 4 * aa + 1]); w1.y = cvt2(U[32 + 4 * aa + 2], U[32 + 4 * aa + 3]); w1.z = cvt2(U[48 + 4 * aa], U[48 + 4 * aa + 1]); w1.w = cvt2(U[48 + 4 * aa + 2], U[48 + 4 * aa + 3]);
                    u32x4* p = (u32x4*)(dst + (16 * aa + c15) * 16); __builtin_nontemporal_store(w0, p); __builtin_nontemporal_store(w1, p + 1); } }
            else { bf16* dst = WP + (size_t)ci * 64 * 128 + gperm(cc);
#pragma unroll
                for (int i = 0; i < 64; ++i) __builtin_nontemporal_store(f2bf(U[i]), dst + i * 128); }
            const int t2 = tid & 255;
            if (STRIP != 3)
#pragma unroll
            for (int it = 0; it < 8; ++it) {
                const int pc = t2 + 256 * it, i = pc >> 5, pos = (pc & 31) * 4; const int s32 = pos & ~31, a = (pos >> 3) & 3, bb = (pos >> 2) & 1, dk = s32 + 16 * bb + 4 * a;
                const u32x2 qv = *(const u32x2*)(L + GP_Q + (i * GP_STR + dk) * 2); const float e = segc[i];
                u32x2 o; o.x = cvt2(bf2f((bf16)(qv.x & 0xffff)) * e, bf2f((bf16)(qv.x >> 16)) * e); o.y = cvt2(bf2f((bf16)(qv.y & 0xffff)) * e, bf2f((bf16)(qv.y >> 16)) * e);
                __builtin_nontemporal_store(o, (u32x2*)(QGP + ((size_t)ci * 64 + i) * 128 + pos)); }
            if (STRIP != 3)
#pragma unroll
            for (int it = 0; it < 8; ++it) {
                const int pc = t2 + 256 * it, dk = pc >> 4, pos = (pc & 15) * 4; const int s32 = pos & ~31, a = (pos >> 3) & 3, bb = (pos >> 2) & 1, i0 = s32 + 16 * bb + 4 * a;
                const unsigned char* ks = L + GP_K + (i0 * GP_STR + dk) * 2;
                const float k0 = bf2f(*(const bf16*)ks) * sekd[i0], k1 = bf2f(*(const bf16*)(ks + GP_STR * 2)) * sekd[i0 + 1], k2 = bf2f(*(const bf16*)(ks + 2 * GP_STR * 2)) * sekd[i0 + 2], k3 = bf2f(*(const bf16*)(ks + 3 * GP_STR * 2)) * sekd[i0 + 3];
                u32x2 o; o.x = cvt2(k0, k1); o.y = cvt2(k2, k3);
                __builtin_nontemporal_store(o, (u32x2*)(KDT + ((size_t)ci * 128 + dk) * 64 + pos)); }
        }
    }
#undef GP_BAR
    __syncthreads();
}

constexpr int GS_WSTR = 272, GS_TSTR = 144;
constexpr int GS_W = 0, GS_Q = 64 * GS_WSTR, GS_KD = 2 * 64 * GS_WSTR, GS_A = GS_KD + 128 * GS_TSTR, GS_STAGE = GS_A + 64 * GS_TSTR;
constexpr int GS_SSQ = 2 * GS_STAGE;
__device__ __forceinline__ void ph_gdn_scan_fast(const bf16* __restrict__ UF, const bf16* __restrict__ WP, const bf16* __restrict__ QGP, const bf16* __restrict__ KDT, const bf16* __restrict__ AP, const float* __restrict__ EGL,
                                                 const bf16* __restrict__ proj, const float* __restrict__ norm_g, bf16* __restrict__ mix, int nblk_scan) {
    extern __shared__ __attribute__((aligned(16))) unsigned char lds_dyn[];
    const int tid = ltid(); const int lane = tid & 63, wave = tid >> 6, r16 = lane & 15, a = lane >> 4;
    for (int bh = blockIdx.x; bh < BATCH * 6; bh += nblk_scan) {
        const int b = bh / 6, h = bh % 6;
        u32x4 st[7];
        auto gload = [&](int ci) {
            const u32x4* w = (const u32x4*)(WP + (size_t)ci * 64 * 128); const u32x4* q = (const u32x4*)(QGP + (size_t)ci * 64 * 128);
            const u32x4* k = (const u32x4*)(KDT + (size_t)ci * 128 * 64); const u32x4* ap = (const u32x4*)(AP + (size_t)ci * 64 * 64);
            st[0] = w[tid]; st[1] = w[tid + 512]; st[2] = q[tid]; st[3] = q[tid + 512]; st[4] = k[tid]; st[5] = k[tid + 512]; st[6] = ap[tid]; };
        auto lwrite = [&](int buf) {
            unsigned char* base = lds_dyn + buf * GS_STAGE;
            *(u32x4*)(base + GS_W + (tid >> 4) * GS_WSTR + (tid & 15) * 16) = st[0]; *(u32x4*)(base + GS_W + ((tid + 512) >> 4) * GS_WSTR + (tid & 15) * 16) = st[1];
            *(u32x4*)(base + GS_Q + (tid >> 4) * GS_WSTR + (tid & 15) * 16) = st[2]; *(u32x4*)(base + GS_Q + ((tid + 512) >> 4) * GS_WSTR + (tid & 15) * 16) = st[3];
            *(u32x4*)(base + GS_KD + (tid >> 3) * GS_TSTR + (tid & 7) * 16) = st[4]; *(u32x4*)(base + GS_KD + ((tid + 512) >> 3) * GS_TSTR + (tid & 7) * 16) = st[5];
            *(u32x4*)(base + GS_A + (tid >> 3) * GS_TSTR + (tid & 7) * 16) = st[6]; };
        f32x4v S[8];
#pragma unroll
        for (int i = 0; i < 8; ++i) S[i] = (f32x4v){0.f, 0.f, 0.f, 0.f};
        const int ci0 = bh * 64;
        __syncthreads();
        gload(ci0); lwrite(0);
        __syncthreads();
        gload(ci0 + 1);
        u32x4 ucur0, ucur1, unext0 = {0u, 0u, 0u, 0u}, unext1 = {0u, 0u, 0u, 0u}; float eglc, egln = 0.f;
        { const u32x4* up = (const u32x4*)(UF + (((size_t)ci0 * 8 + wave) * 64 + lane) * 16); ucur0 = up[0]; ucur1 = up[1]; eglc = EGL[ci0]; }
#define GDN_LDS_BARRIER() asm volatile("s_waitcnt lgkmcnt(0)\n\ts_barrier" ::: "memory")
#pragma unroll 1
        for (int n = 0; n < 64; ++n) {
            const int ci = ci0 + n, buf = n & 1;
            if (n < 63) {
                const u32x4* up = (const u32x4*)(UF + (((size_t)(ci + 1) * 8 + wave) * 64 + lane) * 16); unext0 = up[0]; unext1 = up[1]; egln = EGL[ci + 1]; }
            const unsigned char* base = lds_dyn + buf * GS_STAGE;
            const float egl = eglc;
            const unsigned uw[8] = {ucur0.x, ucur0.y, ucur0.z, ucur0.w, ucur1.x, ucur1.y, ucur1.z, ucur1.w};
            bf16x8 Sb[4];
#pragma unroll
            for (int s = 0; s < 4; ++s) { u32x4 w; w.x = cvt2(S[2 * s][0], S[2 * s][1]); w.y = cvt2(S[2 * s][2], S[2 * s][3]); w.z = cvt2(S[2 * s + 1][0], S[2 * s + 1][1]); w.w = cvt2(S[2 * s + 1][2], S[2 * s + 1][3]); Sb[s] = __builtin_bit_cast(bf16x8, w); }
#define GS_FRAG(off) __builtin_bit_cast(bf16x8, *(const u32x4*)(base + (off)))
#define GS_SB() __builtin_amdgcn_sched_barrier(0)
            bf16x8 fa[4], fb[4];
            f32x4v vn[4], o[4];
            fa[0] = GS_FRAG(GS_W + (16 * 0 + r16) * GS_WSTR + (32 * 0 + 8 * a) * 2); fa[1] = GS_FRAG(GS_W + (16 * 0 + r16) * GS_WSTR + (32 * 1 + 8 * a) * 2); fa[2] = GS_FRAG(GS_W + (16 * 0 + r16) * GS_WSTR + (32 * 2 + 8 * a) * 2); fa[3] = GS_FRAG(GS_W + (16 * 0 + r16) * GS_WSTR + (32 * 3 + 8 * a) * 2); GS_SB();
            fb[0] = GS_FRAG(GS_W + (16 * 1 + r16) * GS_WSTR + (32 * 0 + 8 * a) * 2); fb[1] = GS_FRAG(GS_W + (16 * 1 + r16) * GS_WSTR + (32 * 1 + 8 * a) * 2); fb[2] = GS_FRAG(GS_W + (16 * 1 + r16) * GS_WSTR + (32 * 2 + 8 * a) * 2); fb[3] = GS_FRAG(GS_W + (16 * 1 + r16) * GS_WSTR + (32 * 3 + 8 * a) * 2); GS_SB();
            { f32x4v acc = {0.f, 0.f, 0.f, 0.f}; acc = MFMA16(fa[0], Sb[0], acc); acc = MFMA16(fa[1], Sb[1], acc); acc = MFMA16(fa[2], Sb[2], acc); acc = MFMA16(fa[3], Sb[3], acc); vn[0] = acc; }GS_SB();
            fa[0] = GS_FRAG(GS_W + (16 * 2 + r16) * GS_WSTR + (32 * 0 + 8 * a) * 2); fa[1] = GS_FRAG(GS_W + (16 * 2 + r16) * GS_WSTR + (32 * 1 + 8 * a) * 2); fa[2] = GS_FRAG(GS_W + (16 * 2 + r16) * GS_WSTR + (32 * 2 + 8 * a) * 2); fa[3] = GS_FRAG(GS_W + (16 * 2 + r16) * GS_WSTR + (32 * 3 + 8 * a) * 2); GS_SB();
            { f32x4v acc = {0.f, 0.f, 0.f, 0.f}; acc = MFMA16(fb[0], Sb[0], acc); acc = MFMA16(fb[1], Sb[1], acc); acc = MFMA16(fb[2], Sb[2], acc); acc = MFMA16(fb[3], Sb[3], acc); vn[1] = acc; }GS_SB();
            fb[0] = GS_FRAG(GS_W + (16 * 3 + r16) * GS_WSTR + (32 * 0 + 8 * a) * 2); fb[1] = GS_FRAG(GS_W + (16 * 3 + r16) * GS_WSTR + (32 * 1 + 8 * a) * 2); fb[2] = GS_FRAG(GS_W + (16 * 3 + r16) * GS_WSTR + (32 * 2 + 8 * a) * 2); fb[3] = GS_FRAG(GS_W + (16 * 3 + r16) * GS_WSTR + (32 * 3 + 8 * a) * 2); GS_SB();
            { f32x4v acc = {0.f, 0.f, 0.f, 0.f}; acc = MFMA16(fa[0], Sb[0], acc); acc = MFMA16(fa[1], Sb[1], acc); acc = MFMA16(fa[2], Sb[2], acc); acc = MFMA16(fa[3], Sb[3], acc); vn[2] = acc; }GS_SB();
            fa[0] = GS_FRAG(GS_Q + (16 * 0 + r16) * GS_WSTR + (32 * 0 + 8 * a) * 2); fa[1] = GS_FRAG(GS_Q + (16 * 0 + r16) * GS_WSTR + (32 * 1 + 8 * a) * 2); fa[2] = GS_FRAG(GS_Q + (16 * 0 + r16) * GS_WSTR + (32 * 2 + 8 * a) * 2); fa[3] = GS_FRAG(GS_Q + (16 * 0 + r16) * GS_WSTR + (32 * 3 + 8 * a) * 2); GS_SB();
            { f32x4v acc = {0.f, 0.f, 0.f, 0.f}; acc = MFMA16(fb[0], Sb[0], acc); acc = MFMA16(fb[1], Sb[1], acc); acc = MFMA16(fb[2], Sb[2], acc); acc = MFMA16(fb[3], Sb[3], acc); vn[3] = acc; }GS_SB();
            fb[0] = GS_FRAG(GS_Q + (16 * 1 + r16) * GS_WSTR + (32 * 0 + 8 * a) * 2); fb[1] = GS_FRAG(GS_Q + (16 * 1 + r16) * GS_WSTR + (32 * 1 + 8 * a) * 2); fb[2] = GS_FRAG(GS_Q + (16 * 1 + r16) * GS_WSTR + (32 * 2 + 8 * a) * 2); fb[3] = GS_FRAG(GS_Q + (16 * 1 + r16) * GS_WSTR + (32 * 3 + 8 * a) * 2); GS_SB();
#pragma unroll
            for (int mt = 0; mt < 4; ++mt) { vn[mt][0] = bf2f((bf16)(uw[2 * mt] & 0xffff)) - vn[mt][0]; vn[mt][1] = bf2f((bf16)(uw[2 * mt] >> 16)) - vn[mt][1];
                vn[mt][2] = bf2f((bf16)(uw[2 * mt + 1] & 0xffff)) - vn[mt][2]; vn[mt][3] = bf2f((bf16)(uw[2 * mt + 1] >> 16)) - vn[mt][3]; }
            bf16x8 vb[2];
#pragma unroll
            for (int s2 = 0; s2 < 2; ++s2) { u32x4 w; w.x = cvt2(vn[2 * s2][0], vn[2 * s2][1]); w.y = cvt2(vn[2 * s2][2], vn[2 * s2][3]); w.z = cvt2(vn[2 * s2 + 1][0], vn[2 * s2 + 1][1]); w.w = cvt2(vn[2 * s2 + 1][2], vn[2 * s2 + 1][3]); vb[s2] = __builtin_bit_cast(bf16x8, w); }
            { f32x4v acc = {0.f, 0.f, 0.f, 0.f}; acc = MFMA16(fa[0], Sb[0], acc); acc = MFMA16(fa[1], Sb[1], acc); acc = MFMA16(fa[2], Sb[2], acc); acc = MFMA16(fa[3], Sb[3], acc); o[0] = acc; }GS_SB();
            fa[0] = GS_FRAG(GS_Q + (16 * 2 + r16) * GS_WSTR + (32 * 0 + 8 * a) * 2); fa[1] = GS_FRAG(GS_Q + (16 * 2 + r16) * GS_WSTR + (32 * 1 + 8 * a) * 2); fa[2] = GS_FRAG(GS_Q + (16 * 2 + r16) * GS_WSTR + (32 * 2 + 8 * a) * 2); fa[3] = GS_FRAG(GS_Q + (16 * 2 + r16) * GS_WSTR + (32 * 3 + 8 * a) * 2); GS_SB();
            { f32x4v acc = {0.f, 0.f, 0.f, 0.f}; acc = MFMA16(fb[0], Sb[0], acc); acc = MFMA16(fb[1], Sb[1], acc); acc = MFMA16(fb[2], Sb[2], acc); acc = MFMA16(fb[3], Sb[3], acc); o[1] = acc; }GS_SB();
            fb[0] = GS_FRAG(GS_Q + (16 * 3 + r16) * GS_WSTR + (32 * 0 + 8 * a) * 2); fb[1] = GS_FRAG(GS_Q + (16 * 3 + r16) * GS_WSTR + (32 * 1 + 8 * a) * 2); fb[2] = GS_FRAG(GS_Q + (16 * 3 + r16) * GS_WSTR + (32 * 2 + 8 * a) * 2); fb[3] = GS_FRAG(GS_Q + (16 * 3 + r16) * GS_WSTR + (32 * 3 + 8 * a) * 2); GS_SB();
            { f32x4v acc = {0.f, 0.f, 0.f, 0.f}; acc = MFMA16(fa[0], Sb[0], acc); acc = MFMA16(fa[1], Sb[1], acc); acc = MFMA16(fa[2], Sb[2], acc); acc = MFMA16(fa[3], Sb[3], acc); o[2] = acc; }GS_SB();
            fa[0] = GS_FRAG(GS_A + (16 * 0 + r16) * GS_TSTR + (32 * 0 + 8 * a) * 2); fa[1] = GS_FRAG(GS_A + (16 * 0 + r16) * GS_TSTR + (32 * 1 + 8 * a) * 2); fa[2] = GS_FRAG(GS_A + (16 * 1 + r16) * GS_TSTR + (32 * 0 + 8 * a) * 2); fa[3] = GS_FRAG(GS_A + (16 * 1 + r16) * GS_TSTR + (32 * 1 + 8 * a) * 2); GS_SB();
            { f32x4v acc = {0.f, 0.f, 0.f, 0.f}; acc = MFMA16(fb[0], Sb[0], acc); acc = MFMA16(fb[1], Sb[1], acc); acc = MFMA16(fb[2], Sb[2], acc); acc = MFMA16(fb[3], Sb[3], acc); o[3] = acc; }GS_SB();
            fb[0] = GS_FRAG(GS_A + (16 * 2 + r16) * GS_TSTR + (32 * 0 + 8 * a) * 2); fb[1] = GS_FRAG(GS_A + (16 * 2 + r16) * GS_TSTR + (32 * 1 + 8 * a) * 2); fb[2] = GS_FRAG(GS_A + (16 * 3 + r16) * GS_TSTR + (32 * 0 + 8 * a) * 2); fb[3] = GS_FRAG(GS_A + (16 * 3 + r16) * GS_TSTR + (32 * 1 + 8 * a) * 2); GS_SB();
            o[0] = MFMA16(fa[0], vb[0], o[0]); o[0] = MFMA16(fa[1], vb[1], o[0]); o[1] = MFMA16(fa[2], vb[0], o[1]); o[1] = MFMA16(fa[3], vb[1], o[1]); GS_SB();
            fa[0] = GS_FRAG(GS_KD + (16 * 0 + r16) * GS_TSTR + (32 * 0 + 8 * a) * 2); fa[1] = GS_FRAG(GS_KD + (16 * 0 + r16) * GS_TSTR + (32 * 1 + 8 * a) * 2); fa[2] = GS_FRAG(GS_KD + (16 * 1 + r16) * GS_TSTR + (32 * 0 + 8 * a) * 2); fa[3] = GS_FRAG(GS_KD + (16 * 1 + r16) * GS_TSTR + (32 * 1 + 8 * a) * 2); GS_SB();
            o[2] = MFMA16(fb[0], vb[0], o[2]); o[2] = MFMA16(fb[1], vb[1], o[2]); o[3] = MFMA16(fb[2], vb[0], o[3]); o[3] = MFMA16(fb[3], vb[1], o[3]); GS_SB();
            fb[0] = GS_FRAG(GS_KD + (16 * 2 + r16) * GS_TSTR + (32 * 0 + 8 * a) * 2); fb[1] = GS_FRAG(GS_KD + (16 * 2 + r16) * GS_TSTR + (32 * 1 + 8 * a) * 2); fb[2] = GS_FRAG(GS_KD + (16 * 3 + r16) * GS_TSTR + (32 * 0 + 8 * a) * 2); fb[3] = GS_FRAG(GS_KD + (16 * 3 + r16) * GS_TSTR + (32 * 1 + 8 * a) * 2); GS_SB();
            { f32x4v acc = S[0] * egl; acc = MFMA16(fa[0], vb[0], acc); acc = MFMA16(fa[1], vb[1], acc); S[0] = acc; } { f32x4v acc = S[1] * egl; acc = MFMA16(fa[2], vb[0], acc); acc = MFMA16(fa[3], vb[1], acc); S[1] = acc; } GS_SB();
            fa[0] = GS_FRAG(GS_KD + (16 * 4 + r16) * GS_TSTR + (32 * 0 + 8 * a) * 2); fa[1] = GS_FRAG(GS_KD + (16 * 4 + r16) * GS_TSTR + (32 * 1 + 8 * a) * 2); fa[2] = GS_FRAG(GS_KD + (16 * 5 + r16) * GS_TSTR + (32 * 0 + 8 * a) * 2); fa[3] = GS_FRAG(GS_KD + (16 * 5 + r16) * GS_TSTR + (32 * 1 + 8 * a) * 2); GS_SB();
            { f32x4v acc = S[2] * egl; acc = MFMA16(fb[0], vb[0], acc); acc = MFMA16(fb[1], vb[1], acc); S[2] = acc; } { f32x4v acc = S[3] * egl; acc = MFMA16(fb[2], vb[0], acc); acc = MFMA16(fb[3], vb[1], acc); S[3] = acc; } GS_SB();
            fb[0] = GS_FRAG(GS_KD + (16 * 6 + r16) * GS_TSTR + (32 * 0 + 8 * a) * 2); fb[1] = GS_FRAG(GS_KD + (16 * 6 + r16) * GS_TSTR + (32 * 1 + 8 * a) * 2); fb[2] = GS_FRAG(GS_KD + (16 * 7 + r16) * GS_TSTR + (32 * 0 + 8 * a) * 2); fb[3] = GS_FRAG(GS_KD + (16 * 7 + r16) * GS_TSTR + (32 * 1 + 8 * a) * 2); GS_SB();
            { f32x4v acc = S[4] * egl; acc = MFMA16(fa[0], vb[0], acc); acc = MFMA16(fa[1], vb[1], acc); S[4] = acc; } { f32x4v acc = S[5] * egl; acc = MFMA16(fa[2], vb[0], acc); acc = MFMA16(fa[3], vb[1], acc); S[5] = acc; } GS_SB();
            { f32x4v acc = S[6] * egl; acc = MFMA16(fb[0], vb[0], acc); acc = MFMA16(fb[1], vb[1], acc); S[6] = acc; } { f32x4v acc = S[7] * egl; acc = MFMA16(fb[2], vb[0], acc); acc = MFMA16(fb[3], vb[1], acc); S[7] = acc; } GS_SB();
#undef GS_FRAG
#undef GS_SB
            const size_t mrow = (size_t)b * SEQ + n * 64;
#pragma unroll
            for (int mt = 0; mt < 4; ++mt)
#pragma unroll
                for (int reg = 0; reg < 4; ++reg) mix[(mrow + 16 * mt + 4 * a + reg) * D_MODEL + h * 128 + 16 * wave + r16] = (bf16)(cvt2(o[mt][reg], 0.f) & 0xffffu);
            if (n < 63) lwrite(buf ^ 1);
            if (n < 62) gload(ci + 2);
            GDN_LDS_BARRIER();
            ucur0 = unext0; ucur1 = unext1; eglc = egln;
        }
        asm volatile("s_waitcnt vmcnt(0)" ::: "memory"); __syncthreads(); __builtin_amdgcn_fence(__ATOMIC_ACQUIRE, "agent");
        { const int c0 = (tid & 7) * 16; const float* ngp = norm_g + c0; float ngv[16];
#pragma unroll
          for (int e = 0; e < 16; ++e) ngv[e] = ngp[e];
#pragma unroll 2
          for (int tk = tid >> 3; tk < SEQ; tk += NTHREADS / 8) { const size_t m = (size_t)b * SEQ + tk;
              u32x4* op = (u32x4*)(mix + m * D_MODEL + h * 128 + c0); const u32x4* zp = (const u32x4*)(proj + m * NPROJ + PC_ZA + h * 128 + c0);
              const u32x4 o0 = op[0], o1 = op[1], z0 = zp[0], z1 = zp[1];
              const unsigned ow[8] = {o0.x, o0.y, o0.z, o0.w, o1.x, o1.y, o1.z, o1.w}, zw[8] = {z0.x, z0.y, z0.z, z0.w, z1.x, z1.y, z1.z, z1.w};
              float ov[16]; float ss = 0.f;
#pragma unroll
              for (int e = 0; e < 8; ++e) { ov[2 * e] = __uint_as_float(ow[e] << 16); ov[2 * e + 1] = __uint_as_float(ow[e] & 0xffff0000u); ss += ov[2 * e] * ov[2 * e] + ov[2 * e + 1] * ov[2 * e + 1]; }
              ss += __shfl_xor(ss, 1); ss += __shfl_xor(ss, 2); ss += __shfl_xor(ss, 4);
              const float rstd = rsqrtf(ss * (1.f / 128.f) + NORM_EPS);
              unsigned rw[8];
#pragma unroll
              for (int e = 0; e < 8; ++e) { const float za = __uint_as_float(zw[e] << 16), zb2 = __uint_as_float(zw[e] & 0xffff0000u);
                  rw[e] = cvt2(ov[2 * e] * rstd * ngv[2 * e] * siluf_(za), ov[2 * e + 1] * rstd * ngv[2 * e + 1] * siluf_(zb2)); }
              op[0] = (u32x4){rw[0], rw[1], rw[2], rw[3]}; op[1] = (u32x4){rw[4], rw[5], rw[6], rw[7]}; } }
#undef GDN_LDS_BARRIER
    }
}

constexpr int CP_STR = 272;
constexpr int CP_STAGE = 128 * CP_STR, CP_HID = 2 * CP_STAGE;
__device__ __forceinline__ float gelu_fast(float x) { const float u = 1.5957691216057308f * (x + 0.044715f * x * x * x); return x * __builtin_amdgcn_rcpf(1.0f + __expf(-u)); }
__device__ __forceinline__ void ph_cmp_c1(const float* __restrict__ pos, const float* __restrict__ w1, float* __restrict__ C1) {
    extern __shared__ __attribute__((aligned(16))) unsigned char lds_dyn[];
    const int tid = ltid(); float* red = (float*)lds_dyn;
    for (int o = blockIdx.x; o < 256; o += gridDim.x) { const int kv = o >> 7, j = o & 127; const float* p = pos + kv * 4096; const float* w = w1 + (size_t)kv * 4096 * 128 + j; float s = 0.f;
#pragma unroll
        for (int e = 0; e < 8; ++e) { const int i = tid * 8 + e; s += p[i] * w[(size_t)i * 128]; }
        s = wave_sum(s);
        __syncthreads();
        if ((tid & 63) == 0) red[tid >> 6] = s;
        __syncthreads();
        if (tid == 0) C1[o] = ((red[0] + red[1]) + (red[2] + red[3])) + ((red[4] + red[5]) + (red[6] + red[7])); }
    __syncthreads();
}
__device__ __forceinline__ void ph_nsa_compress_fast(const bf16* __restrict__ proj, const bf16* __restrict__ W1T, const bf16* __restrict__ W2T, const float* __restrict__ C1, const float* __restrict__ kg,
                                                     bf16* __restrict__ KCB, bf16* __restrict__ VCT) {
    extern __shared__ __attribute__((aligned(16))) unsigned char lds_dyn[];
    const int tid0 = ltid();
    for (int item = blockIdx.x; item < 64; item += gridDim.x) {
        int tid = tid0; asm volatile("" : "+v"(tid));
        const int lane = tid & 63, wave = tid >> 6, r16 = lane & 15, a = lane >> 4;
        const int half = item & 1, kv = (item >> 1) & 1, g = (item >> 2) & 1, b = item >> 3;
        const int mt = half * 8 + wave, n = 16 * mt + r16;
        const bf16* arow = proj + (size_t)b * SEQ * NPROJ + (kv ? PC_VCC : PC_KCC) + g * 128 + 8 * a;
        const bf16* w1t = W1T + (size_t)kv * 128 * 4096;
        u32x4 st[4];
        auto gload = [&](int l) {
#pragma unroll
            for (int i = 0; i < 4; ++i) { const int c = tid + 512 * i; st[i] = *(const u32x4*)(w1t + (size_t)(c >> 4) * 4096 + l * 128 + (c & 15) * 8); } };
        auto lwrite = [&](int buf) {
#pragma unroll
            for (int i = 0; i < 4; ++i) { const int c = tid + 512 * i; *(u32x4*)(lds_dyn + buf * CP_STAGE + (c >> 4) * CP_STR + (c & 15) * 16) = st[i]; } };
        f32x4v acc[8];
#pragma unroll
        for (int i = 0; i < 8; ++i) acc[i] = (f32x4v){0.f, 0.f, 0.f, 0.f};
        __syncthreads();
        gload(0); lwrite(0);
        __syncthreads();
#pragma unroll 1
        for (int l = 0; l < 32; ++l) {
            const int buf = l & 1;
            if (l < 31) gload(l + 1);
            const int tok = 16 * n + l < SEQ ? 16 * n + l : SEQ - 1;
            bf16x8 af[4];
#pragma unroll
            for (int s = 0; s < 4; ++s) af[s] = ld_frag(arow + (size_t)tok * NPROJ + 32 * s);
            const unsigned char* wb = lds_dyn + buf * CP_STAGE + r16 * CP_STR + 16 * a;
#pragma unroll
            for (int s = 0; s < 4; ++s)
#pragma unroll
                for (int nt = 0; nt < 8; ++nt) acc[nt] = MFMA16(af[s], __builtin_bit_cast(bf16x8, *(const u32x4*)(wb + nt * 16 * CP_STR + 64 * s)), acc[nt]);
            if (l < 31) lwrite(buf ^ 1);
            __syncthreads();
        }
        unsigned char* hs = lds_dyn + CP_HID + wave * 16 * CP_STR;
#pragma unroll
        for (int nt = 0; nt < 8; ++nt) { const float c1 = C1[kv * 128 + 16 * nt + r16];
#pragma unroll
            for (int reg = 0; reg < 4; ++reg) *(bf16*)(hs + (4 * a + reg) * CP_STR + (16 * nt + r16) * 2) = f2bf(gelu_fast(acc[nt][reg] + c1)); }
        __builtin_amdgcn_s_waitcnt(0); asm volatile("" ::: "memory");
        bf16x8 hf[4];
#pragma unroll
        for (int s = 0; s < 4; ++s) hf[s] = __builtin_bit_cast(bf16x8, *(const u32x4*)(hs + r16 * CP_STR + 64 * s + 16 * a));
        const bf16* w2t = W2T + (size_t)kv * 128 * 128 + (size_t)r16 * 128 + 8 * a;
        f32x4v o2[8];
#pragma unroll
        for (int nt = 0; nt < 8; ++nt) { f32x4v c = {0.f, 0.f, 0.f, 0.f};
#pragma unroll
            for (int s = 0; s < 4; ++s) c = MFMA16(hf[s], ld_frag(w2t + (size_t)nt * 16 * 128 + 32 * s), c);
            o2[nt] = c; }
        const size_t bg = (size_t)(b * 2 + g);
        if (kv == 0) {
            float rs[4];
#pragma unroll
            for (int reg = 0; reg < 4; ++reg) { float q2 = 0.f;
#pragma unroll
                for (int nt = 0; nt < 8; ++nt) q2 += o2[nt][reg] * o2[nt][reg];
                rs[reg] = rsqrtf(row16_sum(q2) * (1.f / 128.f) + NORM_EPS); }
#pragma unroll
            for (int nt = 0; nt < 8; ++nt) { const float gn = kg[16 * nt + r16];
#pragma unroll
                for (int reg = 0; reg < 4; ++reg) { const int nn = 16 * mt + 4 * a + reg; KCB[(bg * 256 + nn) * 128 + 16 * nt + r16] = f2bf(nn < N_CMP ? o2[nt][reg] * rs[reg] * gn : 0.f); } }
        } else {
#pragma unroll
            for (int nt = 0; nt < 8; ++nt) { const bool last = (mt == 15 && a == 3);
                u32x2 w; w.x = cvt2(o2[nt][0], o2[nt][1]); w.y = cvt2(o2[nt][2], last ? 0.f : o2[nt][3]);
                *(u32x2*)(VCT + (bg * 128 + 16 * nt + r16) * 256 + 16 * mt + 8 * (a & 1) + 4 * (a >> 1)) = w; }
        }
    }
    __syncthreads();
}

constexpr int SG_STR = 272;
__device__ __forceinline__ void ph_sgu_wprep(const float* __restrict__ sgu_w, bf16* __restrict__ WSG) {
    const int tid = ltid();
    for (int i = blockIdx.x * NTHREADS + tid; i < 4 * 128 * 128 / 2; i += gridDim.x * NTHREADS) { const int e = 2 * i, s = e & 127, t = (e >> 7) & 127;
        const f32x2 w = *(const f32x2*)(sgu_w + e); *(unsigned*)(WSG + e) = cvt2(s <= t ? w.x : 0.f, s + 1 <= t ? w.y : 0.f); }
}
__device__ __forceinline__ void ph_sgu_mix_fast(const bf16* __restrict__ proj, const bf16* __restrict__ VLN, const bf16* __restrict__ WSG, const float* __restrict__ sgu_b, bf16* __restrict__ mix, unsigned* __restrict__ queue) {
    extern __shared__ __attribute__((aligned(16))) unsigned char lds_dyn[];
    const int tid0 = ltid();
    volatile unsigned* qw = (volatile unsigned*)(lds_dyn + 128 * SG_STR);
    for (;;) {
        int tid = tid0; asm volatile("" : "+v"(tid));
        __syncthreads();
        if (tid == 0) *qw = __hip_atomic_fetch_add(queue, 1u, __ATOMIC_RELAXED, __HIP_MEMORY_SCOPE_AGENT);
        __syncthreads();
        const int item = (int)*qw;
        if (item >= BATCH * 32 * 4) break;
        const int lane = tid & 63, wave = tid >> 6, r16 = lane & 15, a = lane >> 4;
        const int g = item & 3, n = (item >> 2) & 31, b = item >> 7;
        const size_t m0 = (size_t)b * SEQ + n * 128;
        __syncthreads();
#pragma unroll
        for (int i = 0; i < 4; ++i) { const int c = tid + 512 * i, s = c >> 4, part = c & 15;
            *(u32x4*)(lds_dyn + s * SG_STR + part * 16) = *(const u32x4*)(VLN + (m0 + s) * 512 + g * 128 + part * 8); }
        const int nks = ((16 * wave + 15) >> 5) + 1;
        bf16x8 wf[4];
#pragma unroll
        for (int ks = 0; ks < 4; ++ks) wf[ks] = ld_frag(WSG + ((size_t)g * 128 + 16 * wave + r16) * 128 + 32 * ks + 8 * a);
        __syncthreads();
#pragma unroll 2
        for (int nt = 0; nt < 8; ++nt) {
            f32x4v acc = {0.f, 0.f, 0.f, 0.f};
#pragma unroll
            for (int ks = 0; ks < 4; ++ks) if (ks < nks) {
                const unsigned char* vp = lds_dyn + (32 * ks + 8 * a) * SG_STR + (16 * nt + r16) * 2;
                bf16x8 bfr;
#pragma unroll
                for (int j = 0; j < 8; ++j) bfr[j] = *(const short*)(vp + j * SG_STR);
                acc = MFMA16(bfr, wf[ks], acc);
            }
            { const int t = 16 * wave + r16, c = 16 * nt + 4 * a; const float bs = sgu_b[g * 128 + t];
              const u32x2 uu = *(const u32x2*)(proj + (m0 + t) * NPROJ + PC_UB + g * 128 + c);
              u32x2 w; w.x = cvt2(gelu_fast(bf2f((bf16)(uu.x & 0xffff))) * (acc[0] + bs), gelu_fast(bf2f((bf16)(uu.x >> 16))) * (acc[1] + bs));
              w.y = cvt2(gelu_fast(bf2f((bf16)(uu.y & 0xffff))) * (acc[2] + bs), gelu_fast(bf2f((bf16)(uu.y >> 16))) * (acc[3] + bs));
              *(u32x2*)(mix + (m0 + t) * D_MODEL + 768 + g * 128 + c) = w; }
        }
    }
    __syncthreads();
}

constexpr int N_SCAN_WG = 48;
__global__ void __launch_bounds__(NTHREADS, 2) mega(Params P) {
    extern __shared__ __attribute__((aligned(16))) unsigned char lds_dyn[];
    volatile LAS unsigned* st = (volatile LAS unsigned*)(lds_dyn + LDS_MISC);
    if (threadIdx.x == 0) { st[0] = 0u; st[1] = 0u; st[2] = 0u; st[3] = 0u;
        volatile LAS unsigned long long* tab = (volatile LAS unsigned long long*)(lds_dyn + LDS_PTAB);
#pragma unroll
        for (int i = 0; i < 21; ++i) tab[i] = (unsigned long long)P.in[i];
        tab[21] = (unsigned long long)P.out; tab[22] = (unsigned long long)P.ws; }
    __syncthreads();
    unsigned bar_x;
    { const XcdBarrier bar0 = xcd_barrier_post((unsigned*)(P.ws + WS_CTL), st); bar_x = bar0.x; }
#define GRID_BAR() do { XcdBarrier b_; b_.bar = (unsigned*)(gptr(22) + WS_CTL); b_.x = bar_x; b_.st = st; asm volatile("" : "+s"(b_.x)); xcd_barrier(b_); } while (0)
#define WSP() (gptr(22))
#define OUTP() ((float*)gptr(21))
    const int G = (int)gridDim.x;
#pragma unroll 1
    for (int l = 0; l < DEPTH; ++l) {
        { unsigned char* ws = WSP();
        ph_transpose<1>(in_ptr(I_W_IN) + (size_t)l * D_MODEL * NPROJ_ORIG, D_MODEL, NPROJ_ORIG, (bf16*)(ws + WS_WIN), NPROJ, in_ptr(I_ATTN_NORM) + l * D_MODEL);
        ph_transpose<0>(in_ptr(I_CMP_W1) + (size_t)l * 2 * 4096 * 128, 4096, 128, (bf16*)(ws + WS_W1T), 128);
        ph_transpose<0>(in_ptr(I_CMP_W1) + (size_t)(l * 2 + 1) * 4096 * 128, 4096, 128, (bf16*)(ws + WS_W1T) + 128 * 4096, 128);
        ph_transpose<0>(in_ptr(I_CMP_W2) + (size_t)l * 2 * 128 * 128, 128, 128, (bf16*)(ws + WS_W2T), 128);
        ph_transpose<0>(in_ptr(I_CMP_W2) + (size_t)(l * 2 + 1) * 128 * 128, 128, 128, (bf16*)(ws + WS_W2T) + 128 * 128, 128);
        ph_sgu_wprep(in_ptr(I_SGU_W) + (size_t)l * 4 * 128 * 128, (bf16*)(ws + WS_WSG));
        ph_cmp_c1(in_ptr(I_CMP_POS) + (size_t)l * 2 * 4096, in_ptr(I_CMP_W1) + (size_t)l * 2 * 4096 * 128, (float*)(ws + WS_C1));
        if (l == 0) ph_xg0(in_ptr(I_X), in_ptr(I_ATTN_NORM), (bf16*)OUTP(), (float*)(ws + WS_RSQ1));
        else ph_rowsq_reduce((const float*)(ws + WS_RSP), (float*)(ws + WS_RSQ1)); }
        GRID_BAR();
        { unsigned char* ws = WSP(); pg8::Gemm g{(bf16*)OUTP(), (bf16*)(ws + WS_WIN), M, NPROJ, D_MODEL, 0}; pg8::EpiProj E{(bf16*)(ws + WS_PROJ), (float*)(ws + WS_SMALL), (const float*)(ws + WS_RSQ1), NPROJ, PC_SMALL / 256}; pg8::StaticOrder S; S.init(M, NPROJ, G, (int)blockIdx.x);
          pg8::gemm_phase<pg8::EpiProj, pg8::StaticOrder, true, true>((PG8_LAS unsigned char*)lds_dyn, g, S, E); }
        GRID_BAR();
        { unsigned char* ws = WSP(); ph_nsa_compress_fast((bf16*)(ws + WS_PROJ), (bf16*)(ws + WS_W1T), (bf16*)(ws + WS_W2T), (float*)(ws + WS_C1), in_ptr(I_NSA_KN) + l * 128, (bf16*)(ws + WS_KCB), (bf16*)(ws + WS_VCT)); }
        { unsigned char* ws = WSP(); ph_gdn_prep_fast<0>((bf16*)(ws + WS_PROJ), (float*)(ws + WS_SMALL), in_ptr(I_CONV_A) + (size_t)l * 4 * 2304, in_ptr(I_A_LOG) + l * 6, in_ptr(I_DT_BIAS) + l * 6,
                                                      (bf16*)(ws + WS_UF), (bf16*)(ws + WS_WP), (bf16*)(ws + WS_QGP), (bf16*)(ws + WS_KDT), (bf16*)(ws + WS_AP), (float*)(ws + WS_EGL), (unsigned*)(ws + WS_CTL + CTL_QUEUE) + 64 * (8 + l)); }
        { unsigned char* ws = WSP(); ph_sgu_prep((bf16*)(ws + WS_PROJ), in_ptr(I_SGU_LN_G) + l * 512, in_ptr(I_SGU_LN_B) + l * 512, (bf16*)(ws + WS_VLN)); }
        { unsigned char* ws = WSP(); ph_nsa_prep2((bf16*)(ws + WS_PROJ), in_ptr(I_NSA_QN) + l * 128, in_ptr(I_NSA_KN) + l * 128, (bf16*)(ws + WS_NQ), (bf16*)(ws + WS_NKS), (bf16*)(ws + WS_NKW), (bf16*)(ws + WS_VST), (bf16*)(ws + WS_VWT)); }
        GRID_BAR();
        { unsigned char* ws = WSP();
        ph_transpose<0>(in_ptr(I_W_OUT) + (size_t)l * D_MODEL * D_MODEL, D_MODEL, D_MODEL, (bf16*)(ws + WS_WOUT), D_MODEL);
        ph_transpose<0>(in_ptr(I_W_UP) + (size_t)l * D_MODEL * D_FF, D_MODEL, D_FF, (bf16*)(ws + WS_WUP), D_FF, in_ptr(I_MLP_NORM) + l * D_MODEL);
        ph_transpose<0>(in_ptr(I_W_DOWN) + (size_t)l * D_FF * D_MODEL, D_FF, D_MODEL, (bf16*)(ws + WS_WDN), D_MODEL);
        }
        { unsigned char* ws = WSP(); ph_nsa_select_fast((bf16*)(ws + WS_NQ), (bf16*)(ws + WS_KCB), (bf16*)(ws + WS_VCT), (float*)(ws + WS_SMALL), in_ptr(I_REL_BIAS), (unsigned long long*)(ws + WS_SELM), (bf16*)(ws + WS_HB)); }
        { unsigned char* ws = WSP(); ph_sgu_mix_fast((bf16*)(ws + WS_PROJ), (bf16*)(ws + WS_VLN), (bf16*)(ws + WS_WSG), in_ptr(I_SGU_B) + l * 512, (bf16*)(ws + WS_HB), (unsigned*)(ws + WS_CTL + CTL_QUEUE) + 64 * (4 + l)); }
        GRID_BAR();
        if ((int)blockIdx.x < N_SCAN_WG) { unsigned char* ws = WSP(); ph_gdn_scan_fast((bf16*)(ws + WS_UF), (bf16*)(ws + WS_WP), (bf16*)(ws + WS_QGP), (bf16*)(ws + WS_KDT), (bf16*)(ws + WS_AP), (float*)(ws + WS_EGL), (bf16*)(ws + WS_PROJ), in_ptr(I_GDN_NORM) + l * 128, (bf16*)(ws + WS_HB), N_SCAN_WG); }
        { unsigned char* ws = WSP(); ph_nsa_main((bf16*)(ws + WS_NQ), (bf16*)(ws + WS_NKS), (bf16*)(ws + WS_NKW), (bf16*)(ws + WS_VST), (bf16*)(ws + WS_VWT), (unsigned long long*)(ws + WS_SELM), (bf16*)(ws + WS_HB),
                                                 (float*)(ws + WS_SMALL), in_ptr(I_REL_BIAS), (bf16*)(ws + WS_HB), (unsigned*)(ws + WS_CTL + CTL_QUEUE) + 64 * l); }
        GRID_BAR();
        { unsigned char* ws = WSP(); float* out = OUTP(); pg8::Gemm g{(bf16*)(ws + WS_HB), (bf16*)(ws + WS_WOUT), M, D_MODEL, D_MODEL, 0}; pg8::EpiRes E{(const bf16*)out, (bf16*)(ws + WS_XG2), nullptr, (float*)(ws + WS_RSP), D_MODEL, 0}; pg8::StaticOrder S; S.init(M, D_MODEL, G, (int)blockIdx.x);
          pg8::gemm_phase<pg8::EpiRes, pg8::StaticOrder, true, true>((PG8_LAS unsigned char*)lds_dyn, g, S, E); }
        GRID_BAR();
        { unsigned char* ws = WSP(); ph_rowsq_reduce((const float*)(ws + WS_RSP), (float*)(ws + WS_RSQ2)); }
        GRID_BAR();
        { unsigned char* ws = WSP(); pg8::Gemm g{(bf16*)(ws + WS_XG2), (bf16*)(ws + WS_WUP), M, D_FF, D_MODEL, 0}; pg8::EpiRelu2 E{(bf16*)(ws + WS_HID), (const float*)(ws + WS_RSQ2), D_FF, 0}; pg8::StaticOrder S; S.init(M, D_FF, G, (int)blockIdx.x);
          pg8::gemm_phase<pg8::EpiRelu2, pg8::StaticOrder, true, true>((PG8_LAS unsigned char*)lds_dyn, g, S, E); }
        GRID_BAR();
        { unsigned char* ws = WSP(); float* out = OUTP(); pg8::Gemm g{(bf16*)(ws + WS_HID), (bf16*)(ws + WS_WDN), M, D_MODEL, D_FF, 0}; pg8::EpiRes E{(const bf16*)(ws + WS_XG2), (bf16*)out, l + 1 < DEPTH ? nullptr : out, (float*)(ws + WS_RSP), D_MODEL, 0}; pg8::StaticOrder S; S.init(M, D_MODEL, G, (int)blockIdx.x);
          pg8::gemm_phase<pg8::EpiRes, pg8::StaticOrder, true, true>((PG8_LAS unsigned char*)lds_dyn, g, S, E); }
        GRID_BAR();
    }
}

extern "C" void kernel_launch(void* const* d_in, const int* in_sizes, int n_in, void* d_out, int out_size, void* d_ws, size_t ws_size, hipStream_t stream) {
    static int grid = 0;
    if (grid == 0) {
        if (n_in != 21 || in_sizes[0] != M * D_MODEL || out_size != M * D_MODEL || ws_size < WS_END) {
            fprintf(stderr, "kernel_launch: unexpected shapes: n_in %d in0 %d out %d ws %zu (need %zu)\n", n_in, n_in > 0 ? in_sizes[0] : -1, out_size, ws_size, (size_t)WS_END); grid = -1; return; }
        int dev = 0, cus = 0, per_cu = 0; (void)hipGetDevice(&dev); (void)hipDeviceGetAttribute(&cus, hipDeviceAttributeMultiprocessorCount, dev);
        if (hipFuncSetAttribute((const void*)mega, hipFuncAttributeMaxDynamicSharedMemorySize, LDS_BYTES) != hipSuccess) { fprintf(stderr, "kernel_launch: hipFuncSetAttribute failed\n"); grid = -1; return; }
        if (hipOccupancyMaxActiveBlocksPerMultiprocessor(&per_cu, (const void*)mega, NTHREADS, LDS_BYTES) != hipSuccess || per_cu < 1) fprintf(stderr, "kernel_launch: occupancy query says %d\n", per_cu);
        (void)hipGetLastError();
        grid = cus > 0 ? cus : 256;
    }
    if (grid < 0) return;
    (void)hipMemsetAsync((char*)d_ws + WS_CTL, 0, 65536, stream);
    Params p{};
    for (int i = 0; i < 21; ++i) p.in[i] = (const float*)d_in[i];
    p.out = (float*)d_out; p.ws = (unsigned char*)d_ws;
    hipLaunchKernelGGL(mega, dim3(grid), dim3(NTHREADS), LDS_BYTES, stream, p);
}
```

```cpp
#include <hip/hip_runtime.h>
#include <cstdio>
#include <cstdint>
namespace pg8 {
#define PG8_LAS __attribute__((address_space(3)))
typedef unsigned short bf16_t;
typedef short bf16x8 __attribute__((ext_vector_type(8)));
typedef float f32x4 __attribute__((ext_vector_type(4)));
typedef unsigned u32x4 __attribute__((ext_vector_type(4)));
constexpr int BM = 256, BK = 64, HALF = 128, HTB = HALF * BK * 2  , STAGE_BYTES = 8 * HTB, NXCD = 8, WGM = 4;

__host__ __device__ __forceinline__ int lds_byte(int r, int c) { const int st = (r >> 4) * 2 + (c >> 5), rr = r & 15, cc = c & 31, ob = rr * 64 + cc * 2; return st * 1024 + (ob ^ (((ob >> 9) & 1) << 5)); }
__host__ __device__ __forceinline__ void stage_rc(int b, int& R, int& C) { const int st = b / 1024, sb = b % 1024, swz = sb ^ (((sb >> 9) & 1) << 5); R = (st >> 1) * 16 + swz / 64; C = (st & 1) * 32 + (swz % 64) / 2; }
__host__ __device__ __forceinline__ int perm32(int rho) { const int n = rho >> 4, i = rho & 15; return 8 * (i >> 2) + 4 * n + (i & 3); }

struct Unit { int pm, pn; };
struct Gemm { const bf16_t* A; const bf16_t* Bt; int M, N, K, pad; };

struct StaticOrder {
    int nM, nN, nwg, G, c;
    __host__ __device__ void init(int M, int N, int G_, int c_) { nM = M / BM; nN = N / BM; nwg = nM * nN; G = G_; c = c_; }
    __host__ __device__ bool next(int i, Unit& u) const {
        const long L = (long)i * G + c; if (L >= nwg) return false;
        int wgid = (int)L; { const int q = nwg / NXCD, r = nwg % NXCD, xcd = wgid % NXCD, off = wgid / NXCD; wgid = (xcd < r ? xcd * (q + 1) : r * (q + 1) + (xcd - r) * q) + off; }
        const int nig = WGM * nN, gid = wgid / nig, fm = gid * WGM, gsz = (nM - fm) < WGM ? (nM - fm) : WGM;
        u.pm = fm + ((wgid % nig) % gsz); u.pn = (wgid % nig) / gsz; return true;
    }
    __device__ __forceinline__ void a_ready(const Unit&) const {}
    __device__ __forceinline__ void done(const Unit&) const {}
};
__device__ __forceinline__ unsigned cvt_pk_bf16(float lo, float hi) { unsigned r; asm volatile("v_cvt_pk_bf16_f32 %0, %1, %2" : "=v"(r) : "v"(lo), "v"(hi)); return r; }

struct EpiProj {
    static constexpr bool PERM = true, AFTER_DRAIN = false;
    bf16_t* O; float* small; const float* rowsq; int ldc; int small_pn;
    __device__ __forceinline__ void operator()(const f32x4 (&acc)[2][2][4][2], const Unit& u, int wr, int wc, int fr, int fq) const {
        const int row0 = u.pm * BM + wr * 64 + fr;
        float rs[2][4];
#pragma unroll
        for (int ai = 0; ai < 2; ++ai)
#pragma unroll
            for (int m = 0; m < 4; ++m) rs[ai][m] = rsqrtf(rowsq[row0 + ai * HALF + m * 16] * (1.0f / 2048.0f) + 1e-6f);
        if (u.pn == small_pn) {
            if (wc == 0) {
#pragma unroll
                for (int ai = 0; ai < 2; ++ai)
#pragma unroll
                    for (int m = 0; m < 4; ++m) { float* p = small + (size_t)(row0 + ai * HALF + m * 16) * 32 + 8 * fq;
                        *(f32x4*)p = acc[ai][0][m][0] * rs[ai][m]; *(f32x4*)(p + 4) = acc[ai][0][m][1] * rs[ai][m]; }
            }
            return;
        }
        const int col0 = u.pn * BM + wc * 32 + 8 * fq;
#pragma unroll
        for (int ai = 0; ai < 2; ++ai)
#pragma unroll
            for (int m = 0; m < 4; ++m) { bf16_t* rowp = O + (size_t)(row0 + ai * HALF + m * 16) * ldc + col0;
#pragma unroll
                for (int bj = 0; bj < 2; ++bj) { const f32x4 v0 = acc[ai][bj][m][0] * rs[ai][m], v1 = acc[ai][bj][m][1] * rs[ai][m];
                    u32x4 w; w.x = cvt_pk_bf16(v0[0], v0[1]); w.y = cvt_pk_bf16(v0[2], v0[3]); w.z = cvt_pk_bf16(v1[0], v1[1]); w.w = cvt_pk_bf16(v1[2], v1[3]);
                    *(u32x4*)(rowp + bj * HALF) = w; } }
    }
};
struct EpiRelu2 {
    static constexpr bool PERM = true, AFTER_DRAIN = false;
    bf16_t* O; const float* rowsq; int ldc; int pad;
    __device__ __forceinline__ void operator()(const f32x4 (&acc)[2][2][4][2], const Unit& u, int wr, int wc, int fr, int fq) const {
        const int row0 = u.pm * BM + wr * 64 + fr;
        const int col0 = u.pn * BM + wc * 32 + 8 * fq;
#pragma unroll
        for (int ai = 0; ai < 2; ++ai)
#pragma unroll
            for (int m = 0; m < 4; ++m) { bf16_t* rowp = O + (size_t)(row0 + ai * HALF + m * 16) * ldc + col0;
                const float r2 = 1.0f / (rowsq[row0 + ai * HALF + m * 16] * (1.0f / 2048.0f) + 1e-6f);
#pragma unroll
                for (int bj = 0; bj < 2; ++bj) { f32x4 v0 = acc[ai][bj][m][0], v1 = acc[ai][bj][m][1];
#pragma unroll
                    for (int j = 0; j < 4; ++j) { const float a = fmaxf(v0[j], 0.f), b = fmaxf(v1[j], 0.f); v0[j] = a * a * r2; v1[j] = b * b * r2; }
                    u32x4 w; w.x = cvt_pk_bf16(v0[0], v0[1]); w.y = cvt_pk_bf16(v0[2], v0[3]); w.z = cvt_pk_bf16(v1[0], v1[1]); w.w = cvt_pk_bf16(v1[2], v1[3]);
                    __builtin_nontemporal_store(w, (u32x4*)(rowp + bj * HALF)); } }
    }
};
struct EpiRes {
    static constexpr bool PERM = true, AFTER_DRAIN = false;
    const bf16_t* base; bf16_t* xb; float* outf; float* rowsq; int ldc; int pad;
    __device__ __forceinline__ void operator()(const f32x4 (&acc)[2][2][4][2], const Unit& u, int wr, int wc, int fr, int fq) const {
        const int row0 = u.pm * BM + wr * 64 + fr, col0 = u.pn * BM + wc * 32 + 8 * fq;
#pragma unroll
        for (int ai = 0; ai < 2; ++ai) {
            u32x4 t[4][2];
#pragma unroll
            for (int m = 0; m < 4; ++m)
#pragma unroll
                for (int bj = 0; bj < 2; ++bj) t[m][bj] = *(const u32x4*)(base + (size_t)(row0 + ai * HALF + m * 16) * ldc + col0 + bj * HALF);
#pragma unroll
            for (int m = 0; m < 4; ++m) { const int row = row0 + ai * HALF + m * 16; const size_t off = (size_t)row * ldc + col0; float ss = 0.f;
#pragma unroll
                for (int bj = 0; bj < 2; ++bj) { const u32x4 b = t[m][bj]; const f32x4 a0 = acc[ai][bj][m][0], a1 = acc[ai][bj][m][1];
                    f32x4 o0, o1;
                    o0[0] = __builtin_bit_cast(float, b.x << 16) + a0[0]; o0[1] = __builtin_bit_cast(float, b.x & 0xffff0000u) + a0[1]; o0[2] = __builtin_bit_cast(float, b.y << 16) + a0[2]; o0[3] = __builtin_bit_cast(float, b.y & 0xffff0000u) + a0[3];
                    o1[0] = __builtin_bit_cast(float, b.z << 16) + a1[0]; o1[1] = __builtin_bit_cast(float, b.z & 0xffff0000u) + a1[1]; o1[2] = __builtin_bit_cast(float, b.w << 16) + a1[2]; o1[3] = __builtin_bit_cast(float, b.w & 0xffff0000u) + a1[3];
                    ss += ((o0[0] * o0[0] + o0[1] * o0[1]) + (o0[2] * o0[2] + o0[3] * o0[3])) + ((o1[0] * o1[0] + o1[1] * o1[1]) + (o1[2] * o1[2] + o1[3] * o1[3]));
                    if (outf) { *(f32x4*)(outf + off + bj * HALF) = o0; *(f32x4*)(outf + off + bj * HALF + 4) = o1; }
                    else { u32x4 w; w.x = cvt_pk_bf16(o0[0], o0[1]); w.y = cvt_pk_bf16(o0[2], o0[3]); w.z = cvt_pk_bf16(o1[0], o1[1]); w.w = cvt_pk_bf16(o1[2], o1[3]); *(u32x4*)(xb + off + bj * HALF) = w; } }
                ss += __shfl_xor(ss, 16); ss += __shfl_xor(ss, 32);
                if (fq == 0) rowsq[(size_t)row * 32 + u.pn * 4 + wc] = ss; }
            asm volatile("" ::: "memory");
        }
    }
};
template <class Epi, class Sched, bool ALIGN_EPI = false, bool SP2 = false>
__device__ __forceinline__ void gemm_phase(PG8_LAS unsigned char* lds, const Gemm g, const Sched& S, const Epi& E) {
    int tid_ = threadIdx.x; asm volatile("" : "+v"(tid_));
    const int tid = tid_, wid = __builtin_amdgcn_readfirstlane(tid >> 6), lane = tid & 63, wr = wid >> 2, wc = wid & 3, fr = lane & 15, fq = lane >> 4;
    const int K = g.K, nt = K / BK;
    unsigned voffA[2], voffB[2];
#pragma unroll
    for (int i = 0; i < 2; ++i) { int R, C; stage_rc(tid * 16 + i * 8192, R, C); const int Rb = Epi::PERM ? ((R & ~31) + perm32(R & 31)) : R;
        voffA[i] = (unsigned)(R * K + C) * 2u; voffB[i] = (unsigned)(Rb * K + C) * 2u; }
    const size_t kstep = (size_t)(BK * 2);
    const size_t hstep = (size_t)HALF * K * 2;
    const size_t tstep = 2 * hstep;
    const unsigned ldsw = (unsigned)wid * 1024u;
    const int aoff = lds_byte(wr * 64 + fr, fq * 8), boff = lds_byte(wc * 32 + fr, fq * 8);
#define PG8_SA(b, h) (((b) * 2 + (h)) * HTB)
#define PG8_SB(b, h) ((4 + (b) * 2 + (h)) * HTB)
#define PG8_STAGE(bufoff, gbase, voff) do { _Pragma("unroll") for (int _i = 0; _i < 2; ++_i) \
        __builtin_amdgcn_global_load_lds((const unsigned*)((const char*)(gbase) + (voff)[_i]), (PG8_LAS unsigned*)(lds + (bufoff) + ldsw + _i * 8192), 16, 0, 0); } while (0)
#define PG8_LDA(dst, b, h) do { _Pragma("unroll") for (int m = 0; m < 4; ++m) _Pragma("unroll") for (int k = 0; k < 2; ++k) dst[m][k] = *(const PG8_LAS bf16x8*)(lds + PG8_SA(b, h) + aoff + m * 2048 + k * 1024); } while (0)
#define PG8_LDB(dst, b, h) do { _Pragma("unroll") for (int n = 0; n < 2; ++n) _Pragma("unroll") for (int k = 0; k < 2; ++k) dst[n][k] = *(const PG8_LAS bf16x8*)(lds + PG8_SB(b, h) + boff + n * 2048 + k * 1024); } while (0)
#define PG8_MMA(ai, bj, At, Bt) do { __builtin_amdgcn_s_setprio(1); _Pragma("unroll") for (int m = 0; m < 4; ++m) _Pragma("unroll") for (int n = 0; n < 2; ++n) _Pragma("unroll") for (int k = 0; k < 2; ++k) \
        acc[ai][bj][m][n] = __builtin_amdgcn_mfma_f32_16x16x32_bf16(Bt[n][k], At[m][k], acc[ai][bj][m][n], 0, 0, 0); __builtin_amdgcn_s_setprio(0); } while (0)
#define PG8_WAIT_V(n) asm volatile("s_waitcnt vmcnt(" #n ")" ::: "memory")
#define PG8_WAIT_L(n) asm volatile("s_waitcnt lgkmcnt(" #n ")" ::: "memory")
#define PG8_BAR __builtin_amdgcn_s_barrier()
#define PG8_SCHED __builtin_amdgcn_sched_barrier(0)
    Unit cur, nxt; int ui = 0;
    if (!S.next(0, cur)) return;
    f32x4 acc[2][2][4][2];
#pragma unroll
    for (int a = 0; a < 2; ++a)
#pragma unroll
        for (int b = 0; b < 2; ++b)
#pragma unroll
            for (int m = 0; m < 4; ++m)
#pragma unroll
                for (int n = 0; n < 2; ++n) acc[a][b][m][n] = (f32x4){0.f, 0.f, 0.f, 0.f};
    bf16x8 At[4][2], B0[2][2], B1[2][2];
    const char* cA = (const char*)g.A + (size_t)cur.pm * tstep; const char* cB = (const char*)g.Bt + (size_t)cur.pn * tstep;
    S.a_ready(cur);
    if constexpr (SP2) {
        PG8_STAGE(PG8_SB(0, 0), cB, voffB); PG8_STAGE(PG8_SB(0, 1), cB + hstep, voffB); PG8_STAGE(PG8_SA(0, 0), cA, voffA); PG8_STAGE(PG8_SA(0, 1), cA + hstep, voffA);
        if (wr == 1) PG8_BAR;
        PG8_WAIT_V(2); PG8_BAR;
        PG8_STAGE(PG8_SB(1, 0), cB + kstep, voffB); PG8_STAGE(PG8_SA(1, 0), cA + kstep, voffA); PG8_STAGE(PG8_SB(1, 1), cB + hstep + kstep, voffB);
        PG8_WAIT_V(6); PG8_BAR;
    } else {
        PG8_STAGE(PG8_SB(0, 0), cB, voffB); PG8_STAGE(PG8_SA(0, 0), cA, voffA); PG8_STAGE(PG8_SB(0, 1), cB + hstep, voffB); PG8_STAGE(PG8_SA(0, 1), cA + hstep, voffA);
        if (wr == 1) PG8_BAR;
        PG8_WAIT_V(4); PG8_BAR;
        PG8_STAGE(PG8_SB(1, 0), cB + kstep, voffB); PG8_STAGE(PG8_SA(1, 0), cA + kstep, voffA); PG8_STAGE(PG8_SB(1, 1), cB + hstep + kstep, voffB);
        PG8_WAIT_V(6); PG8_BAR;
    }
    for (;;) {
        const bool has_next = S.next(ui + 1, nxt);
        const char* nA = has_next ? (const char*)g.A + (size_t)nxt.pm * tstep : cA; const char* nB = has_next ? (const char*)g.Bt + (size_t)nxt.pn * tstep : cB;
        for (int t = 0; t < nt; t += 2) {
            const bool last = (t == nt - 2);
            const char* a1 = cA + (size_t)(t + 1) * kstep;
            const char* a2 = last ? nA : cA + (size_t)(t + 2) * kstep; const char* b2 = last ? nB : cB + (size_t)(t + 2) * kstep;
            const char* a3 = a2 + kstep; const char* b3 = b2 + kstep;
            if (last && has_next) S.a_ready(nxt);
            if constexpr (SP2) {
            PG8_LDB(B0, 0, 0); PG8_LDB(B1, 0, 1); PG8_SCHED; PG8_LDA(At, 0, 0); PG8_STAGE(PG8_SA(1, 1), a1 + hstep, voffA);
            PG8_WAIT_V(8); PG8_WAIT_L(0); PG8_BAR; PG8_MMA(0, 0, At, B0); PG8_MMA(0, 1, At, B1); PG8_BAR; PG8_SCHED;
            PG8_LDA(At, 0, 1); PG8_STAGE(PG8_SB(0, 0), b2, voffB); PG8_STAGE(PG8_SB(0, 1), b2 + hstep, voffB); PG8_STAGE(PG8_SA(0, 0), a2, voffA);
            PG8_WAIT_V(8); PG8_WAIT_L(0); PG8_BAR; PG8_MMA(1, 0, At, B0); PG8_MMA(1, 1, At, B1); PG8_BAR; PG8_SCHED;
            PG8_LDB(B0, 1, 0); PG8_LDB(B1, 1, 1); PG8_SCHED; PG8_LDA(At, 1, 0); PG8_STAGE(PG8_SA(0, 1), a2 + hstep, voffA);
            PG8_WAIT_V(8); PG8_WAIT_L(0); PG8_BAR; PG8_MMA(0, 0, At, B0); PG8_MMA(0, 1, At, B1); PG8_BAR; PG8_SCHED;
            PG8_LDA(At, 1, 1); PG8_STAGE(PG8_SB(1, 0), b3, voffB); PG8_STAGE(PG8_SB(1, 1), b3 + hstep, voffB); PG8_STAGE(PG8_SA(1, 0), a3, voffA);
            PG8_WAIT_V(8); PG8_WAIT_L(0); PG8_BAR; PG8_MMA(1, 0, At, B0); PG8_MMA(1, 1, At, B1); PG8_BAR; PG8_SCHED;
            } else {
            PG8_LDB(B0, 0, 0); PG8_SCHED; PG8_LDA(At, 0, 0); PG8_STAGE(PG8_SA(1, 1), a1 + hstep, voffA);
            PG8_WAIT_L(8); PG8_BAR; PG8_WAIT_L(0); PG8_MMA(0, 0, At, B0); PG8_BAR; PG8_SCHED;
            PG8_LDB(B1, 0, 1); PG8_STAGE(PG8_SB(0, 0), b2, voffB);
            PG8_BAR; PG8_WAIT_L(0); PG8_MMA(0, 1, At, B1); PG8_BAR;
            PG8_LDA(At, 0, 1); PG8_STAGE(PG8_SA(0, 0), a2, voffA);
            PG8_BAR; PG8_WAIT_L(0); PG8_MMA(1, 0, At, B0); PG8_BAR; PG8_SCHED;
            PG8_STAGE(PG8_SB(0, 1), b2 + hstep, voffB);
            PG8_WAIT_V(6); PG8_BAR; PG8_MMA(1, 1, At, B1); PG8_BAR;
            PG8_LDB(B0, 1, 0); PG8_SCHED; PG8_LDA(At, 1, 0); PG8_STAGE(PG8_SA(0, 1), a2 + hstep, voffA);
            PG8_WAIT_L(8); PG8_BAR; PG8_WAIT_L(0); PG8_MMA(0, 0, At, B0); PG8_BAR; PG8_SCHED;
            PG8_LDB(B1, 1, 1); PG8_STAGE(PG8_SB(1, 0), b3, voffB);
            PG8_BAR; PG8_WAIT_L(0); PG8_MMA(0, 1, At, B1); PG8_BAR;
            PG8_LDA(At, 1, 1); PG8_STAGE(PG8_SA(1, 0), a3, voffA);
            PG8_BAR; PG8_WAIT_L(0); PG8_MMA(1, 0, At, B0); PG8_BAR; PG8_SCHED;
            PG8_STAGE(PG8_SB(1, 1), b3 + hstep, voffB);
            PG8_WAIT_V(6); PG8_BAR; PG8_MMA(1, 1, At, B1); PG8_BAR;
            }
        }
        if constexpr (ALIGN_EPI) { if (wr == 0) PG8_BAR; }
        if constexpr (!Epi::AFTER_DRAIN) { E(acc, cur, wr, wc, fr, fq); S.done(cur); }
        if (!has_next) break;
#pragma unroll
        for (int a = 0; a < 2; ++a)
#pragma unroll
            for (int b = 0; b < 2; ++b)
#pragma unroll
                for (int m = 0; m < 4; ++m)
#pragma unroll
                    for (int n = 0; n < 2; ++n) acc[a][b][m][n] = (f32x4){0.f, 0.f, 0.f, 0.f};
        cur = nxt; cA = nA; cB = nB; ++ui;
        if constexpr (ALIGN_EPI) { if (wr == 1) PG8_BAR; }
    }
    PG8_WAIT_V(0);
    if constexpr (!ALIGN_EPI) { if (wr == 0) PG8_BAR; }
    PG8_BAR;
    if constexpr (Epi::AFTER_DRAIN) { E.fused(acc, cur, wr, wc, fr, fq, lds, wid, lane); S.done(cur); }
#undef PG8_SA
#undef PG8_SB
#undef PG8_STAGE
#undef PG8_LDA
#undef PG8_LDB
#undef PG8_MMA
#undef PG8_WAIT_V
#undef PG8_WAIT_L
#undef PG8_BAR
#undef PG8_SCHED
}
}

typedef unsigned short bf16;
typedef float f32x4 __attribute__((ext_vector_type(4)));
typedef float f32x2 __attribute__((ext_vector_type(2)));
typedef unsigned u32x4 __attribute__((ext_vector_type(4)));
typedef unsigned u32x2 __attribute__((ext_vector_type(2)));
constexpr int D_MODEL = 2048, BATCH = 8, SEQ = 4096, DEPTH = 4, HD = 128, D_FF = 8192;
constexpr int M = BATCH * SEQ;
constexpr int NPROJ_ORIG = 6430, NPROJ = 6656;
constexpr int PC_QA = 0, PC_KA = 768, PC_VA = 1536, PC_ZA = 2304, PC_UB = 3072, PC_VB = 3584, PC_QC = 4096, PC_KCC = 4864, PC_VCC = 5120,
              PC_KSL = 5376, PC_VSL = 5632, PC_KWN = 5888, PC_VWN = 6144, PC_SMALL = 6400;
constexpr int SM_BA = 0, SM_AA = 6, SM_GC = 12;
constexpr int N_CMP = 255;
constexpr float NORM_EPS = 1e-6f;
__host__ __device__ __forceinline__ int win_map(int n) {
    if (n < 3072) return n;
    if (n < 4096) return 3084 + (n - 3072);
    if (n < 6400) return 4108 + (n - 4096);
    if (n < 6412) return 3072 + (n - 6400);
    if (n < 6430) return n;
    return -1;
}
constexpr size_t MiB = 1u << 20;
constexpr size_t WS_CTL = 0;
constexpr size_t WS_WIN = 1 * MiB, WS_WOUT = 27 * MiB, WS_WUP = 35 * MiB, WS_WDN = 67 * MiB;
constexpr size_t WS_HB = 100 * MiB;
constexpr size_t WS_R1 = 228 * MiB;
constexpr size_t WS_PROJ = WS_R1, WS_SMALL = 644 * MiB, WS_NQ = 648 * MiB, WS_NKS = 696 * MiB, WS_NKW = 712 * MiB;
constexpr size_t WS_KCB = 728 * MiB, WS_VCT = 729 * MiB, WS_SELM = 730 * MiB, WS_EGL = 731 * MiB, WS_W1T = 732 * MiB, WS_W2T = 734 * MiB, WS_C1 = 735 * MiB, WS_WSG = 735 * MiB + 65536, WS_RSQ1 = 956 * MiB, WS_RSQ2 = 956 * MiB + 131072;
constexpr size_t WS_RSP = 1020 * MiB;
constexpr size_t WS_XG2 = 740 * MiB;
constexpr size_t WS_HID = WS_R1;
constexpr size_t WS_UF = 740 * MiB, WS_WP = 788 * MiB, WS_QGP = 836 * MiB, WS_KDT = 884 * MiB, WS_AP = 932 * MiB;
constexpr size_t WS_VLN = 956 * MiB, WS_VST = 988 * MiB, WS_VWT = 1004 * MiB, WS_KC = 1020 * MiB, WS_VC = 1022 * MiB, WS_END = 1024 * MiB;
constexpr size_t CTL_QUEUE = 32768;

__device__ __forceinline__ float bf2f(bf16 v) { return __uint_as_float(((unsigned)v) << 16); }
typedef __bf16 bf16x2_hw __attribute__((ext_vector_type(2)));
__device__ __forceinline__ unsigned pk2(float lo, float hi) { f32x2 v = {lo, hi}; return __builtin_bit_cast(unsigned, __builtin_convertvector(v, bf16x2_hw)); }
__device__ __forceinline__ bf16 f2bf(float f) { return (bf16)(pk2(f, 0.f) & 0xffffu); }
__device__ __forceinline__ float row16_sum(float x) {
    x += __builtin_bit_cast(float, __builtin_amdgcn_update_dpp(0, __builtin_bit_cast(int, x), 0x128, 0xf, 0xf, false));
    x += __builtin_bit_cast(float, __builtin_amdgcn_update_dpp(0, __builtin_bit_cast(int, x), 0x124, 0xf, 0xf, false));
    x += __builtin_bit_cast(float, __builtin_amdgcn_update_dpp(0, __builtin_bit_cast(int, x), 0x122, 0xf, 0xf, false));
    x += __builtin_bit_cast(float, __builtin_amdgcn_update_dpp(0, __builtin_bit_cast(int, x), 0x121, 0xf, 0xf, false));
    return x;
}
__device__ __forceinline__ float wave_sum(float v) {
    v = row16_sum(v);
    const float s0 = __builtin_bit_cast(float, __builtin_amdgcn_readlane(__builtin_bit_cast(int, v), 0)), s1 = __builtin_bit_cast(float, __builtin_amdgcn_readlane(__builtin_bit_cast(int, v), 16));
    const float s2 = __builtin_bit_cast(float, __builtin_amdgcn_readlane(__builtin_bit_cast(int, v), 32)), s3 = __builtin_bit_cast(float, __builtin_amdgcn_readlane(__builtin_bit_cast(int, v), 48));
    return (s0 + s1) + (s2 + s3);
}
__device__ __forceinline__ float wave_max(float v) {
#pragma unroll
    for (int o = 1; o < 64; o <<= 1) v = fmaxf(v, __shfl_xor(v, o));
    return v;
}
__device__ __forceinline__ float sigmoidf_(float x) { return 1.0f / (1.0f + __expf(-x)); }
__device__ __forceinline__ float siluf_(float x) { return x * sigmoidf_(x); }
__device__ __forceinline__ float gelu_tanh(float x) { const float u = 1.5957691216057308f * (x + 0.044715f * x * x * x); return x * __builtin_amdgcn_rcpf(1.0f + __expf(-u)); }
__device__ __forceinline__ float softplusf_(float x) { const float e = __expf(-fabsf(x)); const float lp = e < 0.01f ? e * (1.f - e * (0.5f - e * 0.33333334f)) : __logf(1.f + e); return fmaxf(x, 0.f) + lp; }
__device__ __forceinline__ int t5_bucket(int dist) {
    const int n = dist > 0 ? dist : 0;
    if (n < 16) return n;
    const float lr = logf((float)n / 16.0f) / 2.0794415416798357f;
    const int large = 16 + (int)(lr * 16.0f);
    return large < 31 ? large : 31;
}

#define XB_TMO      128
#define XB_XCNT(j)  (256  + 64 * (j))
#define XB_XSUB(j)  (1280 + 64 * (j))
#define XB_XGEN(j)  (2304 + 64 * (j))
#define XB_TOP      3328
#define XB_TOPGEN   3392
#define XCD_BAR_WORDS 3456
#define XB_SPIN_CAP (1u << 18)
#define LAS __attribute__((address_space(3)))

__device__ __forceinline__ unsigned xb_ld(unsigned* p)              { return __hip_atomic_load(p, __ATOMIC_RELAXED, __HIP_MEMORY_SCOPE_AGENT); }
__device__ __forceinline__ unsigned xb_add(unsigned* p, unsigned v) { return __hip_atomic_fetch_add(p, v, __ATOMIC_RELAXED, __HIP_MEMORY_SCOPE_AGENT); }
__device__ __forceinline__ unsigned xb_xcc_id() { return (unsigned)__builtin_amdgcn_s_getreg((3 << 11) | 20) & 0xFu; }
#define XB_SPIN(cond, bar) do { unsigned _sp = 0; while (cond) { __builtin_amdgcn_s_sleep(1); \
    if ((++_sp & 255u) == 0u) { if (xb_ld(&(bar)[XB_TMO])) break; if (_sp > XB_SPIN_CAP) { atomicAdd(&(bar)[XB_TMO], 1u); break; } } } } while (0)

struct XcdBarrier {
    unsigned* bar; unsigned x;
    volatile LAS unsigned* st;
};

__device__ __forceinline__ XcdBarrier xcd_barrier_post(unsigned* bar, volatile LAS unsigned* st) {
    XcdBarrier b; b.bar = bar; b.x = xb_xcc_id(); b.st = st;
    if (threadIdx.x == 0) (void)xb_add(&bar[XB_XCNT(b.x)], 1u);
    return b;
}
__device__ __forceinline__ void xcd_barrier_complete(unsigned* bar, unsigned x, unsigned& nloc, unsigned& nx) {
    const unsigned G = gridDim.x * gridDim.y * gridDim.z;
    unsigned sum, cnt, mine, sp = 0u;
    for (;;) {
        sum = 0u; cnt = 0u; mine = 0u;
#pragma unroll
        for (unsigned j = 0; j < 16; ++j) { const unsigned c = xb_ld(&bar[XB_XCNT(j)]); sum += c; cnt += (c > 0u) ? 1u : 0u; mine = (j == x) ? c : mine; }
        if (sum == G) break;
        __builtin_amdgcn_s_sleep(1);
        if ((++sp & 255u) == 0u) { if (xb_ld(&bar[XB_TMO])) break; if (sp > XB_SPIN_CAP) { atomicAdd(&bar[XB_TMO], 1u); break; } }
    }
    nloc = mine > 0u ? mine : 1u; nx = cnt > 0u ? cnt : 1u;
}

__device__ __forceinline__ void xcd_barrier(const XcdBarrier& b) {
    asm volatile("s_waitcnt vmcnt(0)" ::: "memory");
    __syncthreads();
    if (threadIdx.x == 0) {
        unsigned* bar = b.bar;
        __builtin_amdgcn_s_waitcnt(0);
        unsigned nloc = b.st[0], nx = b.st[1];
        if (nloc == 0u) { xcd_barrier_complete(bar, b.x, nloc, nx); b.st[0] = nloc; b.st[1] = nx; }
        const unsigned old = xb_add(&bar[XB_XSUB(b.x)], 1u);
        const unsigned gen = old / nloc;
        if (old + 1u == (gen + 1u) * nloc) {
            __builtin_amdgcn_fence(__ATOMIC_RELEASE, "agent");
            asm volatile("s_waitcnt vmcnt(0)" ::: "memory");
            const unsigned og = xb_add(&bar[XB_TOP], 1u);
            const unsigned tg = og / nx;
            if (og + 1u == (tg + 1u) * nx) xb_add(&bar[XB_TOPGEN], 1u);
            else XB_SPIN(xb_ld(&bar[XB_TOPGEN]) == tg, bar);
            __builtin_amdgcn_fence(__ATOMIC_ACQUIRE, "agent");
            xb_add(&bar[XB_XGEN(b.x)], 1u);
            asm volatile("s_waitcnt vmcnt(0)" ::: "memory");
        } else {
            XB_SPIN(xb_ld(&bar[XB_XGEN(b.x)]) == gen, bar);
            __builtin_amdgcn_fence(__ATOMIC_ACQUIRE, "agent");
            asm volatile("s_waitcnt vmcnt(0)" ::: "memory");
        }
    }
    __syncthreads();
}

#define LAS __attribute__((address_space(3)))
constexpr int NWAVES = 8, NTHREADS = 512;
constexpr int LDS_BYTES = 147456;
constexpr int LDS_MISC = LDS_BYTES - 256;
struct Params { const float* in[21]; float* out; unsigned char* ws; };
constexpr int LDS_PTAB = LDS_MISC + 16;
__device__ __forceinline__ int ltid() { int t = threadIdx.x; asm volatile("" : "+v"(t)); return t; }
__device__ __forceinline__ unsigned long long lds_ptr_raw(int i) {
    extern __shared__ __attribute__((aligned(16))) unsigned char lds_dyn[];
    const volatile LAS unsigned long long* tab = (const volatile LAS unsigned long long*)(lds_dyn + LDS_PTAB);
    int ii = i; asm volatile("" : "+v"(ii));
    const unsigned long long v = tab[ii];
    const unsigned lo = __builtin_amdgcn_readfirstlane((unsigned)v), hi = __builtin_amdgcn_readfirstlane((unsigned)(v >> 32));
    return ((unsigned long long)hi << 32) | lo;
}
#define GAS __attribute__((address_space(1)))
__device__ __forceinline__ unsigned char* gptr(int i) { return (unsigned char*)(GAS unsigned char*)lds_ptr_raw(i); }
__device__ __forceinline__ const float* in_ptr(int i) { return (const float*)gptr(i); }
enum { I_X = 0, I_ATTN_NORM, I_W_IN, I_CONV_A, I_A_LOG, I_DT_BIAS, I_GDN_NORM, I_SGU_LN_G, I_SGU_LN_B, I_SGU_W, I_SGU_B, I_NSA_QN, I_NSA_KN, I_CMP_POS, I_CMP_W1, I_CMP_W2, I_REL_BIAS, I_W_OUT, I_MLP_NORM, I_W_UP, I_W_DOWN };

template <int MAP> __device__ __forceinline__ void ph_transpose(const float* __restrict__ W, int K, int N_orig, bf16* __restrict__ WT, int N_out, const float* __restrict__ kscale = nullptr, int it_first = -1, int it_count = 0) {
    extern __shared__ __attribute__((aligned(16))) unsigned char lds_dyn[];
    const int tid = ltid(); const int lane = tid & 63, wave = tid >> 6;
    float* scr = (float*)lds_dyn + wave * (64 * 65);
    const int nblk = N_out / 64, nitems = (K / 64) * nblk;
    const int ksub = lane >> 4, n4 = (lane & 15) * 4;
    const int it_lo = it_first >= 0 ? it_first + wave : (int)blockIdx.x * NWAVES + wave, it_hi = it_first >= 0 ? (it_first + it_count < nitems ? it_first + it_count : nitems) : nitems, it_st = it_first >= 0 ? NWAVES : (int)gridDim.x * NWAVES;
    for (int it = it_lo; it < it_hi; it += it_st) {
        const int kb = it / nblk, nb = it % nblk, k0 = 64 * kb, n0 = 64 * nb;
        const int ng = n0 + n4; const int no = MAP ? win_map(ng) : ng;
        const bool vec = MAP ? (no >= 0 && win_map(ng + 3) == no + 3) : true;
        f32x4 v[16];
        if (vec) {
#pragma unroll
            for (int i = 0; i < 16; ++i) { const float* p = W + (size_t)(k0 + 4 * i + ksub) * N_orig + no; if (MAP) { const f32x2 a0 = *(const f32x2*)p, a1 = *(const f32x2*)(p + 2); v[i] = (f32x4){a0.x, a0.y, a1.x, a1.y}; }
                else v[i] = *(const f32x4*)p; }
        } else {
#pragma unroll
            for (int i = 0; i < 16; ++i) { const float* p = W + (size_t)(k0 + 4 * i + ksub) * N_orig;
#pragma unroll
                for (int e = 0; e < 4; ++e) { const int ne = MAP ? win_map(ng + e) : ng + e; v[i][e] = ne >= 0 ? p[ne] : 0.f; } }
        }
        if (kscale) {
#pragma unroll
            for (int i = 0; i < 16; ++i) v[i] *= kscale[k0 + 4 * i + ksub]; }
#pragma unroll
        for (int i = 0; i < 16; ++i) { float* d = scr + (4 * i + ksub) * 65 + n4; d[0] = v[i].x; d[1] = v[i].y; d[2] = v[i].z; d[3] = v[i].w; }
        __builtin_amdgcn_s_waitcnt(0); asm volatile("" ::: "memory");
        const int c = lane & 7;
#pragma unroll
        for (int j = 0; j < 8; ++j) { const int nn = (lane >> 3) + 8 * j; const float* sp = scr + (8 * c) * 65 + nn;
            u32x4 o; o.x = pk2(sp[0 * 65], sp[1 * 65]); o.y = pk2(sp[2 * 65], sp[3 * 65]); o.z = pk2(sp[4 * 65], sp[5 * 65]); o.w = pk2(sp[6 * 65], sp[7 * 65]);
            *(u32x4*)(WT + (size_t)(n0 + nn) * K + k0 + 8 * c) = o; }
        __builtin_amdgcn_s_waitcnt(0); asm volatile("" ::: "memory");
    }
}

__device__ __forceinline__ void ph_rmsnorm(const float* __restrict__ x, const float* __restrict__ gain, bf16* __restrict__ out) {
    const int tid = ltid(); const int lane = tid & 63; const int gw = blockIdx.x * NWAVES + (tid >> 6), ngw = gridDim.x * NWAVES;
    for (int m = gw; m < M; m += ngw) {
        const f32x4* xr = (const f32x4*)(x + (size_t)m * D_MODEL) + lane; f32x4 v[8]; float s = 0.f;
#pragma unroll
        for (int j = 0; j < 8; ++j) { v[j] = xr[64 * j]; s += (v[j].x * v[j].x + v[j].y * v[j].y) + (v[j].z * v[j].z + v[j].w * v[j].w); }
        const float rstd = rsqrtf(wave_sum(s) * (1.f / D_MODEL) + NORM_EPS);
        u32x2* o = (u32x2*)(out + (size_t)m * D_MODEL) + lane;
#pragma unroll
        for (int j = 0; j < 8; ++j) { const f32x4 g = ((const f32x4*)gain)[64 * j + lane]; u32x2 w; w.x = pk2(v[j].x * rstd * g.x, v[j].y * rstd * g.y); w.y = pk2(v[j].z * rstd * g.z, v[j].w * rstd * g.w); o[64 * j] = w; }
    }
}

__device__ __forceinline__ void ph_xg0(const float* __restrict__ x, const float* __restrict__ gain, bf16* __restrict__ xg, float* __restrict__ rowsq) {
    const int tid = ltid(); const int lane = tid & 63; const int gw = blockIdx.x * NWAVES + (tid >> 6), ngw = gridDim.x * NWAVES;
    for (int m = gw; m < M; m += ngw) {
        const f32x4* xr = (const f32x4*)(x + (size_t)m * D_MODEL) + lane; f32x4 v[8]; float s = 0.f;
#pragma unroll
        for (int j = 0; j < 8; ++j) { v[j] = xr[64 * j]; s += (v[j].x * v[j].x + v[j].y * v[j].y) + (v[j].z * v[j].z + v[j].w * v[j].w); }
        s = wave_sum(s); if (lane == 0) rowsq[m] = s;
        u32x2* o = (u32x2*)(xg + (size_t)m * D_MODEL) + lane;
#pragma unroll
        for (int j = 0; j < 8; ++j) { u32x2 w; w.x = pk2(v[j].x, v[j].y); w.y = pk2(v[j].z, v[j].w); o[64 * j] = w; }
    }
}
__device__ __forceinline__ void ph_rowsq_reduce(const float* __restrict__ part, float* __restrict__ rowsq) {
    const int tid = ltid();
    for (int r = blockIdx.x * NTHREADS + tid; r < M; r += gridDim.x * NTHREADS) { const f32x4* p = (const f32x4*)(part + (size_t)r * 32); float s = 0.f;
#pragma unroll
        for (int j = 0; j < 8; ++j) { const f32x4 v = p[j]; s += (v.x + v.y) + (v.z + v.w); }
        rowsq[r] = s; }
}
__device__ __forceinline__ void ph_zero_f32(float* __restrict__ p, int n) { const int tid = ltid(); for (int i = blockIdx.x * NTHREADS + tid; i < n; i += gridDim.x * NTHREADS) p[i] = 0.f; }
__device__ __forceinline__ void ph_gdn_prep(const bf16* __restrict__ proj, const float* __restrict__ small, const float* __restrict__ conv_w, const float* __restrict__ a_log,
                                            const float* __restrict__ dt_bias, bf16* __restrict__ GQ, float* __restrict__ BG) {
    const int tid = ltid(); const int lane = tid & 63; const int gw = blockIdx.x * NWAVES + (tid >> 6), ngw = gridDim.x * NWAVES;
    for (int p = gw; p < M * 18; p += ngw) {
        const int m = p / 18, j = p % 18, t = m & (SEQ - 1), c = j * 128 + lane * 2;
        float y0 = 0.f, y1 = 0.f;
#pragma unroll
        for (int tap = 0; tap < 4; ++tap) { const int tt = t - 3 + tap; if (tt >= 0) { const unsigned pr = *(const unsigned*)(proj + (size_t)(m - 3 + tap) * NPROJ + c);
            y0 += conv_w[tap * 2304 + c] * bf2f((bf16)(pr & 0xffff)); y1 += conv_w[tap * 2304 + c + 1] * bf2f((bf16)(pr >> 16)); } }
        y0 = siluf_(y0); y1 = siluf_(y1);
        if (j < 12) { const float ss = wave_sum(y0 * y0 + y1 * y1); float r = rsqrtf(ss + NORM_EPS); if (j < 6) r *= 0.08838834764831845f; y0 *= r; y1 *= r; }
        *(unsigned*)(GQ + (size_t)m * 2304 + c) = pk2(y0, y1);
    }
    for (int i = blockIdx.x * NTHREADS + tid; i < M * 6; i += gridDim.x * NTHREADS) { const int m = i / 6, h = i % 6;
        BG[(size_t)m * 12 + h] = sigmoidf_(small[(size_t)m * 32 + SM_BA + h]);
        BG[(size_t)m * 12 + 6 + h] = -__expf(a_log[h]) * softplusf_(small[(size_t)m * 32 + SM_AA + h] + dt_bias[h]); }
}
__device__ __forceinline__ void ph_gdn_scan(const bf16* __restrict__ GQ, const float* __restrict__ BG, const bf16* __restrict__ proj, const float* __restrict__ norm_g, bf16* __restrict__ mix, int nblk_scan) {
    extern __shared__ __attribute__((aligned(16))) unsigned char lds_dyn[];
    float (*sq)[144] = (float (*)[144])lds_dyn; float (*sk)[144] = (float (*)[144])(lds_dyn + 8 * 144 * 4);
    float (*sv)[128] = (float (*)[128])(lds_dyn + 16 * 144 * 4); float (*osh)[128] = (float (*)[128])(lds_dyn + 16 * 144 * 4 + 8 * 128 * 4);
    float (*sc)[2] = (float (*)[2])(lds_dyn + 16 * 144 * 4 + 16 * 128 * 4);
    const int tid = ltid(); const int c = tid >> 2, p = tid & 3, lane = tid & 63, wave = tid >> 6;
    for (int bh = blockIdx.x; bh < BATCH * 6; bh += nblk_scan) {
        const int b = bh / 6, h = bh % 6;
        float S[32];
#pragma unroll
        for (int j = 0; j < 32; ++j) S[j] = 0.f;
        for (int t0 = 0; t0 < SEQ; t0 += 8) {
            for (int i = tid; i < 8 * 384; i += NTHREADS) { const int tt = i / 384, r = i % 384, which = r >> 7, d = r & 127;
                const float v = bf2f(GQ[(size_t)(b * SEQ + t0 + tt) * 2304 + which * 768 + h * 128 + d]);
                if (which == 0) sq[tt][(d >> 5) * 36 + (d & 31)] = v; else if (which == 1) sk[tt][(d >> 5) * 36 + (d & 31)] = v; else sv[tt][d] = v; }
            if (tid < 8) { const size_t m = (size_t)b * SEQ + t0 + tid; sc[tid][0] = BG[m * 12 + h]; sc[tid][1] = __expf(BG[m * 12 + 6 + h]); }
            __syncthreads();
#pragma unroll 1
            for (int tt = 0; tt < 8; ++tt) {
                const float beta = sc[tt][0], eg = sc[tt][1];
                float kS = 0.f;
#pragma unroll
                for (int j = 0; j < 32; ++j) kS += sk[tt][p * 36 + j] * S[j];
                kS += __shfl_xor(kS, 1); kS += __shfl_xor(kS, 2);
                const float coef = beta * (sv[tt][c] - eg * kS);
                float o = 0.f;
#pragma unroll
                for (int j = 0; j < 32; ++j) { S[j] = eg * S[j] + sk[tt][p * 36 + j] * coef; o += sq[tt][p * 36 + j] * S[j]; }
                o += __shfl_xor(o, 1); o += __shfl_xor(o, 2);
                if (p == 0) osh[tt][c] = o;
            }
            __syncthreads();
            { const int tt = wave; const size_t m = (size_t)b * SEQ + t0 + tt; const int c0 = lane * 2;
              const float o0 = osh[tt][c0], o1 = osh[tt][c0 + 1]; const float rstd = rsqrtf(wave_sum(o0 * o0 + o1 * o1) * (1.f / 128.f) + NORM_EPS);
              const unsigned zz = *(const unsigned*)(proj + m * NPROJ + PC_ZA + h * 128 + c0);
              const float r0 = o0 * rstd * norm_g[c0] * siluf_(bf2f((bf16)(zz & 0xffff))), r1 = o1 * rstd * norm_g[c0 + 1] * siluf_(bf2f((bf16)(zz >> 16)));
              *(unsigned*)(mix + m * D_MODEL + h * 128 + c0) = pk2(r0, r1); }
            __syncthreads();
        }
    }
}

__device__ __forceinline__ void ph_sgu_prep(const bf16* __restrict__ proj, const float* __restrict__ ln_g, const float* __restrict__ ln_b, bf16* __restrict__ VLN) {
    const int tid = ltid(); const int lane = tid & 63; const int gw = blockIdx.x * NWAVES + (tid >> 6), ngw = gridDim.x * NWAVES;
    float lg[8], lb[8];
#pragma unroll
    for (int j = 0; j < 8; ++j) { lg[j] = ln_g[lane * 8 + j]; lb[j] = ln_b[lane * 8 + j]; }
    for (int m0 = gw; m0 < M; m0 += 4 * ngw) {
        u32x4 raw4[4];
#pragma unroll
        for (int k = 0; k < 4; ++k) { const int m = m0 + k * ngw < M ? m0 + k * ngw : m0; raw4[k] = *(const u32x4*)(proj + (size_t)m * NPROJ + PC_VB + lane * 8); }
#pragma unroll
        for (int k = 0; k < 4; ++k) { const int m = m0 + k * ngw;
            if (m < M) {
                float v[8]; const unsigned rw[4] = {raw4[k].x, raw4[k].y, raw4[k].z, raw4[k].w};
                float s = 0.f;
#pragma unroll
                for (int j = 0; j < 4; ++j) { v[2 * j] = gelu_tanh(bf2f((bf16)(rw[j] & 0xffff))); v[2 * j + 1] = gelu_tanh(bf2f((bf16)(rw[j] >> 16))); s += v[2 * j] + v[2 * j + 1]; }
                const float mu = wave_sum(s) * (1.f / 512.f); float q = 0.f;
#pragma unroll
                for (int j = 0; j < 8; ++j) { v[j] -= mu; q += v[j] * v[j]; }
                const float rstd = rsqrtf(wave_sum(q) * (1.f / 512.f) + NORM_EPS);
                u32x4 o; unsigned ow[4];
#pragma unroll
                for (int j = 0; j < 4; ++j) ow[j] = pk2(v[2 * j] * rstd * lg[2 * j] + lb[2 * j], v[2 * j + 1] * rstd * lg[2 * j + 1] + lb[2 * j + 1]);
                o.x = ow[0]; o.y = ow[1]; o.z = ow[2]; o.w = ow[3];
                *(u32x4*)(VLN + (size_t)m * 512 + lane * 8) = o;
            } }
    }
}
__device__ __forceinline__ void ph_sgu_mix(const bf16* __restrict__ proj, const bf16* __restrict__ VLN, const float* __restrict__ sgu_w, const float* __restrict__ sgu_b, bf16* __restrict__ mix, int first, int count) {
    extern __shared__ __attribute__((aligned(16))) unsigned char lds_dyn[];
    bf16 (*vs)[128] = (bf16 (*)[128])lds_dyn;
    const int tid = ltid();
    if ((int)blockIdx.x < first) return;
    for (int item = blockIdx.x - first; item < BATCH * 32 * 4; item += count) {
        const int g = item & 3, n = (item >> 2) & 31, b = item >> 7;
        const size_t m0 = (size_t)b * SEQ + n * 128;
        __syncthreads();
        for (int i = tid; i < 128 * 128; i += NTHREADS) { const int s = i >> 7, c = i & 127; vs[s][c] = VLN[(m0 + s) * 512 + g * 128 + c]; }
        __syncthreads();
        const int c = tid & 127, tq = tid >> 7;
        for (int t = tq * 32; t < tq * 32 + 32; ++t) {
            const float* wr = sgu_w + ((size_t)g * 128 + t) * 128; float acc = 0.f;
            for (int s = 0; s <= t; ++s) acc += wr[s] * bf2f(vs[s][c]);
            const float u = gelu_tanh(bf2f(proj[(m0 + t) * NPROJ + PC_UB + g * 128 + c]));
            mix[(m0 + t) * D_MODEL + 768 + g * 128 + c] = f2bf(u * (acc + sgu_b[g * 128 + t]));
        }
    }
    __syncthreads();
}

__device__ __forceinline__ void ph_nsa_prep(const bf16* __restrict__ proj, const float* __restrict__ qg, const float* __restrict__ kg, bf16* __restrict__ NQ, bf16* __restrict__ NKS, bf16* __restrict__ NKW) {
    const int tid = ltid(); const int lane = tid & 63; const int gw = blockIdx.x * NWAVES + (tid >> 6), ngw = gridDim.x * NWAVES;
    for (int p = gw; p < M * 10; p += ngw) {
        const int m = p / 10, j = p % 10, c0 = lane * 2;
        const int src = j < 6 ? PC_QC + j * 128 : (j < 8 ? PC_KSL + (j - 6) * 128 : PC_KWN + (j - 8) * 128);
        const unsigned pr = *(const unsigned*)(proj + (size_t)m * NPROJ + src + c0);
        float y0 = bf2f((bf16)(pr & 0xffff)), y1 = bf2f((bf16)(pr >> 16));
        float r = rsqrtf(wave_sum(y0 * y0 + y1 * y1) * (1.f / 128.f) + NORM_EPS);
        const float* gn = j < 6 ? qg : kg; if (j < 6) r *= 0.08838834764831845f;
        const unsigned o = pk2(y0 * r * gn[c0], y1 * r * gn[c0 + 1]);
        if (j < 6) *(unsigned*)(NQ + (size_t)m * 768 + j * 128 + c0) = o;
        else if (j < 8) *(unsigned*)(NKS + (size_t)m * 256 + (j - 6) * 128 + c0) = o;
        else *(unsigned*)(NKW + (size_t)m * 256 + (j - 8) * 128 + c0) = o;
    }
}
__device__ __forceinline__ void ph_nsa_compress(const bf16* __restrict__ proj, const float* __restrict__ pos, const float* __restrict__ w1, const float* __restrict__ w2, const float* __restrict__ kg,
                                                bf16* __restrict__ KCB, bf16* __restrict__ VCT) {
    extern __shared__ __attribute__((aligned(16))) unsigned char lds_dyn[];
    bf16 (*tok)[128] = (bf16 (*)[128])lds_dyn;
    float (*posl)[128] = (float (*)[128])(lds_dyn + 144 * 128 * 2);
    float (*hid)[128] = (float (*)[128])(lds_dyn + 144 * 128 * 2 + 32 * 128 * 4);
    float (*red)[2] = (float (*)[2])(lds_dyn + 144 * 128 * 2 + 32 * 128 * 4 + 8 * 128 * 4);
    const int tid = ltid(); const int j = tid & 127, q4 = tid >> 7;
    for (int item = blockIdx.x; item < 1024; item += gridDim.x) {
        const int kv = item & 1, grp = (item >> 1) & 31, g = (item >> 6) & 1, b = item >> 7, n0 = grp * 8;
        const int col = (kv == 0 ? PC_KCC : PC_VCC) + g * 128;
        __syncthreads();
        for (int i = tid; i < 144 * 128; i += NTHREADS) { const int tk = i >> 7, d = i & 127; const int t = 16 * n0 + tk; tok[tk][d] = t < SEQ ? proj[(size_t)(b * SEQ + t) * NPROJ + col + d] : (bf16)0; }
        for (int i = tid; i < 32 * 128; i += NTHREADS) posl[i >> 7][i & 127] = pos[(size_t)kv * 4096 + i];
        __syncthreads();
        float acc0 = 0.f, acc1 = 0.f;
        const float* w1p = w1 + (size_t)kv * 4096 * 128 + j;
        for (int l = 0; l < 32; ++l)
#pragma unroll 4
            for (int d = 0; d < 128; ++d) { const float w = w1p[(size_t)(l * 128 + d) * 128]; const float pp = posl[l][d];
                acc0 += (bf2f(tok[16 * (2 * q4) + l][d]) + pp) * w; acc1 += (bf2f(tok[16 * (2 * q4 + 1) + l][d]) + pp) * w; }
        hid[2 * q4][j] = gelu_tanh(acc0); hid[2 * q4 + 1][j] = gelu_tanh(acc1);
        __syncthreads();
        float out0 = 0.f, out1 = 0.f;
        const float* w2p = w2 + (size_t)kv * 128 * 128 + j;
        for (int i = 0; i < 128; ++i) { const float w = w2p[(size_t)i * 128]; out0 += hid[2 * q4][i] * w; out1 += hid[2 * q4 + 1][i] * w; }
        if (kv == 0) {
            const float s0 = wave_sum(out0 * out0), s1 = wave_sum(out1 * out1);
            if ((tid & 63) == 0) { red[2 * q4][(tid >> 6) & 1] = s0; red[2 * q4 + 1][(tid >> 6) & 1] = s1; }
            __syncthreads();
            out0 *= rsqrtf((red[2 * q4][0] + red[2 * q4][1]) * (1.f / 128.f) + NORM_EPS) * kg[j];
            out1 *= rsqrtf((red[2 * q4 + 1][0] + red[2 * q4 + 1][1]) * (1.f / 128.f) + NORM_EPS) * kg[j];
        }
#pragma unroll
        for (int e = 0; e < 2; ++e) { const int n = n0 + 2 * q4 + e; const float o = n < N_CMP ? (e ? out1 : out0) : 0.f;
            if (kv == 0) KCB[((size_t)(b * 2 + g) * 256 + n) * 128 + j] = f2bf(o);
            else VCT[((size_t)(b * 2 + g) * 128 + j) * 256 + (n & ~15) + ((n & 3) | ((n & 4) << 1) | ((n & 8) >> 1))] = f2bf(o); }
    }
    __syncthreads();
}
__device__ __forceinline__ void ph_nsa_attn(const bf16* __restrict__ NQ, const bf16* __restrict__ NKS, const bf16* __restrict__ NKW, const bf16* __restrict__ proj,
                                            const float* __restrict__ KC, const float* __restrict__ VC, const float* __restrict__ small, const float* __restrict__ rel_bias, bf16* __restrict__ mix, int first, int count) {
    extern __shared__ __attribute__((aligned(16))) unsigned char lds_dyn[];
    const int tid = ltid(); const int lane = tid & 63, wave = tid >> 6;
    if ((int)blockIdx.x < first) return;
    float (*bias_s)[6] = (float (*)[6])(lds_dyn + 8 * 16896);
    __syncthreads();
    for (int i = tid; i < 192; i += NTHREADS) bias_s[i / 6][i % 6] = rel_bias[i];
    __syncthreads();
    float (*qs)[128] = (float (*)[128])(lds_dyn + wave * 16896); float (*pc)[256] = (float (*)[256])(lds_dyn + wave * 16896 + 1536); float (*sc)[1024] = (float (*)[1024])(lds_dyn + wave * 16896 + 4608);
    for (int idx = (blockIdx.x - first) * NWAVES + wave; idx < M * 2; idx += count * NWAVES) {
    const int t = idx & (SEQ - 1), g = (idx >> 12) & 1, b = idx >> 13;
    const size_t m = (size_t)b * SEQ + t;
    for (int i = lane; i < 384; i += 64) qs[i >> 7][i & 127] = bf2f(NQ[m * 768 + g * 384 + i]);
    __builtin_amdgcn_s_waitcnt(0); asm volatile("" ::: "memory");
    const int hb = g * 3;
    float oc[3][2], os[3][2], ow[3][2];
    const int nvalid = t >= 31 ? ((t - 31) >> 4) + 1 : 0;
    {
        float mx[3] = {-3.0e38f, -3.0e38f, -3.0e38f};
        for (int base = 0; base < 256; base += 64) { const int n = base + lane; float s[3] = {-3.0e38f, -3.0e38f, -3.0e38f};
            if (n < nvalid) { const f32x4* kr = (const f32x4*)(KC + ((size_t)(b * 2 + g) * N_CMP + n) * 128); float a0 = 0.f, a1 = 0.f, a2 = 0.f;
#pragma unroll 2
                for (int d = 0; d < 32; ++d) { const f32x4 kk = kr[d]; const f32x4 q0 = *(const f32x4*)&qs[0][4 * d], q1 = *(const f32x4*)&qs[1][4 * d], q2 = *(const f32x4*)&qs[2][4 * d];
                    a0 += kk.x * q0.x + kk.y * q0.y + kk.z * q0.z + kk.w * q0.w; a1 += kk.x * q1.x + kk.y * q1.y + kk.z * q1.z + kk.w * q1.w; a2 += kk.x * q2.x + kk.y * q2.y + kk.z * q2.z + kk.w * q2.w; }
                const int bk = t5_bucket(t - (16 * n + 31)); s[0] = a0 + bias_s[bk][hb]; s[1] = a1 + bias_s[bk][hb + 1]; s[2] = a2 + bias_s[bk][hb + 2]; }
#pragma unroll
            for (int r = 0; r < 3; ++r) { pc[r][n] = s[r]; mx[r] = fmaxf(mx[r], s[r]); } }
#pragma unroll
        for (int r = 0; r < 3; ++r) { mx[r] = wave_max(mx[r]); float sum = 0.f;
            for (int base = 0; base < 256; base += 64) { const int n = base + lane; const float e = n < nvalid ? __expf(pc[r][n] - mx[r]) : 0.f; pc[r][n] = e; sum += e; }
            sum = wave_sum(sum); const float inv = 1.0f / fmaxf(sum, 1e-30f);
            for (int base = 0; base < 256; base += 64) pc[r][base + lane] *= inv; }
        __builtin_amdgcn_s_waitcnt(0); asm volatile("" ::: "memory");
#pragma unroll
        for (int r = 0; r < 3; ++r) { oc[r][0] = 0.f; oc[r][1] = 0.f; }
        for (int n = 0; n < nvalid; ++n) { const f32x2 vv = *(const f32x2*)(VC + ((size_t)(b * 2 + g) * N_CMP + n) * 128 + 2 * lane);
#pragma unroll
            for (int r = 0; r < 3; ++r) { const float p = pc[r][n]; oc[r][0] += p * vv.x; oc[r][1] += p * vv.y; } }
    }
    unsigned long long mask;
    {
        const int j = lane, cur = t >> 6; float imp = 0.f;
        for (int n = 4 * j - 1; n <= 4 * j + 3; ++n) if (n >= 0 && n < N_CMP) imp += pc[0][n] + pc[1][n] + pc[2][n];
        const bool forced = (j == 0) || (j == cur) || (j == cur - 1);
        const float score = forced ? 1e9f : (j <= cur ? imp : -1e30f);
        int rank = 0;
        for (int i = 0; i < 64; ++i) { const float si = __shfl(score, i); rank += (si > score || (si == score && i < j)) ? 1 : 0; }
        mask = __ballot(rank < 16 && j <= cur);
    }
    {
        float mx[3] = {-3.0e38f, -3.0e38f, -3.0e38f}; int slot = 0;
        for (unsigned long long mm = mask; mm; mm &= mm - 1, ++slot) { const int blk = __builtin_ctzll(mm); const int kpos = blk * 64 + lane; float s[3] = {-3.0e38f, -3.0e38f, -3.0e38f};
            if (kpos <= t) { const u32x4* kr = (const u32x4*)(NKS + ((size_t)b * SEQ + kpos) * 256 + g * 128); float a0 = 0.f, a1 = 0.f, a2 = 0.f;
#pragma unroll 2
                for (int d = 0; d < 16; ++d) { const u32x4 kk = kr[d]; const unsigned kw[4] = {kk.x, kk.y, kk.z, kk.w};
#pragma unroll
                    for (int e = 0; e < 4; ++e) { const float k0 = bf2f((bf16)(kw[e] & 0xffff)), k1 = bf2f((bf16)(kw[e] >> 16)); const int dd = 8 * d + 2 * e;
                        a0 += k0 * qs[0][dd] + k1 * qs[0][dd + 1]; a1 += k0 * qs[1][dd] + k1 * qs[1][dd + 1]; a2 += k0 * qs[2][dd] + k1 * qs[2][dd + 1]; } }
                const int bk = t5_bucket(t - kpos); s[0] = a0 + bias_s[bk][hb]; s[1] = a1 + bias_s[bk][hb + 1]; s[2] = a2 + bias_s[bk][hb + 2]; }
#pragma unroll
            for (int r = 0; r < 3; ++r) { sc[r][slot * 64 + lane] = s[r]; mx[r] = fmaxf(mx[r], s[r]); } }
        const int nslot = slot; float inv[3];
#pragma unroll
        for (int r = 0; r < 3; ++r) { mx[r] = wave_max(mx[r]); float sum = 0.f;
            for (int i = lane; i < nslot * 64; i += 64) { const float sv = sc[r][i]; const float e = sv > -1.0e38f ? __expf(sv - mx[r]) : 0.f; sc[r][i] = e; sum += e; }
            sum = wave_sum(sum); inv[r] = 1.0f / fmaxf(sum, 1e-30f); }
        __builtin_amdgcn_s_waitcnt(0); asm volatile("" ::: "memory");
#pragma unroll
        for (int r = 0; r < 3; ++r) { os[r][0] = 0.f; os[r][1] = 0.f; }
        slot = 0;
        for (unsigned long long mm = mask; mm; mm &= mm - 1, ++slot) { const int blk = __builtin_ctzll(mm); const int kmax = (t - blk * 64) < 63 ? (t - blk * 64) : 63;
            for (int kk = 0; kk <= kmax; ++kk) { const unsigned vv = *(const unsigned*)(proj + ((size_t)b * SEQ + blk * 64 + kk) * NPROJ + PC_VSL + g * 128 + 2 * lane);
                const float v0 = bf2f((bf16)(vv & 0xffff)), v1 = bf2f((bf16)(vv >> 16));
#pragma unroll
                for (int r = 0; r < 3; ++r) { const float p = sc[r][slot * 64 + kk]; os[r][0] += p * v0; os[r][1] += p * v1; } } }
#pragma unroll
        for (int r = 0; r < 3; ++r) { os[r][0] *= inv[r]; os[r][1] *= inv[r]; }
    }
    {
        const int lo = t - 511 > 0 ? t - 511 : 0, nk = t - lo + 1; float mx[3] = {-3.0e38f, -3.0e38f, -3.0e38f};
        for (int base = 0; base < nk; base += 64) { const int kpos = lo + base + lane; float s[3] = {-3.0e38f, -3.0e38f, -3.0e38f};
            if (kpos <= t) { const u32x4* kr = (const u32x4*)(NKW + ((size_t)b * SEQ + kpos) * 256 + g * 128); float a0 = 0.f, a1 = 0.f, a2 = 0.f;
#pragma unroll 2
                for (int d = 0; d < 16; ++d) { const u32x4 kk = kr[d]; const unsigned kw[4] = {kk.x, kk.y, kk.z, kk.w};
#pragma unroll
                    for (int e = 0; e < 4; ++e) { const float k0 = bf2f((bf16)(kw[e] & 0xffff)), k1 = bf2f((bf16)(kw[e] >> 16)); const int dd = 8 * d + 2 * e;
                        a0 += k0 * qs[0][dd] + k1 * qs[0][dd + 1]; a1 += k0 * qs[1][dd] + k1 * qs[1][dd + 1]; a2 += k0 * qs[2][dd] + k1 * qs[2][dd + 1]; } }
                const int bk = t5_bucket(t - kpos); s[0] = a0 + bias_s[bk][hb]; s[1] = a1 + bias_s[bk][hb + 1]; s[2] = a2 + bias_s[bk][hb + 2]; }
#pragma unroll
            for (int r = 0; r < 3; ++r) { sc[r][base + lane] = s[r]; mx[r] = fmaxf(mx[r], s[r]); } }
        const int ntot = (nk + 63) & ~63; float inv[3];
#pragma unroll
        for (int r = 0; r < 3; ++r) { mx[r] = wave_max(mx[r]); float sum = 0.f;
            for (int i = lane; i < ntot; i += 64) { const float sv = sc[r][i]; const float e = sv > -1.0e38f ? __expf(sv - mx[r]) : 0.f; sc[r][i] = e; sum += e; }
            sum = wave_sum(sum); inv[r] = 1.0f / fmaxf(sum, 1e-30f); }
        __builtin_amdgcn_s_waitcnt(0); asm volatile("" ::: "memory");
#pragma unroll
        for (int r = 0; r < 3; ++r) { ow[r][0] = 0.f; ow[r][1] = 0.f; }
        for (int kk = 0; kk < nk; ++kk) { const unsigned vv = *(const unsigned*)(proj + ((size_t)b * SEQ + lo + kk) * NPROJ + PC_VWN + g * 128 + 2 * lane);
            const float v0 = bf2f((bf16)(vv & 0xffff)), v1 = bf2f((bf16)(vv >> 16));
#pragma unroll
            for (int r = 0; r < 3; ++r) { const float p = sc[r][kk]; ow[r][0] += p * v0; ow[r][1] += p * v1; } }
#pragma unroll
        for (int r = 0; r < 3; ++r) { ow[r][0] *= inv[r]; ow[r][1] *= inv[r]; }
    }
#pragma unroll
    for (int r = 0; r < 3; ++r) { const float* gp = small + m * 32 + SM_GC + hb + r;
        const float g0 = sigmoidf_(gp[0]), g1 = sigmoidf_(gp[6]), g2 = sigmoidf_(gp[12]);
        *(unsigned*)(mix + m * D_MODEL + 1280 + (hb + r) * 128 + 2 * lane) = pk2(g0 * oc[r][0] + g1 * os[r][0] + g2 * ow[r][0], g0 * oc[r][1] + g1 * os[r][1] + g2 * ow[r][1]); }
    }
    __syncthreads();
}

typedef short bf16x8 __attribute__((ext_vector_type(8)));
typedef float f32x16 __attribute__((ext_vector_type(16)));
typedef __bf16 bf16x2_t __attribute__((ext_vector_type(2)));
#define MFMA32(a, b, c) __builtin_amdgcn_mfma_f32_32x32x16_bf16((a), (b), (c), 0, 0, 0)
constexpr float LOG2E = 1.4426950408889634f, LN2 = 0.6931471805599453f;
__device__ __forceinline__ unsigned cvt2(float lo, float hi) { f32x2 v = {lo, hi}; return __builtin_bit_cast(unsigned, __builtin_convertvector(v, bf16x2_t)); }
__device__ __forceinline__ int perm16(int k) { return (k & 3) | ((k & 4) << 1) | ((k & 8) >> 1); }
__device__ __forceinline__ bf16x8 ld_frag(const bf16* p) { return __builtin_bit_cast(bf16x8, *(const u32x4*)p); }

__device__ __forceinline__ void ph_nsa_prep2(const bf16* __restrict__ proj, const float* __restrict__ qg, const float* __restrict__ kg, bf16* __restrict__ NQ, bf16* __restrict__ KS, bf16* __restrict__ KW,
                                             bf16* __restrict__ VST, bf16* __restrict__ VWT) {
    const int tid = ltid(); const int lane = tid & 63; const int gw = blockIdx.x * NWAVES + (tid >> 6), ngw = gridDim.x * NWAVES;
    {
        const int c0 = (lane & 15) * 8;
        const f32x4 qg0 = *(const f32x4*)(qg + c0), qg1 = *(const f32x4*)(qg + c0 + 4), kg0 = *(const f32x4*)(kg + c0), kg1 = *(const f32x4*)(kg + c0 + 4);
        const int pstep = ngw * 4;
        for (int p0 = gw * 4 + (lane >> 4); p0 < M * 10; p0 += 4 * pstep) {
            u32x4 prr[4];
#pragma unroll
            for (int k = 0; k < 4; ++k) { const int p = p0 + k * pstep; const int pc = p < M * 10 ? p : p0; const int m = pc / 10, j = pc % 10;
                const int src = j < 6 ? PC_QC + j * 128 : (j < 8 ? PC_KSL + (j - 6) * 128 : PC_KWN + (j - 8) * 128);
                prr[k] = *(const u32x4*)(proj + (size_t)m * NPROJ + src + c0); }
#pragma unroll
            for (int k = 0; k < 4; ++k) { const int p = p0 + k * pstep;
                if (p < M * 10) {
                    const int m = p / 10, j = p % 10;
                    const unsigned pw[4] = {prr[k].x, prr[k].y, prr[k].z, prr[k].w};
                    float y[8]; float ss = 0.f;
#pragma unroll
                    for (int e = 0; e < 4; ++e) { y[2 * e] = bf2f((bf16)(pw[e] & 0xffff)); y[2 * e + 1] = bf2f((bf16)(pw[e] >> 16)); ss += y[2 * e] * y[2 * e] + y[2 * e + 1] * y[2 * e + 1]; }
                    float r = rsqrtf(row16_sum(ss) * (1.f / 128.f) + NORM_EPS);
                    if (j < 6) r *= 0.08838834764831845f * LOG2E;
                    const f32x4 g0 = j < 6 ? qg0 : kg0, g1 = j < 6 ? qg1 : kg1;
                    u32x4 o; o.x = cvt2(y[0] * r * g0.x, y[1] * r * g0.y); o.y = cvt2(y[2] * r * g0.z, y[3] * r * g0.w); o.z = cvt2(y[4] * r * g1.x, y[5] * r * g1.y); o.w = cvt2(y[6] * r * g1.z, y[7] * r * g1.w);
                    const int b = m >> 12, t = m & (SEQ - 1);
                    if (j < 6) *(u32x4*)(NQ + (size_t)m * 768 + j * 128 + c0) = o;
                    else if (j < 8) *(u32x4*)(KS + ((size_t)(b * 2 + (j - 6)) * SEQ + t) * 128 + c0) = o;
                    else *(u32x4*)(KW + ((size_t)(b * 2 + (j - 8)) * SEQ + t) * 128 + c0) = o;
                } }
        }
    }
    for (int task = gw; task < BATCH * 2 * 2 * 64; task += ngw) {
        const int tile = task & 63, which = (task >> 6) & 1, g = (task >> 7) & 1, b = task >> 8;
        const int t = tile * 64 + lane;
        const bf16* src = proj + (size_t)(b * SEQ + t) * NPROJ + (which ? PC_VWN : PC_VSL) + g * 128;
        bf16* dst = (which ? VWT : VST) + (size_t)(b * 2 + g) * 128 * SEQ + (t & ~15) + perm16(t & 15);
        u32x4 vv[16];
#pragma unroll
        for (int c = 0; c < 16; ++c) vv[c] = *(const u32x4*)(src + 8 * c);
#pragma unroll
        for (int c = 0; c < 16; ++c) { const unsigned w[4] = {vv[c].x, vv[c].y, vv[c].z, vv[c].w};
#pragma unroll
            for (int e = 0; e < 4; ++e) { dst[(size_t)(8 * c + 2 * e) * SEQ] = (bf16)(w[e] & 0xffff); dst[(size_t)(8 * c + 2 * e + 1) * SEQ] = (bf16)(w[e] >> 16); } }
    }
}

__device__ __forceinline__ void ph_nsa_select_naive(const bf16* __restrict__ NQ, const float* __restrict__ KC, const float* __restrict__ VC, const float* __restrict__ small, const float* __restrict__ rel_bias,
                                                    unsigned long long* __restrict__ SELM, bf16* __restrict__ OC) {
    extern __shared__ __attribute__((aligned(16))) unsigned char lds_dyn[];
    const int tid = ltid(); const int lane = tid & 63, wave = tid >> 6;
    float (*bias_s)[6] = (float (*)[6])(lds_dyn + 8 * 4608);
    __syncthreads();
    for (int i = tid; i < 192; i += NTHREADS) bias_s[i / 6][i % 6] = rel_bias[i];
    __syncthreads();
    float (*qs)[128] = (float (*)[128])(lds_dyn + wave * 4608); float (*pc)[256] = (float (*)[256])(lds_dyn + wave * 4608 + 1536);
    for (int idx = blockIdx.x * NWAVES + wave; idx < M * 2; idx += gridDim.x * NWAVES) {
        const int t = idx & (SEQ - 1), g = (idx >> 12) & 1, b = idx >> 13;
        const size_t m = (size_t)b * SEQ + t;
        for (int i = lane; i < 384; i += 64) qs[i >> 7][i & 127] = bf2f(NQ[m * 768 + g * 384 + i]) * LN2;
        __builtin_amdgcn_s_waitcnt(0); asm volatile("" ::: "memory");
        const int hb = g * 3;
        float oc[3][2];
        const int nvalid = t >= 31 ? ((t - 31) >> 4) + 1 : 0;
        float mx[3] = {-3.0e38f, -3.0e38f, -3.0e38f};
        for (int base = 0; base < 256; base += 64) { const int n = base + lane; float s[3] = {-3.0e38f, -3.0e38f, -3.0e38f};
            if (n < nvalid) { const f32x4* kr = (const f32x4*)(KC + ((size_t)(b * 2 + g) * N_CMP + n) * 128); float a0 = 0.f, a1 = 0.f, a2 = 0.f;
#pragma unroll 2
                for (int d = 0; d < 32; ++d) { const f32x4 kk = kr[d]; const f32x4 q0 = *(const f32x4*)&qs[0][4 * d], q1 = *(const f32x4*)&qs[1][4 * d], q2 = *(const f32x4*)&qs[2][4 * d];
                    a0 += kk.x * q0.x + kk.y * q0.y + kk.z * q0.z + kk.w * q0.w; a1 += kk.x * q1.x + kk.y * q1.y + kk.z * q1.z + kk.w * q1.w; a2 += kk.x * q2.x + kk.y * q2.y + kk.z * q2.z + kk.w * q2.w; }
                const int bk = t5_bucket(t - (16 * n + 31)); s[0] = a0 + bias_s[bk][hb]; s[1] = a1 + bias_s[bk][hb + 1]; s[2] = a2 + bias_s[bk][hb + 2]; }
#pragma unroll
            for (int r = 0; r < 3; ++r) { pc[r][n] = s[r]; mx[r] = fmaxf(mx[r], s[r]); } }
#pragma unroll
        for (int r = 0; r < 3; ++r) { mx[r] = wave_max(mx[r]); float sum = 0.f;
            for (int base = 0; base < 256; base += 64) { const int n = base + lane; const float e = n < nvalid ? __expf(pc[r][n] - mx[r]) : 0.f; pc[r][n] = e; sum += e; }
            sum = wave_sum(sum); const float inv = 1.0f / fmaxf(sum, 1e-30f);
            for (int base = 0; base < 256; base += 64) pc[r][base + lane] *= inv; }
        __builtin_amdgcn_s_waitcnt(0); asm volatile("" ::: "memory");
#pragma unroll
        for (int r = 0; r < 3; ++r) { oc[r][0] = 0.f; oc[r][1] = 0.f; }
        for (int n = 0; n < nvalid; ++n) { const f32x2 vv = *(const f32x2*)(VC + ((size_t)(b * 2 + g) * N_CMP + n) * 128 + 2 * lane);
#pragma unroll
            for (int r = 0; r < 3; ++r) { const float p = pc[r][n]; oc[r][0] += p * vv.x; oc[r][1] += p * vv.y; } }
        { const int j = lane, cur = t >> 6; float imp = 0.f;
          for (int n = 4 * j - 1; n <= 4 * j + 3; ++n) if (n >= 0 && n < N_CMP) imp += pc[0][n] + pc[1][n] + pc[2][n];
          const bool forced = (j == 0) || (j == cur) || (j == cur - 1);
          const float score = forced ? 1e9f : (j <= cur ? imp : -1e30f);
          int rank = 0;
          for (int i = 0; i < 64; ++i) { const float si = __shfl(score, i); rank += (si > score || (si == score && i < j)) ? 1 : 0; }
          const unsigned long long mask = __ballot(rank < 16 && j <= cur);
          if (lane == 0) SELM[(size_t)(b * 2 + g) * SEQ + t] = mask; }
#pragma unroll
        for (int r = 0; r < 3; ++r) { const float g0 = sigmoidf_(small[m * 32 + SM_GC + hb + r]);
            *(unsigned*)(OC + m * D_MODEL + 1280 + (hb + r) * 128 + 2 * lane) = cvt2(g0 * oc[r][0], g0 * oc[r][1]); }
    }
    __syncthreads();
}

constexpr int ATT_BUF = 32768, ATT_NBUF = 3;
constexpr int ATT_NEXT = 328, ATT_EOFF = 224;
constexpr int ATT_BTAB = ATT_NBUF * ATT_BUF, ATT_QW = ATT_BTAB + 4 * ATT_NEXT * 4;
#define ATT_SB() __builtin_amdgcn_sched_barrier(0)
#define ATT_BAR() asm volatile("s_waitcnt lgkmcnt(0)\n\ts_barrier" ::: "memory")
template <int MODE, int KIND> __device__ __forceinline__ void attn_tile(const LAS unsigned char* fq, const LAS unsigned char* tb, float msk, int dlim, const bf16x8 (&qf)[8], f32x16 (&O)[4], float& lsum) {
#define ATT_KF(kk_, s_) (*(const LAS u32x4*)(fq + ((kk_) * 8 + (s_)) * 1024))
#define ATT_VF(dt_, c_) (*(const LAS u32x4*)(fq + 16384 + ((dt_) * 4 + (c_)) * 1024))
#define ATT_BF(x_) __builtin_bit_cast(bf16x8, x_)
#define ATT_EXP(S_, half_, pb_) do { \
        if (KIND == 3 && dlim != 0) { _Pragma("unroll") for (int gq = 0; gq < 4; ++gq) { const f32x4 bv = *(const LAS f32x4*)(tb + 4 * (8 * gq + 32 * (half_))); \
            S_[4 * gq] += bv[0]; S_[4 * gq + 1] += bv[1]; S_[4 * gq + 2] += bv[2]; S_[4 * gq + 3] += bv[3]; } }     \
        _Pragma("unroll") for (int i = 0; i < 16; ++i) { float e = __builtin_amdgcn_exp2f(S_[i]); \
            if (KIND == 2) e = ((i & 3) + 8 * (i >> 2) + 32 * (half_) > dlim) ? e : 0.f; \
            if (MODE == 0) e *= msk; \
            S_[i] = e; lsum += e; } \
        _Pragma("unroll") for (int s2 = 0; s2 < 2; ++s2) { u32x4 w; w.x = cvt2(S_[8 * s2], S_[8 * s2 + 1]); w.y = cvt2(S_[8 * s2 + 2], S_[8 * s2 + 3]); w.z = cvt2(S_[8 * s2 + 4], S_[8 * s2 + 5]); w.w = cvt2(S_[8 * s2 + 6], S_[8 * s2 + 7]); pb_[s2] = ATT_BF(w); } } while (0)
#define ATT_SINIT(S_, half_) do { if (KIND == 1) { _Pragma("unroll") for (int gq = 0; gq < 4; ++gq) { const f32x4 bv = *(const LAS f32x4*)(tb + 4 * (8 * gq + 32 * (half_))); \
            S_[4 * gq] = bv[0]; S_[4 * gq + 1] = bv[1]; S_[4 * gq + 2] = bv[2]; S_[4 * gq + 3] = bv[3]; } } else { _Pragma("unroll") for (int i = 0; i < 16; ++i) S_[i] = 0.f; } } while (0)
    u32x4 fa[4], fb[4]; f32x16 S0, S1; bf16x8 pb0[2], pb1[2];
    ATT_SINIT(S0, 0);
#pragma unroll
    for (int s = 0; s < 4; ++s) fa[s] = ATT_KF(0, s);
    ATT_SB();
#pragma unroll
    for (int s = 0; s < 4; ++s) fb[s] = ATT_KF(0, 4 + s);
#pragma unroll
    for (int s = 0; s < 4; ++s) S0 = MFMA32(ATT_BF(fa[s]), qf[s], S0);
    ATT_SB();
#pragma unroll
    for (int s = 0; s < 4; ++s) fa[s] = ATT_KF(1, s);
    ATT_SINIT(S1, 1);
#pragma unroll
    for (int s = 0; s < 4; ++s) S0 = MFMA32(ATT_BF(fb[s]), qf[4 + s], S0);
    ATT_SB();
#pragma unroll
    for (int s = 0; s < 4; ++s) fb[s] = ATT_KF(1, 4 + s);
#pragma unroll
    for (int s = 0; s < 4; ++s) S1 = MFMA32(ATT_BF(fa[s]), qf[s], S1);
    ATT_SB();
    fa[0] = ATT_VF(0, 0); fa[1] = ATT_VF(0, 1); fa[2] = ATT_VF(1, 0); fa[3] = ATT_VF(1, 1);
#pragma unroll
    for (int s = 0; s < 4; ++s) S1 = MFMA32(ATT_BF(fb[s]), qf[4 + s], S1);
    ATT_EXP(S0, 0, pb0);
    ATT_SB();
    fb[0] = ATT_VF(2, 0); fb[1] = ATT_VF(2, 1); fb[2] = ATT_VF(3, 0); fb[3] = ATT_VF(3, 1);
    O[0] = MFMA32(ATT_BF(fa[0]), pb0[0], O[0]); O[0] = MFMA32(ATT_BF(fa[1]), pb0[1], O[0]); O[1] = MFMA32(ATT_BF(fa[2]), pb0[0], O[1]); O[1] = MFMA32(ATT_BF(fa[3]), pb0[1], O[1]);
    ATT_EXP(S1, 1, pb1);
    ATT_SB();
    fa[0] = ATT_VF(0, 2); fa[1] = ATT_VF(0, 3); fa[2] = ATT_VF(1, 2); fa[3] = ATT_VF(1, 3);
    O[2] = MFMA32(ATT_BF(fb[0]), pb0[0], O[2]); O[2] = MFMA32(ATT_BF(fb[1]), pb0[1], O[2]); O[3] = MFMA32(ATT_BF(fb[2]), pb0[0], O[3]); O[3] = MFMA32(ATT_BF(fb[3]), pb0[1], O[3]);
    ATT_SB();
    fb[0] = ATT_VF(2, 2); fb[1] = ATT_VF(2, 3); fb[2] = ATT_VF(3, 2); fb[3] = ATT_VF(3, 3);
    O[0] = MFMA32(ATT_BF(fa[0]), pb1[0], O[0]); O[0] = MFMA32(ATT_BF(fa[1]), pb1[1], O[0]); O[1] = MFMA32(ATT_BF(fa[2]), pb1[0], O[1]); O[1] = MFMA32(ATT_BF(fa[3]), pb1[1], O[1]);
    ATT_SB();
    O[2] = MFMA32(ATT_BF(fb[0]), pb1[0], O[2]); O[2] = MFMA32(ATT_BF(fb[1]), pb1[1], O[2]); O[3] = MFMA32(ATT_BF(fb[2]), pb1[0], O[3]); O[3] = MFMA32(ATT_BF(fb[3]), pb1[1], O[3]);
    ATT_SB();
#undef ATT_KF
#undef ATT_VF
#undef ATT_BF
#undef ATT_EXP
#undef ATT_SINIT
}
template <int MODE> __device__ __forceinline__ void attn_branch(const bf16* __restrict__ Kbase, const bf16* __restrict__ VTbase, int kt_lo, int kt_hi, int tq0, int t, int h, int q, int tid, int wave,
                                                                unsigned long long selmask, const bf16x8 (&qf)[8], f32x16 (&O)[4], float& lsum) {
    extern __shared__ __attribute__((aligned(16))) unsigned char lds_dyn[];
    LAS unsigned char* ldsl = (LAS unsigned char*)lds_dyn;
    const unsigned kvo = (unsigned)(q * 256 + h * 16), vvo = (unsigned)(q * (SEQ * 2) + h * 16);
    auto dma = [&](int kt, int buf) {
        const char* kg = (const char*)Kbase + (size_t)kt * (64 * 128 * 2); const char* vg = (const char*)VTbase + kt * 128;
#pragma unroll
        for (int i = 0; i < 2; ++i) { const int n = 2 * wave + i;
            __builtin_amdgcn_global_load_lds((const unsigned*)(kg + ((n >> 3) * 8192 + (n & 7) * 32) + kvo), (LAS unsigned*)(ldsl + buf * ATT_BUF + n * 1024), 16, 0, 0);
            __builtin_amdgcn_global_load_lds((const unsigned*)(vg + ((size_t)(n >> 2) * (32 * SEQ * 2) + (n & 3) * 32) + vvo), (LAS unsigned*)(ldsl + buf * ATT_BUF + 16384 + n * 1024), 16, 0, 0); } };
    const int lane16 = (h * 32 + q) * 16;
    const int tlane = ATT_BTAB + ((0 - q) & 3) * (ATT_NEXT * 4) + 4 * (ATT_EOFF - ((0 - q) & 3));
    ATT_BAR();
    dma(kt_lo, 0);
    if (kt_lo < kt_hi) { dma(kt_lo + 1, 1); asm volatile("s_waitcnt vmcnt(4)" ::: "memory"); } else asm volatile("s_waitcnt vmcnt(0)" ::: "memory");
    ATT_BAR();
    int buf = 0;
    for (int kt = kt_lo; kt <= kt_hi; ++kt) {
        const bool more = kt + 2 <= kt_hi;
        if (more) dma(kt + 2, buf == 0 ? 2 : buf - 1);
        bool need = 64 * kt <= tq0 + 31;
        if (MODE == 1) need = need && (64 * kt + 63 >= tq0 - 511);
        const bool sel = MODE == 0 ? ((selmask >> kt) & 1ull) != 0ull : true;
        if (need && (MODE == 1 || __ballot(sel) != 0ull)) {
            const LAS unsigned char* fq = ldsl + buf * ATT_BUF + lane16;
            const int mind = tq0 - (64 * kt + 63), maxd = tq0 + 31 - 64 * kt;
            const float msk = sel ? 1.f : 0.f;
            const int d0 = t - 64 * kt - 4 * h;
            if (MODE == 0) {
                const int nearf = __builtin_amdgcn_readfirstlane(mind < 128 ? 1 : 0);
                attn_tile<MODE, 3>(fq, ldsl + tlane - 4 * d0, msk, nearf, qf, O, lsum);
            } else if (mind >= 128) {
                if (maxd <= 511) attn_tile<MODE, 0>(fq, ldsl, msk, 0, qf, O, lsum);
                else attn_tile<MODE, 2>(fq, ldsl, msk, d0 - 512, qf, O, lsum);
            } else attn_tile<MODE, 1>(fq, ldsl + tlane - 4 * d0, msk, 0, qf, O, lsum);
        }
        if (more) asm volatile("s_waitcnt vmcnt(4)" ::: "memory"); else asm volatile("s_waitcnt vmcnt(0)" ::: "memory");
        ATT_BAR();
        buf = buf == 2 ? 0 : buf + 1;
    }
}
__device__ __forceinline__ void ph_nsa_main(const bf16* __restrict__ NQ, const bf16* __restrict__ KS, const bf16* __restrict__ KW, const bf16* __restrict__ VST, const bf16* __restrict__ VWT,
                                            const unsigned long long* __restrict__ SELM, const bf16* __restrict__ OC, const float* __restrict__ small, const float* __restrict__ rel_bias, bf16* __restrict__ mix,
                                            unsigned* __restrict__ queue) {
    extern __shared__ __attribute__((aligned(16))) unsigned char lds_dyn[];
    float* btab = (float*)(lds_dyn + ATT_BTAB); volatile unsigned* qw = (volatile unsigned*)(lds_dyn + ATT_QW);
    for (;;) {
        const int tid = ltid();
        const int lane = tid & 63, wave = __builtin_amdgcn_readfirstlane(tid >> 6), q = lane & 31, h = lane >> 5;
        __syncthreads();
        if (tid == 0) *qw = __hip_atomic_fetch_add(queue, 1u, __ATOMIC_RELAXED, __HIP_MEMORY_SCOPE_AGENT);
        __syncthreads();
        const int u = __builtin_amdgcn_readfirstlane((int)*qw);
        if (u >= 768) break;
        const int qb = 15 - u / 48, rem = u % 48, r = rem % 3, bg = rem / 3, g = bg & 1, b = bg >> 1, head = g * 3 + r;
        { const float bfar = rel_bias[t5_bucket(127) * 6 + head];
          for (int e = tid; e < 4 * ATT_NEXT; e += NTHREADS) { const int c = e / ATT_NEXT, dist = ATT_EOFF - (e - c * ATT_NEXT) - c;
              btab[e] = dist < 0 ? -1e30f : (rel_bias[t5_bucket(dist > 127 ? 127 : dist) * 6 + head] - bfar) * LOG2E; } }
        const int t0 = qb * 256, tq0 = t0 + 32 * wave, t = tq0 + q; const size_t m = (size_t)b * SEQ + t;
        bf16x8 qf[8];
#pragma unroll
        for (int s = 0; s < 8; ++s) qf[s] = ld_frag(NQ + m * 768 + head * 128 + 16 * s + 8 * h);
        const unsigned long long selmask = SELM[(size_t)(b * 2 + g) * SEQ + t];
        f32x16 O[4]; float lsum = 0.f;
#pragma unroll
        for (int dt = 0; dt < 4; ++dt)
#pragma unroll
            for (int i = 0; i < 16; ++i) O[dt][i] = 0.f;
        attn_branch<0>(KS + (size_t)(b * 2 + g) * SEQ * 128, VST + (size_t)(b * 2 + g) * 128 * SEQ, 0, 4 * qb + 3, tq0, t, h, q, tid, wave, selmask, qf, O, lsum);
        { const float l = lsum + __shfl_xor(lsum, 32); const float sc = sigmoidf_(small[m * 32 + SM_GC + 6 + head]) / l;
#pragma unroll
          for (int dt = 0; dt < 4; ++dt)
#pragma unroll
              for (int gq = 0; gq < 4; ++gq) { const int d = 32 * dt + 8 * gq + 4 * h;
                  const u32x2 ocv = *(const u32x2*)(mix + m * D_MODEL + 1280 + head * 128 + d);
                  u32x2 w; w.x = cvt2(O[dt][4 * gq] * sc + bf2f((bf16)(ocv.x & 0xffff)), O[dt][4 * gq + 1] * sc + bf2f((bf16)(ocv.x >> 16)));
                  w.y = cvt2(O[dt][4 * gq + 2] * sc + bf2f((bf16)(ocv.y & 0xffff)), O[dt][4 * gq + 3] * sc + bf2f((bf16)(ocv.y >> 16)));
                  *(u32x2*)(mix + m * D_MODEL + 1280 + head * 128 + d) = w; }
#pragma unroll
          for (int dt = 0; dt < 4; ++dt)
#pragma unroll
              for (int i = 0; i < 16; ++i) O[dt][i] = 0.f; }
        lsum = 0.f;
        { const int lo = t0 - 512 > 0 ? (t0 - 512) >> 6 : 0;
          attn_branch<1>(KW + (size_t)(b * 2 + g) * SEQ * 128, VWT + (size_t)(b * 2 + g) * 128 * SEQ, lo, (t0 + 255) >> 6, tq0, t, h, q, tid, wave, 0ull, qf, O, lsum); }
        { const float l = lsum + __shfl_xor(lsum, 32); const float sc = sigmoidf_(small[m * 32 + SM_GC + 12 + head]) / l;
#pragma unroll
          for (int dt = 0; dt < 4; ++dt)
#pragma unroll
              for (int gq = 0; gq < 4; ++gq) { const int d = 32 * dt + 8 * gq + 4 * h;
                  u32x2* mp = (u32x2*)(mix + m * D_MODEL + 1280 + head * 128 + d); const u32x2 pv = *mp;
                  u32x2 w; w.x = cvt2(O[dt][4 * gq] * sc + bf2f((bf16)(pv.x & 0xffff)), O[dt][4 * gq + 1] * sc + bf2f((bf16)(pv.x >> 16)));
                  w.y = cvt2(O[dt][4 * gq + 2] * sc + bf2f((bf16)(pv.y & 0xffff)), O[dt][4 * gq + 3] * sc + bf2f((bf16)(pv.y >> 16)));
                  *mp = w; } }
    }
    __syncthreads();
}

constexpr int SL_KSTR = 272, SL_VSTR = 528;
constexpr int SL_K = 0, SL_V = 256 * SL_KSTR, SL_BT = SL_V + 128 * SL_VSTR;
static_assert(SL_BT + 3072 <= LDS_MISC, "selection phase LDS");
__device__ __forceinline__ void ph_nsa_select_fast(const bf16* __restrict__ NQ, const bf16* __restrict__ KCB, const bf16* __restrict__ VCT, const float* __restrict__ small, const float* __restrict__ rel_bias,
                                                   unsigned long long* __restrict__ SELM, bf16* __restrict__ mix) {
    extern __shared__ __attribute__((aligned(16))) unsigned char lds_dyn[];
    const int tid = ltid(); const int lane = tid & 63, wave = tid >> 6, q = lane & 31, h = lane >> 5;
    float* btab = (float*)(lds_dyn + SL_BT);
    __syncthreads();
    for (int i = tid; i < 768; i += NTHREADS) btab[i] = (rel_bias[t5_bucket(i & 127) * 6 + (i >> 7)] - rel_bias[t5_bucket(127) * 6 + (i >> 7)]) * LOG2E;
    for (int item = blockIdx.x; item < BATCH * 2 * 16; item += gridDim.x) {
        const int qb = item & 15, g = (item >> 4) & 1, b = item >> 5;
        const int qt = 8 * qb + wave, t0 = 32 * qt, t = t0 + q; const size_t m = (size_t)b * SEQ + t;
        const int nv = t >= 31 ? ((t - 31) >> 4) + 1 : 0;
        const int ntile = (qt + 16) >> 4;
        const int nt_blk = (8 * qb + 7 + 16) >> 4;
        const int t0u = __builtin_amdgcn_readfirstlane(t0);
        {
          const bf16* Kb = KCB + (size_t)(b * 2 + g) * 256 * 128; const bf16* Vb = VCT + (size_t)(b * 2 + g) * 128 * 256;
          __syncthreads();
          const int vch = nt_blk * 4;
          const int nbu = __builtin_amdgcn_readfirstlane(nt_blk);
          u32x4 kr[8], vr[8];
#pragma unroll
          for (int i = 0; i < 8; ++i) { const int c = tid + NTHREADS * (i < nbu ? i : 0); kr[i] = *(const u32x4*)(Kb + (size_t)c * 8);
              const int d = c / vch, part = c - d * vch; vr[i] = *(const u32x4*)(Vb + (size_t)d * 256 + part * 8); }
#pragma unroll
          for (int i = 0; i < 8; ++i) if (i < nbu) { const int c = tid + NTHREADS * i; *(u32x4*)(lds_dyn + SL_K + (c >> 4) * SL_KSTR + (c & 15) * 16) = kr[i];
              const int d = c / vch, part = c - d * vch; *(u32x4*)(lds_dyn + SL_V + d * SL_VSTR + part * 16) = vr[i]; }
          __syncthreads(); }
        float imp[32];
#pragma unroll
        for (int i = 0; i < 32; ++i) imp[i] = 0.f;
#pragma unroll 1
        for (int r = 0; r < 3; ++r) {
            const int head = g * 3 + r;
            int h_ = h, t_ = t, q_ = q; asm volatile("" : "+v"(h_), "+v"(t_), "+v"(q_));
            bf16x8 qf[8];
#pragma unroll
            for (int s = 0; s < 8; ++s) qf[s] = ld_frag(NQ + m * 768 + head * 128 + 16 * s + 8 * h_);
            const float* bt = btab + head * 128;
            const unsigned char* kl = lds_dyn + SL_K + q_ * SL_KSTR + 16 * h_; const unsigned char* vl = lds_dyn + SL_V + q_ * SL_VSTR + 16 * h_;
            f32x16 O[4]; float Uacc[32]; float lsum = 0.f, carry = 0.f;
#pragma unroll
            for (int dt = 0; dt < 4; ++dt)
#pragma unroll
                for (int i = 0; i < 16; ++i) O[dt][i] = 0.f;
#pragma unroll
            for (int i = 0; i < 32; ++i) Uacc[i] = 0.f;
#pragma unroll
            for (int kk = 0; kk < 8; ++kk) {
                if (kk < ntile) {
                    f32x16 S;
#pragma unroll
                    for (int i = 0; i < 16; ++i) S[i] = 0.f;
#pragma unroll
                    for (int s = 0; s < 8; ++s) S = MFMA32(__builtin_bit_cast(bf16x8, *(const u32x4*)(kl + kk * 32 * SL_KSTR + 32 * s)), qf[s], S);
                    float p[16];
                    if (512 * kk + 655 <= t0u) {
#pragma unroll
                        for (int i = 0; i < 16; ++i) { p[i] = __builtin_amdgcn_exp2f(S[i]); lsum += p[i]; }
                    } else {
#pragma unroll
                    for (int i = 0; i < 16; ++i) { const int n = 32 * kk + (i & 3) + 8 * (i >> 2) + 4 * h_; const int dist = t_ - 16 * n - 31;
                        const int bi = dist < 0 ? 0 : (dist > 127 ? 127 : dist);
                        const float e = __builtin_amdgcn_exp2f(S[i] + bt[bi]); p[i] = n < nv ? e : 0.f; lsum += p[i]; }
                    }
                    float G[4], Lp[4];
#pragma unroll
                    for (int gq = 0; gq < 4; ++gq) { G[gq] = (p[4 * gq] + p[4 * gq + 1]) + (p[4 * gq + 2] + p[4 * gq + 3]); Lp[gq] = __shfl_xor(p[4 * gq + 3], 32); }
#pragma unroll
                    for (int gq = 0; gq < 4; ++gq) { const float prev = gq > 0 ? Lp[gq > 0 ? gq - 1 : 0] : carry; Uacc[4 * kk + gq] += G[gq] + (h_ ? Lp[gq] : prev); }
                    carry = Lp[3];
#pragma unroll
                    for (int s2 = 0; s2 < 2; ++s2) { u32x4 w; w.x = cvt2(p[8 * s2], p[8 * s2 + 1]); w.y = cvt2(p[8 * s2 + 2], p[8 * s2 + 3]); w.z = cvt2(p[8 * s2 + 4], p[8 * s2 + 5]); w.w = cvt2(p[8 * s2 + 6], p[8 * s2 + 7]);
                        const bf16x8 pb = __builtin_bit_cast(bf16x8, w);
#pragma unroll
                        for (int dt = 0; dt < 4; ++dt) O[dt] = MFMA32(__builtin_bit_cast(bf16x8, *(const u32x4*)(vl + dt * 32 * SL_VSTR + (32 * kk + 16 * s2) * 2)), pb, O[dt]); }
                }
            }
            const float l = lsum + __shfl_xor(lsum, 32); const float inv = l > 0.f ? 1.0f / l : 0.f;
#pragma unroll
            for (int i = 0; i < 32; ++i) imp[i] += Uacc[i] * inv;
            const float sc = sigmoidf_(small[m * 32 + SM_GC + head]) * inv;
#pragma unroll
            for (int dt = 0; dt < 4; ++dt)
#pragma unroll
                for (int gq = 0; gq < 4; ++gq) { u32x2 w; w.x = cvt2(O[dt][4 * gq] * sc, O[dt][4 * gq + 1] * sc); w.y = cvt2(O[dt][4 * gq + 2] * sc, O[dt][4 * gq + 3] * sc);
                    *(u32x2*)(mix + m * D_MODEL + 1280 + head * 128 + 32 * dt + 8 * gq + 4 * h_) = w; }
        }
        const int cur = t >> 6;
        int hs = h; asm volatile("" : "+v"(hs));
        unsigned keys[32];
#pragma unroll
        for (int i = 0; i < 32; ++i) { const int j = 2 * i + hs; const bool causal = j <= cur, forced = (j == 0) || (j == cur) || (j == cur - 1);
            keys[i] = !causal ? 0u : (forced ? (0x7f000000u | (unsigned)(63 - j)) : ((__float_as_uint(imp[i]) & ~63u) | (unsigned)(63 - j))); }
        unsigned selbits = 0u;
#pragma unroll 1
        for (int round = 0; round < 16; ++round) {
            unsigned mx = keys[0];
#pragma unroll
            for (int i = 1; i < 32; ++i) mx = mx > keys[i] ? mx : keys[i];
            const unsigned pm = (unsigned)__shfl_xor((int)mx, 32); const unsigned gm = mx > pm ? mx : pm;
#pragma unroll
            for (int i = 0; i < 32; ++i) { const bool hit = keys[i] == gm && gm != 0u; selbits |= hit ? (1u << i) : 0u; keys[i] = hit ? 0u : keys[i]; }
        }
        unsigned long long x = selbits;
        x = (x | (x << 16)) & 0x0000FFFF0000FFFFull; x = (x | (x << 8)) & 0x00FF00FF00FF00FFull; x = (x | (x << 4)) & 0x0F0F0F0F0F0F0F0Full; x = (x | (x << 2)) & 0x3333333333333333ull; x = (x | (x << 1)) & 0x5555555555555555ull;
        x <<= h;
        const unsigned plo = (unsigned)__shfl_xor((int)(unsigned)x, 32), phi = (unsigned)__shfl_xor((int)(unsigned)(x >> 32), 32);
        x |= ((unsigned long long)phi << 32) | plo;
        if (h == 0) SELM[(size_t)(b * 2 + g) * SEQ + t] = x;
    }
    __syncthreads();
}

typedef float f32x4v __attribute__((ext_vector_type(4)));
#define MFMA16(a, b, c) __builtin_amdgcn_mfma_f32_16x16x32_bf16((a), (b), (c), 0, 0, 0)
__device__ __forceinline__ int gperm(int x) { return (x & ~31) | ((x & 12) << 1) | ((x & 16) >> 2) | (x & 3); }
constexpr int GP_STR = 136;
constexpr int GP_Q = 0, GP_K = 64 * GP_STR * 2, GP_V = 2 * 64 * GP_STR * 2, GP_L = 3 * 64 * GP_STR * 2, GP_LSTR = 68, GP_SC = GP_L + 64 * GP_LSTR * 4;
constexpr int GP_CHUNK = GP_SC + 320 * 4;
static_assert(2 * GP_CHUNK + 16 <= LDS_MISC, "two chunk images must fit below the frame's LDS words");
template <int STRIP> __device__ __forceinline__ void ph_gdn_prep_fast(const bf16* __restrict__ proj, const float* __restrict__ small, const float* __restrict__ conv_w, const float* __restrict__ a_log, const float* __restrict__ dt_bias,
                                                 bf16* __restrict__ UF, bf16* __restrict__ WP, bf16* __restrict__ QGP, bf16* __restrict__ KDT, bf16* __restrict__ AP, float* __restrict__ EGL, unsigned* __restrict__ queue) {
    extern __shared__ __attribute__((aligned(16))) unsigned char lds_dyn[];
    const int tid0 = ltid();
    volatile unsigned* qw = (volatile unsigned*)(lds_dyn + 2 * GP_CHUNK);
#define GP_BAR() asm volatile("s_waitcnt lgkmcnt(0)\n\ts_barrier" ::: "memory")
    for (;;) {
        int tid = tid0; asm volatile("" : "+v"(tid));
        __syncthreads();
        if (tid == 0) *qw = __hip_atomic_fetch_add(queue, 1u, __ATOMIC_RELAXED, __HIP_MEMORY_SCOPE_AGENT);
        __syncthreads();
        const int pair = (int)*qw;
        if (pair >= BATCH * 6 * 32) break;
        const int lane = tid & 63, wave = tid >> 6;
        const int bh = pair >> 5, b = bh / 6, h = bh % 6;
        GP_BAR();
        {
            const int cg = tid & 31, ts = tid >> 5;
            f32x4 cw[3][4];
#pragma unroll
            for (int which = 0; which < 3; ++which)
#pragma unroll
                for (int tap = 0; tap < 4; ++tap) cw[which][tap] = *(const f32x4*)(conv_w + tap * 2304 + which * 768 + h * 128 + 4 * cg);
#pragma unroll 1
            for (int cs = 0; cs < 2; ++cs) {
                const int n = 2 * (pair & 31) + cs; const size_t m0 = (size_t)b * SEQ + n * 64;
                unsigned char* L = lds_dyn + cs * GP_CHUNK;
                const int tb = n * 64 + 4 * ts - 3;
                u32x2 xr[3][7];
#pragma unroll
                for (int which = 0; which < 3; ++which)
#pragma unroll
                    for (int r = 0; r < 7; ++r) { const bool ok = tb + r >= 0; const bf16* src = proj + (m0 + 4 * ts - (ok ? 3 - r : 0)) * NPROJ + which * 768 + h * 128 + 4 * cg;
                        xr[which][r] = *(const u32x2*)src; if (!ok) xr[which][r] = (u32x2){0u, 0u}; }
#pragma unroll
                for (int which = 0; which < 3; ++which) {
                    float xf[7][4];
#pragma unroll
                    for (int r = 0; r < 7; ++r) { xf[r][0] = bf2f((bf16)(xr[which][r].x & 0xffff)); xf[r][1] = bf2f((bf16)(xr[which][r].x >> 16)); xf[r][2] = bf2f((bf16)(xr[which][r].y & 0xffff)); xf[r][3] = bf2f((bf16)(xr[which][r].y >> 16)); }
#pragma unroll
                    for (int j = 0; j < 4; ++j) { float y[4]; float ss = 0.f;
#pragma unroll
                        for (int e = 0; e < 4; ++e) { float v = cw[which][0][e] * xf[j][e]; v += cw[which][1][e] * xf[j + 1][e]; v += cw[which][2][e] * xf[j + 2][e]; v += cw[which][3][e] * xf[j + 3][e]; y[e] = siluf_(v); ss += y[e] * y[e]; }
                        float r = 1.f;
                        if (which < 2) { ss = row16_sum(ss); ss += __shfl_xor(ss, 16); r = rsqrtf(ss + NORM_EPS); if (which == 0) r *= 0.08838834764831845f; }
                        u32x2 o; o.x = cvt2(y[0] * r, y[1] * r); o.y = cvt2(y[2] * r, y[3] * r);
                        *(u32x2*)(L + which * (64 * GP_STR * 2) + ((4 * ts + j) * GP_STR + 4 * cg) * 2) = o; }
                }
            }
        }
        if (wave < 2) {
            const int cs = wave, n = 2 * (pair & 31) + cs, ci = 2 * pair + cs; const size_t m = (size_t)b * SEQ + n * 64 + lane;
            float* sgc = (float*)(lds_dyn + cs * GP_CHUNK + GP_SC);
            const float beta = sigmoidf_(small[m * 32 + SM_BA + h]);
            float g = -__expf(a_log[h]) * softplusf_(small[m * 32 + SM_AA + h] + dt_bias[h]);
#pragma unroll
            for (int o = 1; o < 64; o <<= 1) { const float up = __shfl_up(g, o); if (lane >= o) g += up; }
            const float gl = __shfl(g, 63);
            sgc[lane] = g; sgc[64 + lane] = beta; sgc[128 + lane] = __expf(g); sgc[192 + lane] = __expf(gl - g); sgc[256 + lane] = beta * __expf(g);
            if (lane == 0) EGL[ci] = __expf(gl);
        }
        GP_BAR();
        if (STRIP != 1) { const int r16 = lane & 15, a = lane >> 4;
          for (int tq = wave; tq < 52; tq += NWAVES) {
              const int cs = tq >= 26 ? 1 : 0, tl = tq - 26 * cs, ci = 2 * pair + cs;
              unsigned char* L = lds_dyn + cs * GP_CHUNK; const float* sgc = (const float*)(L + GP_SC); const float* sbeta = sgc + 64;
              const bool isA = tl >= 10; int ti, tj;
              if (!isA) { int k = tl; ti = 0; while (k > ti) { k -= ti + 1; ++ti; } tj = k; }
              else { ti = (tl - 10) >> 2; tj = (tl - 10) & 3; }
              f32x4v acc = {0.f, 0.f, 0.f, 0.f};
              if (tj <= ti) {
                  const unsigned char* xa = L + (isA ? GP_Q : GP_K) + ((16 * ti + r16) * GP_STR + 8 * a) * 2;
                  const unsigned char* xb = L + GP_K + ((16 * tj + r16) * GP_STR + 8 * a) * 2;
#pragma unroll
                  for (int s = 0; s < 4; ++s) acc = MFMA16(__builtin_bit_cast(bf16x8, *(const u32x4*)(xa + 64 * s)), __builtin_bit_cast(bf16x8, *(const u32x4*)(xb + 64 * s)), acc);
              }
              const int j = 16 * tj + r16; const float gj = sgc[j];
#pragma unroll
              for (int reg = 0; reg < 4; ++reg) { const int i = 16 * ti + 4 * a + reg; const float dec = __expf(sgc[i] - gj);
                  if (!isA) { ((float*)(L + GP_L))[i * GP_LSTR + j] = j < i ? sbeta[i] * acc[reg] * dec : 0.f; }
                  else __builtin_nontemporal_store(f2bf(j <= i ? acc[reg] * dec : 0.f), AP + ((size_t)ci * 64 + i) * 64 + gperm(j)); }
          } }
        GP_BAR();
        if (STRIP != 1 && STRIP != 2) {
            const int cs = wave >> 2, ci = 2 * pair + cs;
            unsigned char* L = lds_dyn + cs * GP_CHUNK; const float* sgc = (const float*)(L + GP_SC); const float* sbeta = sgc + 64; const float* segc = sgc + 128; const float* sekd = sgc + 192;
            const int c = (wave & 3) * 64 + lane; const bool isw = c >= 128; const int cc = c & 127;
            const unsigned char* xsrc = L + (isw ? GP_K : GP_V) + cc * 2;
            const float* Lm = (const float*)(L + GP_L);
            float U[64];
            const float* scl = isw ? (sgc + 256) : sbeta;
            f32x4 bA[16], bB[16]; float rA, rB = 0.f;
            rA = bf2f(*(const bf16*)xsrc) * scl[0];
#define GDN_LOADROW(buf, rr_, i_) do { _Pragma("unroll") for (int j4 = 0; j4 < ((i_) + 3) / 4; ++j4) buf[j4] = *(const f32x4*)(Lm + (i_) * GP_LSTR + 4 * j4); rr_ = bf2f(*(const bf16*)(xsrc + (i_) * GP_STR * 2)) * scl[i_]; } while (0)
#define GDN_ROW(buf, rr_, i_) do { float a0 = rr_, a1 = 0.f, a2 = 0.f, a3 = 0.f; _Pragma("unroll") for (int j4 = 0; j4 < ((i_) + 3) / 4; ++j4) { const f32x4 lv = buf[j4]; \
                    if (4 * j4 < (i_)) a0 -= lv.x * U[4 * j4]; if (4 * j4 + 1 < (i_)) a1 -= lv.y * U[4 * j4 + 1]; if (4 * j4 + 2 < (i_)) a2 -= lv.z * U[4 * j4 + 2]; if (4 * j4 + 3 < (i_)) a3 -= lv.w * U[4 * j4 + 3]; } \
                    U[i_] = (a0 + a1) + (a2 + a3); asm volatile("" ::: "memory"); } while (0)
#pragma unroll
            for (int i = 0; i < 64; i += 2) {
                GDN_LOADROW(bB, rB, i + 1);
                GDN_ROW(bA, rA, i);
                if (i + 2 < 64) GDN_LOADROW(bA, rA, i + 2);
                GDN_ROW(bB, rB, i + 1);
            }
#undef GDN_LOADROW
#undef GDN_ROW
            if (STRIP == 3) { if (U[63] == 12345.678f) EGL[ci] = U[5]; } else
            if (!isw) { const int v = cc >> 4, c15 = cc & 15; bf16* dst = UF + ((size_t)ci * 8 + v) * 64 * 16;
#pragma unroll
                for (int aa = 0; aa < 4; ++aa) { u32x4 w0, w1;
                    w0.x = cvt2(U[4 * aa], U[4 * aa + 1]); w0.y = cvt2(U[4 * aa + 2], U[4 * aa + 3]); w0.z = cvt2(U[16 + 4 * aa], U[16 + 4 * aa + 1]); w0.w = cvt2(U[16 + 4 * aa + 2], U[16 + 4 * aa + 3]);
                    w1.x = cvt2(U[32 + 4 * aa], U[32 + 4 * aa + 1]); w1.y = cvt2(U[32 + 4 * aa + 2], U[32 + 4 * aa + 3]); w1.z = cvt2(U[48 + 4 * aa], U[48 + 4 * aa + 1]); w1.w = cvt2(U[48 + 4 * aa + 2], U[48 + 4 * aa + 3]);
                    u32x4* p = (u32x4*)(dst + (16 * aa + c15) * 16); __builtin_nontemporal_store(w0, p); __builtin_nontemporal_store(w1, p + 1); } }
            else { bf16* dst = WP + (size_t)ci * 64 * 128 + gperm(cc);
#pragma unroll
                for (int i = 0; i < 64; ++i) __builtin_nontemporal_store(f2bf(U[i]), dst + i * 128); }
            const int t2 = tid & 255;
            if (STRIP != 3)
#pragma unroll
            for (int it = 0; it < 8; ++it) {
                const int pc = t2 + 256 * it, i = pc >> 5, pos = (pc & 31) * 4; const int s32 = pos & ~31, a = (pos >> 3) & 3, bb = (pos >> 2) & 1, dk = s32 + 16 * bb + 4 * a;
                const u32x2 qv = *(const u32x2*)(L + GP_Q + (i * GP_STR + dk) * 2); const float e = segc[i];
                u32x2 o; o.x = cvt2(bf2f((bf16)(qv.x & 0xffff)) * e, bf2f((bf16)(qv.x >> 16)) * e); o.y = cvt2(bf2f((bf16)(qv.y & 0xffff)) * e, bf2f((bf16)(qv.y >> 16)) * e);
                __builtin_nontemporal_store(o, (u32x2*)(QGP + ((size_t)ci * 64 + i) * 128 + pos)); }
            if (STRIP != 3)
#pragma unroll
            for (int it = 0; it < 8; ++it) {
                const int pc = t2 + 256 * it, dk = pc >> 4, pos = (pc & 15) * 4; const int s32 = pos & ~31, a = (pos >> 3) & 3, bb = (pos >> 2) & 1, i0 = s32 + 16 * bb + 4 * a;
                const unsigned char* ks = L + GP_K + (i0 * GP_STR + dk) * 2;
                const float k0 = bf2f(*(const bf16*)ks) * sekd[i0], k1 = bf2f(*(const bf16*)(ks + GP_STR * 2)) * sekd[i0 + 1], k2 = bf2f(*(const bf16*)(ks + 2 * GP_STR * 2)) * sekd[i0 + 2], k3 = bf2f(*(const bf16*)(ks + 3 * GP_STR * 2)) * sekd[i0 + 3];
                u32x2 o; o.x = cvt2(k0, k1); o.y = cvt2(k2, k3);
                __builtin_nontemporal_store(o, (u32x2*)(KDT + ((size_t)ci * 128 + dk) * 64 + pos)); }
        }
    }
#undef GP_BAR
    __syncthreads();
}

constexpr int GS_WSTR = 272, GS_TSTR = 144;
constexpr int GS_W = 0, GS_Q = 64 * GS_WSTR, GS_KD = 2 * 64 * GS_WSTR, GS_A = GS_KD + 128 * GS_TSTR, GS_STAGE = GS_A + 64 * GS_TSTR;
constexpr int GS_SSQ = 2 * GS_STAGE;
__device__ __forceinline__ void ph_gdn_scan_fast(const bf16* __restrict__ UF, const bf16* __restrict__ WP, const bf16* __restrict__ QGP, const bf16* __restrict__ KDT, const bf16* __restrict__ AP, const float* __restrict__ EGL,
                                                 const bf16* __restrict__ proj, const float* __restrict__ norm_g, bf16* __restrict__ mix, int nblk_scan) {
    extern __shared__ __attribute__((aligned(16))) unsigned char lds_dyn[];
    const int tid = ltid(); const int lane = tid & 63, wave = tid >> 6, r16 = lane & 15, a = lane >> 4;
    for (int bh = blockIdx.x; bh < BATCH * 6; bh += nblk_scan) {
        const int b = bh / 6, h = bh % 6;
        u32x4 st[7];
        auto gload = [&](int ci) {
            const u32x4* w = (const u32x4*)(WP + (size_t)ci * 64 * 128); const u32x4* q = (const u32x4*)(QGP + (size_t)ci * 64 * 128);
            const u32x4* k = (const u32x4*)(KDT + (size_t)ci * 128 * 64); const u32x4* ap = (const u32x4*)(AP + (size_t)ci * 64 * 64);
            st[0] = w[tid]; st[1] = w[tid + 512]; st[2] = q[tid]; st[3] = q[tid + 512]; st[4] = k[tid]; st[5] = k[tid + 512]; st[6] = ap[tid]; };
        auto lwrite = [&](int buf) {
            unsigned char* base = lds_dyn + buf * GS_STAGE;
            *(u32x4*)(base + GS_W + (tid >> 4) * GS_WSTR + (tid & 15) * 16) = st[0]; *(u32x4*)(base + GS_W + ((tid + 512) >> 4) * GS_WSTR + (tid & 15) * 16) = st[1];
            *(u32x4*)(base + GS_Q + (tid >> 4) * GS_WSTR + (tid & 15) * 16) = st[2]; *(u32x4*)(base + GS_Q + ((tid + 512) >> 4) * GS_WSTR + (tid & 15) * 16) = st[3];
            *(u32x4*)(base + GS_KD + (tid >> 3) * GS_TSTR + (tid & 7) * 16) = st[4]; *(u32x4*)(base + GS_KD + ((tid + 512) >> 3) * GS_TSTR + (tid & 7) * 16) = st[5];
            *(u32x4*)(base + GS_A + (tid >> 3) * GS_TSTR + (tid & 7) * 16) = st[6]; };
        f32x4v S[8];
#pragma unroll
        for (int i = 0; i < 8; ++i) S[i] = (f32x4v){0.f, 0.f, 0.f, 0.f};
        const int ci0 = bh * 64;
        __syncthreads();
        gload(ci0); lwrite(0);
        __syncthreads();
        gload(ci0 + 1);
        u32x4 ucur0, ucur1, unext0 = {0u, 0u, 0u, 0u}, unext1 = {0u, 0u, 0u, 0u}; float eglc, egln = 0.f;
        { const u32x4* up = (const u32x4*)(UF + (((size_t)ci0 * 8 + wave) * 64 + lane) * 16); ucur0 = up[0]; ucur1 = up[1]; eglc = EGL[ci0]; }
#define GDN_LDS_BARRIER() asm volatile("s_waitcnt lgkmcnt(0)\n\ts_barrier" ::: "memory")
#pragma unroll 1
        for (int n = 0; n < 64; ++n) {
            const int ci = ci0 + n, buf = n & 1;
            if (n < 63) {
                const u32x4* up = (const u32x4*)(UF + (((size_t)(ci + 1) * 8 + wave) * 64 + lane) * 16); unext0 = up[0]; unext1 = up[1]; egln = EGL[ci + 1]; }
            const unsigned char* base = lds_dyn + buf * GS_STAGE;
            const float egl = eglc;
            const unsigned uw[8] = {ucur0.x, ucur0.y, ucur0.z, ucur0.w, ucur1.x, ucur1.y, ucur1.z, ucur1.w};
            bf16x8 Sb[4];
#pragma unroll
            for (int s = 0; s < 4; ++s) { u32x4 w; w.x = cvt2(S[2 * s][0], S[2 * s][1]); w.y = cvt2(S[2 * s][2], S[2 * s][3]); w.z = cvt2(S[2 * s + 1][0], S[2 * s + 1][1]); w.w = cvt2(S[2 * s + 1][2], S[2 * s + 1][3]); Sb[s] = __builtin_bit_cast(bf16x8, w); }
#define GS_FRAG(off) __builtin_bit_cast(bf16x8, *(const u32x4*)(base + (off)))
#define GS_SB() __builtin_amdgcn_sched_barrier(0)
            bf16x8 fa[4], fb[4];
            f32x4v vn[4], o[4];
            fa[0] = GS_FRAG(GS_W + (16 * 0 + r16) * GS_WSTR + (32 * 0 + 8 * a) * 2); fa[1] = GS_FRAG(GS_W + (16 * 0 + r16) * GS_WSTR + (32 * 1 + 8 * a) * 2); fa[2] = GS_FRAG(GS_W + (16 * 0 + r16) * GS_WSTR + (32 * 2 + 8 * a) * 2); fa[3] = GS_FRAG(GS_W + (16 * 0 + r16) * GS_WSTR + (32 * 3 + 8 * a) * 2); GS_SB();
            fb[0] = GS_FRAG(GS_W + (16 * 1 + r16) * GS_WSTR + (32 * 0 + 8 * a) * 2); fb[1] = GS_FRAG(GS_W + (16 * 1 + r16) * GS_WSTR + (32 * 1 + 8 * a) * 2); fb[2] = GS_FRAG(GS_W + (16 * 1 + r16) * GS_WSTR + (32 * 2 + 8 * a) * 2); fb[3] = GS_FRAG(GS_W + (16 * 1 + r16) * GS_WSTR + (32 * 3 + 8 * a) * 2); GS_SB();
            { f32x4v acc = {0.f, 0.f, 0.f, 0.f}; acc = MFMA16(fa[0], Sb[0], acc); acc = MFMA16(fa[1], Sb[1], acc); acc = MFMA16(fa[2], Sb[2], acc); acc = MFMA16(fa[3], Sb[3], acc); vn[0] = acc; }GS_SB();
            fa[0] = GS_FRAG(GS_W + (16 * 2 + r16) * GS_WSTR + (32 * 0 + 8 * a) * 2); fa[1] = GS_FRAG(GS_W + (16 * 2 + r16) * GS_WSTR + (32 * 1 + 8 * a) * 2); fa[2] = GS_FRAG(GS_W + (16 * 2 + r16) * GS_WSTR + (32 * 2 + 8 * a) * 2); fa[3] = GS_FRAG(GS_W + (16 * 2 + r16) * GS_WSTR + (32 * 3 + 8 * a) * 2); GS_SB();
            { f32x4v acc = {0.f, 0.f, 0.f, 0.f}; acc = MFMA16(fb[0], Sb[0], acc); acc = MFMA16(fb[1], Sb[1], acc); acc = MFMA16(fb[2], Sb[2], acc); acc = MFMA16(fb[3], Sb[3], acc); vn[1] = acc; }GS_SB();
            fb[0] = GS_FRAG(GS_W + (16 * 3 + r16) * GS_WSTR + (32 * 0 + 8 * a) * 2); fb[1] = GS_FRAG(GS_W + (16 * 3 + r16) * GS_WSTR + (32 * 1 + 8 * a) * 2); fb[2] = GS_FRAG(GS_W + (16 * 3 + r16) * GS_WSTR + (32 * 2 + 8 * a) * 2); fb[3] = GS_FRAG(GS_W + (16 * 3 + r16) * GS_WSTR + (32 * 3 + 8 * a) * 2); GS_SB();
            { f32x4v acc = {0.f, 0.f, 0.f, 0.f}; acc = MFMA16(fa[0], Sb[0], acc); acc = MFMA16(fa[1], Sb[1], acc); acc = MFMA16(fa[2], Sb[2], acc); acc = MFMA16(fa[3], Sb[3], acc); vn[2] = acc; }GS_SB();
            fa[0] = GS_FRAG(GS_Q + (16 * 0 + r16) * GS_WSTR + (32 * 0 + 8 * a) * 2); fa[1] = GS_FRAG(GS_Q + (16 * 0 + r16) * GS_WSTR + (32 * 1 + 8 * a) * 2); fa[2] = GS_FRAG(GS_Q + (16 * 0 + r16) * GS_WSTR + (32 * 2 + 8 * a) * 2); fa[3] = GS_FRAG(GS_Q + (16 * 0 + r16) * GS_WSTR + (32 * 3 + 8 * a) * 2); GS_SB();
            { f32x4v acc = {0.f, 0.f, 0.f, 0.f}; acc = MFMA16(fb[0], Sb[0], acc); acc = MFMA16(fb[1], Sb[1], acc); acc = MFMA16(fb[2], Sb[2], acc); acc = MFMA16(fb[3], Sb[3], acc); vn[3] = acc; }GS_SB();
            fb[0] = GS_FRAG(GS_Q + (16 * 1 + r16) * GS_WSTR + (32 * 0 + 8 * a) * 2); fb[1] = GS_FRAG(GS_Q + (16 * 1 + r16) * GS_WSTR + (32 * 1 + 8 * a) * 2); fb[2] = GS_FRAG(GS_Q + (16 * 1 + r16) * GS_WSTR + (32 * 2 + 8 * a) * 2); fb[3] = GS_FRAG(GS_Q + (16 * 1 + r16) * GS_WSTR + (32 * 3 + 8 * a) * 2); GS_SB();
#pragma unroll
            for (int mt = 0; mt < 4; ++mt) { vn[mt][0] = bf2f((bf16)(uw[2 * mt] & 0xffff)) - vn[mt][0]; vn[mt][1] = bf2f((bf16)(uw[2 * mt] >> 16)) - vn[mt][1];
                vn[mt][2] = bf2f((bf16)(uw[2 * mt + 1] & 0xffff)) - vn[mt][2]; vn[mt][3] = bf2f((bf16)(uw[2 * mt + 1] >> 16)) - vn[mt][3]; }
            bf16x8 vb[2];
#pragma unroll
            for (int s2 = 0; s2 < 2; ++s2) { u32x4 w; w.x = cvt2(vn[2 * s2][0], vn[2 * s2][1]); w.y = cvt2(vn[2 * s2][2], vn[2 * s2][3]); w.z = cvt2(vn[2 * s2 + 1][0], vn[2 * s2 + 1][1]); w.w = cvt2(vn[2 * s2 + 1][2], vn[2 * s2 + 1][3]); vb[s2] = __builtin_bit_cast(bf16x8, w); }
            { f32x4v acc = {0.f, 0.f, 0.f, 0.f}; acc = MFMA16(fa[0], Sb[0], acc); acc = MFMA16(fa[1], Sb[1], acc); acc = MFMA16(fa[2], Sb[2], acc); acc = MFMA16(fa[3], Sb[3], acc); o[0] = acc; }GS_SB();
            fa[0] = GS_FRAG(GS_Q + (16 * 2 + r16) * GS_WSTR + (32 * 0 + 8 * a) * 2); fa[1] = GS_FRAG(GS_Q + (16 * 2 + r16) * GS_WSTR + (32 * 1 + 8 * a) * 2); fa[2] = GS_FRAG(GS_Q + (16 * 2 + r16) * GS_WSTR + (32 * 2 + 8 * a) * 2); fa[3] = GS_FRAG(GS_Q + (16 * 2 + r16) * GS_WSTR + (32 * 3 + 8 * a) * 2); GS_SB();
            { f32x4v acc = {0.f, 0.f, 0.f, 0.f}; acc = MFMA16(fb[0], Sb[0], acc); acc = MFMA16(fb[1], Sb[1], acc); acc = MFMA16(fb[2], Sb[2], acc); acc = MFMA16(fb[3], Sb[3], acc); o[1] = acc; }GS_SB();
            fb[0] = GS_FRAG(GS_Q + (16 * 3 + r16) * GS_WSTR + (32 * 0 + 8 * a) * 2); fb[1] = GS_FRAG(GS_Q + (16 * 3 + r16) * GS_WSTR + (32 * 1 + 8 * a) * 2); fb[2] = GS_FRAG(GS_Q + (16 * 3 + r16) * GS_WSTR + (32 * 2 + 8 * a) * 2); fb[3] = GS_FRAG(GS_Q + (16 * 3 + r16) * GS_WSTR + (32 * 3 + 8 * a) * 2); GS_SB();
            { f32x4v acc = {0.f, 0.f, 0.f, 0.f}; acc = MFMA16(fa[0], Sb[0], acc); acc = MFMA16(fa[1], Sb[1], acc); acc = MFMA16(fa[2], Sb[2], acc); acc = MFMA16(fa[3], Sb[3], acc); o[2] = acc; }GS_SB();
            fa[0] = GS_FRAG(GS_A + (16 * 0 + r16) * GS_TSTR + (32 * 0 + 8 * a) * 2); fa[1] = GS_FRAG(GS_A + (16 * 0 + r16) * GS_TSTR + (32 * 1 + 8 * a) * 2); fa[2] = GS_FRAG(GS_A + (16 * 1 + r16) * GS_TSTR + (32 * 0 + 8 * a) * 2); fa[3] = GS_FRAG(GS_A + (16 * 1 + r16) * GS_TSTR + (32 * 1 + 8 * a) * 2); GS_SB();
            { f32x4v acc = {0.f, 0.f, 0.f, 0.f}; acc = MFMA16(fb[0], Sb[0], acc); acc = MFMA16(fb[1], Sb[1], acc); acc = MFMA16(fb[2], Sb[2], acc); acc = MFMA16(fb[3], Sb[3], acc); o[3] = acc; }GS_SB();
            fb[0] = GS_FRAG(GS_A + (16 * 2 + r16) * GS_TSTR + (32 * 0 + 8 * a) * 2); fb[1] = GS_FRAG(GS_A + (16 * 2 + r16) * GS_TSTR + (32 * 1 + 8 * a) * 2); fb[2] = GS_FRAG(GS_A + (16 * 3 + r16) * GS_TSTR + (32 * 0 + 8 * a) * 2); fb[3] = GS_FRAG(GS_A + (16 * 3 + r16) * GS_TSTR + (32 * 1 + 8 * a) * 2); GS_SB();
            o[0] = MFMA16(fa[0], vb[0], o[0]); o[0] = MFMA16(fa[1], vb[1], o[0]); o[1] = MFMA16(fa[2], vb[0], o[1]); o[1] = MFMA16(fa[3], vb[1], o[1]); GS_SB();
            fa[0] = GS_FRAG(GS_KD + (16 * 0 + r16) * GS_TSTR + (32 * 0 + 8 * a) * 2); fa[1] = GS_FRAG(GS_KD + (16 * 0 + r16) * GS_TSTR + (32 * 1 + 8 * a) * 2); fa[2] = GS_FRAG(GS_KD + (16 * 1 + r16) * GS_TSTR + (32 * 0 + 8 * a) * 2); fa[3] = GS_FRAG(GS_KD + (16 * 1 + r16) * GS_TSTR + (32 * 1 + 8 * a) * 2); GS_SB();
            o[2] = MFMA16(fb[0], vb[0], o[2]); o[2] = MFMA16(fb[1], vb[1], o[2]); o[3] = MFMA16(fb[2], vb[0], o[3]); o[3] = MFMA16(fb[3], vb[1], o[3]); GS_SB();
            fb[0] = GS_FRAG(GS_KD + (16 * 2 + r16) * GS_TSTR + (32 * 0 + 8 * a) * 2); fb[1] = GS_FRAG(GS_KD + (16 * 2 + r16) * GS_TSTR + (32 * 1 + 8 * a) * 2); fb[2] = GS_FRAG(GS_KD + (16 * 3 + r16) * GS_TSTR + (32 * 0 + 8 * a) * 2); fb[3] = GS_FRAG(GS_KD + (16 * 3 + r16) * GS_TSTR + (32 * 1 + 8 * a) * 2); GS_SB();
            { f32x4v acc = S[0] * egl; acc = MFMA16(fa[0], vb[0], acc); acc = MFMA16(fa[1], vb[1], acc); S[0] = acc; } { f32x4v acc = S[1] * egl; acc = MFMA16(fa[2], vb[0], acc); acc = MFMA16(fa[3], vb[1], acc); S[1] = acc; } GS_SB();
            fa[0] = GS_FRAG(GS_KD + (16 * 4 + r16) * GS_TSTR + (32 * 0 + 8 * a) * 2); fa[1] = GS_FRAG(GS_KD + (16 * 4 + r16) * GS_TSTR + (32 * 1 + 8 * a) * 2); fa[2] = GS_FRAG(GS_KD + (16 * 5 + r16) * GS_TSTR + (32 * 0 + 8 * a) * 2); fa[3] = GS_FRAG(GS_KD + (16 * 5 + r16) * GS_TSTR + (32 * 1 + 8 * a) * 2); GS_SB();
            { f32x4v acc = S[2] * egl; acc = MFMA16(fb[0], vb[0], acc); acc = MFMA16(fb[1], vb[1], acc); S[2] = acc; } { f32x4v acc = S[3] * egl; acc = MFMA16(fb[2], vb[0], acc); acc = MFMA16(fb[3], vb[1], acc); S[3] = acc; } GS_SB();
            fb[0] = GS_FRAG(GS_KD + (16 * 6 + r16) * GS_TSTR + (32 * 0 + 8 * a) * 2); fb[1] = GS_FRAG(GS_KD + (16 * 6 + r16) * GS_TSTR + (32 * 1 + 8 * a) * 2); fb[2] = GS_FRAG(GS_KD + (16 * 7 + r16) * GS_TSTR + (32 * 0 + 8 * a) * 2); fb[3] = GS_FRAG(GS_KD + (16 * 7 + r16) * GS_TSTR + (32 * 1 + 8 * a) * 2); GS_SB();
            { f32x4v acc = S[4] * egl; acc = MFMA16(fa[0], vb[0], acc); acc = MFMA16(fa[1], vb[1], acc); S[4] = acc; } { f32x4v acc = S[5] * egl; acc = MFMA16(fa[2], vb[0], acc); acc = MFMA16(fa[3], vb[1], acc); S[5] = acc; } GS_SB();
            { f32x4v acc = S[6] * egl; acc = MFMA16(fb[0], vb[0], acc); acc = MFMA16(fb[1], vb[1], acc); S[6] = acc; } { f32x4v acc = S[7] * egl; acc = MFMA16(fb[2], vb[0], acc); acc = MFMA16(fb[3], vb[1], acc); S[7] = acc; } GS_SB();
#undef GS_FRAG
#undef GS_SB
            const size_t mrow = (size_t)b * SEQ + n * 64;
#pragma unroll
            for (int mt = 0; mt < 4; ++mt)
#pragma unroll
                for (int reg = 0; reg < 4; ++reg) mix[(mrow + 16 * mt + 4 * a + reg) * D_MODEL + h * 128 + 16 * wave + r16] = (bf16)(cvt2(o[mt][reg], 0.f) & 0xffffu);
            if (n < 63) lwrite(buf ^ 1);
            if (n < 62) gload(ci + 2);
            GDN_LDS_BARRIER();
            ucur0 = unext0; ucur1 = unext1; eglc = egln;
        }
        asm volatile("s_waitcnt vmcnt(0)" ::: "memory"); __syncthreads(); __builtin_amdgcn_fence(__ATOMIC_ACQUIRE, "agent");
        { const int c0 = (tid & 7) * 16; const float* ngp = norm_g + c0; float ngv[16];
#pragma unroll
          for (int e = 0; e < 16; ++e) ngv[e] = ngp[e];
#pragma unroll 2
          for (int tk = tid >> 3; tk < SEQ; tk += NTHREADS / 8) { const size_t m = (size_t)b * SEQ + tk;
              u32x4* op = (u32x4*)(mix + m * D_MODEL + h * 128 + c0); const u32x4* zp = (const u32x4*)(proj + m * NPROJ + PC_ZA + h * 128 + c0);
              const u32x4 o0 = op[0], o1 = op[1], z0 = zp[0], z1 = zp[1];
              const unsigned ow[8] = {o0.x, o0.y, o0.z, o0.w, o1.x, o1.y, o1.z, o1.w}, zw[8] = {z0.x, z0.y, z0.z, z0.w, z1.x, z1.y, z1.z, z1.w};
              float ov[16]; float ss = 0.f;
#pragma unroll
              for (int e = 0; e < 8; ++e) { ov[2 * e] = __uint_as_float(ow[e] << 16); ov[2 * e + 1] = __uint_as_float(ow[e] & 0xffff0000u); ss += ov[2 * e] * ov[2 * e] + ov[2 * e + 1] * ov[2 * e + 1]; }
              ss += __shfl_xor(ss, 1); ss += __shfl_xor(ss, 2); ss += __shfl_xor(ss, 4);
              const float rstd = rsqrtf(ss * (1.f / 128.f) + NORM_EPS);
              unsigned rw[8];
#pragma unroll
              for (int e = 0; e < 8; ++e) { const float za = __uint_as_float(zw[e] << 16), zb2 = __uint_as_float(zw[e] & 0xffff0000u);
                  rw[e] = cvt2(ov[2 * e] * rstd * ngv[2 * e] * siluf_(za), ov[2 * e + 1] * rstd * ngv[2 * e + 1] * siluf_(zb2)); }
              op[0] = (u32x4){rw[0], rw[1], rw[2], rw[3]}; op[1] = (u32x4){rw[4], rw[5], rw[6], rw[7]}; } }
#undef GDN_LDS_BARRIER
    }
}

constexpr int CP_STR = 272;
constexpr int CP_STAGE = 128 * CP_STR, CP_HID = 2 * CP_STAGE;
__device__ __forceinline__ float gelu_fast(float x) { const float u = 1.5957691216057308f * (x + 0.044715f * x * x * x); return x * __builtin_amdgcn_rcpf(1.0f + __expf(-u)); }
__device__ __forceinline__ void ph_cmp_c1(const float* __restrict__ pos, const float* __restrict__ w1, float* __restrict__ C1) {
    extern __shared__ __attribute__((aligned(16))) unsigned char lds_dyn[];
    const int tid = ltid(); float* red = (float*)lds_dyn;
    for (int o = blockIdx.x; o < 256; o += gridDim.x) { const int kv = o >> 7, j = o & 127; const float* p = pos + kv * 4096; const float* w = w1 + (size_t)kv * 4096 * 128 + j; float s = 0.f;
#pragma unroll
        for (int e = 0; e < 8; ++e) { const int i = tid * 8 + e; s += p[i] * w[(size_t)i * 128]; }
        s = wave_sum(s);
        __syncthreads();
        if ((tid & 63) == 0) red[tid >> 6] = s;
        __syncthreads();
        if (tid == 0) C1[o] = ((red[0] + red[1]) + (red[2] + red[3])) + ((red[4] + red[5]) + (red[6] + red[7])); }
    __syncthreads();
}
__device__ __forceinline__ void ph_nsa_compress_fast(const bf16* __restrict__ proj, const bf16* __restrict__ W1T, const bf16* __restrict__ W2T, const float* __restrict__ C1, const float* __restrict__ kg,
                                                     bf16* __restrict__ KCB, bf16* __restrict__ VCT) {
    extern __shared__ __attribute__((aligned(16))) unsigned char lds_dyn[];
    const int tid0 = ltid();
    for (int item = blockIdx.x; item < 64; item += gridDim.x) {
        int tid = tid0; asm volatile("" : "+v"(tid));
        const int lane = tid & 63, wave = tid >> 6, r16 = lane & 15, a = lane >> 4;
        const int half = item & 1, kv = (item >> 1) & 1, g = (item >> 2) & 1, b = item >> 3;
        const int mt = half * 8 + wave, n = 16 * mt + r16;
        const bf16* arow = proj + (size_t)b * SEQ * NPROJ + (kv ? PC_VCC : PC_KCC) + g * 128 + 8 * a;
        const bf16* w1t = W1T + (size_t)kv * 128 * 4096;
        u32x4 st[4];
        auto gload = [&](int l) {
#pragma unroll
            for (int i = 0; i < 4; ++i) { const int c = tid + 512 * i; st[i] = *(const u32x4*)(w1t + (size_t)(c >> 4) * 4096 + l * 128 + (c & 15) * 8); } };
        auto lwrite = [&](int buf) {
#pragma unroll
            for (int i = 0; i < 4; ++i) { const int c = tid + 512 * i; *(u32x4*)(lds_dyn + buf * CP_STAGE + (c >> 4) * CP_STR + (c & 15) * 16) = st[i]; } };
        f32x4v acc[8];
#pragma unroll
        for (int i = 0; i < 8; ++i) acc[i] = (f32x4v){0.f, 0.f, 0.f, 0.f};
        __syncthreads();
        gload(0); lwrite(0);
        __syncthreads();
#pragma unroll 1
        for (int l = 0; l < 32; ++l) {
            const int buf = l & 1;
            if (l < 31) gload(l + 1);
            const int tok = 16 * n + l < SEQ ? 16 * n + l : SEQ - 1;
            bf16x8 af[4];
#pragma unroll
            for (int s = 0; s < 4; ++s) af[s] = ld_frag(arow + (size_t)tok * NPROJ + 32 * s);
            const unsigned char* wb = lds_dyn + buf * CP_STAGE + r16 * CP_STR + 16 * a;
#pragma unroll
            for (int s = 0; s < 4; ++s)
#pragma unroll
                for (int nt = 0; nt < 8; ++nt) acc[nt] = MFMA16(af[s], __builtin_bit_cast(bf16x8, *(const u32x4*)(wb + nt * 16 * CP_STR + 64 * s)), acc[nt]);
            if (l < 31) lwrite(buf ^ 1);
            __syncthreads();
        }
        unsigned char* hs = lds_dyn + CP_HID + wave * 16 * CP_STR;
#pragma unroll
        for (int nt = 0; nt < 8; ++nt) { const float c1 = C1[kv * 128 + 16 * nt + r16];
#pragma unroll
            for (int reg = 0; reg < 4; ++reg) *(bf16*)(hs + (4 * a + reg) * CP_STR + (16 * nt + r16) * 2) = f2bf(gelu_fast(acc[nt][reg] + c1)); }
        __builtin_amdgcn_s_waitcnt(0); asm volatile("" ::: "memory");
        bf16x8 hf[4];
#pragma unroll
        for (int s = 0; s < 4; ++s) hf[s] = __builtin_bit_cast(bf16x8, *(const u32x4*)(hs + r16 * CP_STR + 64 * s + 16 * a));
        const bf16* w2t = W2T + (size_t)kv * 128 * 128 + (size_t)r16 * 128 + 8 * a;
        f32x4v o2[8];
#pragma unroll
        for (int nt = 0; nt < 8; ++nt) { f32x4v c = {0.f, 0.f, 0.f, 0.f};
#pragma unroll
            for (int s = 0; s < 4; ++s) c = MFMA16(hf[s], ld_frag(w2t + (size_t)nt * 16 * 128 + 32 * s), c);
            o2[nt] = c; }
        const size_t bg = (size_t)(b * 2 + g);
        if (kv == 0) {
            float rs[4];
#pragma unroll
            for (int reg = 0; reg < 4; ++reg) { float q2 = 0.f;
#pragma unroll
                for (int nt = 0; nt < 8; ++nt) q2 += o2[nt][reg] * o2[nt][reg];
                rs[reg] = rsqrtf(row16_sum(q2) * (1.f / 128.f) + NORM_EPS); }
#pragma unroll
            for (int nt = 0; nt < 8; ++nt) { const float gn = kg[16 * nt + r16];
#pragma unroll
                for (int reg = 0; reg < 4; ++reg) { const int nn = 16 * mt + 4 * a + reg; KCB[(bg * 256 + nn) * 128 + 16 * nt + r16] = f2bf(nn < N_CMP ? o2[nt][reg] * rs[reg] * gn : 0.f); } }
        } else {
#pragma unroll
            for (int nt = 0; nt < 8; ++nt) { const bool last = (mt == 15 && a == 3);
                u32x2 w; w.x = cvt2(o2[nt][0], o2[nt][1]); w.y = cvt2(o2[nt][2], last ? 0.f : o2[nt][3]);
                *(u32x2*)(VCT + (bg * 128 + 16 * nt + r16) * 256 + 16 * mt + 8 * (a & 1) + 4 * (a >> 1)) = w; }
        }
    }
    __syncthreads();
}

constexpr int SG_STR = 272;
__device__ __forceinline__ void ph_sgu_wprep(const float* __restrict__ sgu_w, bf16* __restrict__ WSG) {
    const int tid = ltid();
    for (int i = blockIdx.x * NTHREADS + tid; i < 4 * 128 * 128 / 2; i += gridDim.x * NTHREADS) { const int e = 2 * i, s = e & 127, t = (e >> 7) & 127;
        const f32x2 w = *(const f32x2*)(sgu_w + e); *(unsigned*)(WSG + e) = cvt2(s <= t ? w.x : 0.f, s + 1 <= t ? w.y : 0.f); }
}
__device__ __forceinline__ void ph_sgu_mix_fast(const bf16* __restrict__ proj, const bf16* __restrict__ VLN, const bf16* __restrict__ WSG, const float* __restrict__ sgu_b, bf16* __restrict__ mix, unsigned* __restrict__ queue) {
    extern __shared__ __attribute__((aligned(16))) unsigned char lds_dyn[];
    const int tid0 = ltid();
    volatile unsigned* qw = (volatile unsigned*)(lds_dyn + 128 * SG_STR);
    for (;;) {
        int tid = tid0; asm volatile("" : "+v"(tid));
        __syncthreads();
        if (tid == 0) *qw = __hip_atomic_fetch_add(queue, 1u, __ATOMIC_RELAXED, __HIP_MEMORY_SCOPE_AGENT);
        __syncthreads();
        const int item = (int)*qw;
        if (item >= BATCH * 32 * 4) break;
        const int lane = tid & 63, wave = tid >> 6, r16 = lane & 15, a = lane >> 4;
        const int g = item & 3, n = (item >> 2) & 31, b = item >> 7;
        const size_t m0 = (size_t)b * SEQ + n * 128;
        __syncthreads();
#pragma unroll
        for (int i = 0; i < 4; ++i) { const int c = tid + 512 * i, s = c >> 4, part = c & 15;
            *(u32x4*)(lds_dyn + s * SG_STR + part * 16) = *(const u32x4*)(VLN + (m0 + s) * 512 + g * 128 + part * 8); }
        const int nks = ((16 * wave + 15) >> 5) + 1;
        bf16x8 wf[4];
#pragma unroll
        for (int ks = 0; ks < 4; ++ks) wf[ks] = ld_frag(WSG + ((size_t)g * 128 + 16 * wave + r16) * 128 + 32 * ks + 8 * a);
        __syncthreads();
#pragma unroll 2
        for (int nt = 0; nt < 8; ++nt) {
            f32x4v acc = {0.f, 0.f, 0.f, 0.f};
#pragma unroll
            for (int ks = 0; ks < 4; ++ks) if (ks < nks) {
                const unsigned char* vp = lds_dyn + (32 * ks + 8 * a) * SG_STR + (16 * nt + r16) * 2;
                bf16x8 bfr;
#pragma unroll
                for (int j = 0; j < 8; ++j) bfr[j] = *(const short*)(vp + j * SG_STR);
                acc = MFMA16(bfr, wf[ks], acc);
            }
            { const int t = 16 * wave + r16, c = 16 * nt + 4 * a; const float bs = sgu_b[g * 128 + t];
              const u32x2 uu = *(const u32x2*)(proj + (m0 + t) * NPROJ + PC_UB + g * 128 + c);
              u32x2 w; w.x = cvt2(gelu_fast(bf2f((bf16)(uu.x & 0xffff))) * (acc[0] + bs), gelu_fast(bf2f((bf16)(uu.x >> 16))) * (acc[1] + bs));
              w.y = cvt2(gelu_fast(bf2f((bf16)(uu.y & 0xffff))) * (acc[2] + bs), gelu_fast(bf2f((bf16)(uu.y >> 16))) * (acc[3] + bs));
              *(u32x2*)(mix + (m0 + t) * D_MODEL + 768 + g * 128 + c) = w; }
        }
    }
    __syncthreads();
}

constexpr int N_SCAN_WG = 48;
__global__ void __launch_bounds__(NTHREADS, 2) mega(Params P) {
    extern __shared__ __attribute__((aligned(16))) unsigned char lds_dyn[];
    volatile LAS unsigned* st = (volatile LAS unsigned*)(lds_dyn + LDS_MISC);
    if (threadIdx.x == 0) { st[0] = 0u; st[1] = 0u; st[2] = 0u; st[3] = 0u;
        volatile LAS unsigned long long* tab = (volatile LAS unsigned long long*)(lds_dyn + LDS_PTAB);
#pragma unroll
        for (int i = 0; i < 21; ++i) tab[i] = (unsigned long long)P.in[i];
        tab[21] = (unsigned long long)P.out; tab[22] = (unsigned long long)P.ws; }
    __syncthreads();
    unsigned bar_x;
    { const XcdBarrier bar0 = xcd_barrier_post((unsigned*)(P.ws + WS_CTL), st); bar_x = bar0.x; }
#define GRID_BAR() do { XcdBarrier b_; b_.bar = (unsigned*)(gptr(22) + WS_CTL); b_.x = bar_x; b_.st = st; asm volatile("" : "+s"(b_.x)); xcd_barrier(b_); } while (0)
#define WSP() (gptr(22))
#define OUTP() ((float*)gptr(21))
    const int G = (int)gridDim.x;
#pragma unroll 1
    for (int l = 0; l < DEPTH; ++l) {
        { unsigned char* ws = WSP();
        ph_transpose<1>(in_ptr(I_W_IN) + (size_t)l * D_MODEL * NPROJ_ORIG, D_MODEL, NPROJ_ORIG, (bf16*)(ws + WS_WIN), NPROJ, in_ptr(I_ATTN_NORM) + l * D_MODEL);
        ph_transpose<0>(in_ptr(I_CMP_W1) + (size_t)l * 2 * 4096 * 128, 4096, 128, (bf16*)(ws + WS_W1T), 128);
        ph_transpose<0>(in_ptr(I_CMP_W1) + (size_t)(l * 2 + 1) * 4096 * 128, 4096, 128, (bf16*)(ws + WS_W1T) + 128 * 4096, 128);
        ph_transpose<0>(in_ptr(I_CMP_W2) + (size_t)l * 2 * 128 * 128, 128, 128, (bf16*)(ws + WS_W2T), 128);
        ph_transpose<0>(in_ptr(I_CMP_W2) + (size_t)(l * 2 + 1) * 128 * 128, 128, 128, (bf16*)(ws + WS_W2T) + 128 * 128, 128);
        ph_sgu_wprep(in_ptr(I_SGU_W) + (size_t)l * 4 * 128 * 128, (bf16*)(ws + WS_WSG));
        ph_cmp_c1(in_ptr(I_CMP_POS) + (size_t)l * 2 * 4096, in_ptr(I_CMP_W1) + (size_t)l * 2 * 4096 * 128, (float*)(ws + WS_C1));
        if (l == 0) ph_xg0(in_ptr(I_X), in_ptr(I_ATTN_NORM), (bf16*)OUTP(), (float*)(ws + WS_RSQ1));
        else ph_rowsq_reduce((const float*)(ws + WS_RSP), (float*)(ws + WS_RSQ1)); }
        GRID_BAR();
        { unsigned char* ws = WSP(); pg8::Gemm g{(bf16*)OUTP(), (bf16*)(ws + WS_WIN), M, NPROJ, D_MODEL, 0}; pg8::EpiProj E{(bf16*)(ws + WS_PROJ), (float*)(ws + WS_SMALL), (const float*)(ws + WS_RSQ1), NPROJ, PC_SMALL / 256}; pg8::StaticOrder S; S.init(M, NPROJ, G, (int)blockIdx.x);
          pg8::gemm_phase<pg8::EpiProj, pg8::StaticOrder, true, true>((PG8_LAS unsigned char*)lds_dyn, g, S, E); }
        GRID_BAR();
        { unsigned char* ws = WSP(); ph_nsa_compress_fast((bf16*)(ws + WS_PROJ), (bf16*)(ws + WS_W1T), (bf16*)(ws + WS_W2T), (float*)(ws + WS_C1), in_ptr(I_NSA_KN) + l * 128, (bf16*)(ws + WS_KCB), (bf16*)(ws + WS_VCT)); }
        { unsigned char* ws = WSP(); ph_gdn_prep_fast<0>((bf16*)(ws + WS_PROJ), (float*)(ws + WS_SMALL), in_ptr(I_CONV_A) + (size_t)l * 4 * 2304, in_ptr(I_A_LOG) + l * 6, in_ptr(I_DT_BIAS) + l * 6,
                                                      (bf16*)(ws + WS_UF), (bf16*)(ws + WS_WP), (bf16*)(ws + WS_QGP), (bf16*)(ws + WS_KDT), (bf16*)(ws + WS_AP), (float*)(ws + WS_EGL), (unsigned*)(ws + WS_CTL + CTL_QUEUE) + 64 * (8 + l)); }
        { unsigned char* ws = WSP(); ph_sgu_prep((bf16*)(ws + WS_PROJ), in_ptr(I_SGU_LN_G) + l * 512, in_ptr(I_SGU_LN_B) + l * 512, (bf16*)(ws + WS_VLN)); }
        { unsigned char* ws = WSP(); ph_nsa_prep2((bf16*)(ws + WS_PROJ), in_ptr(I_NSA_QN) + l * 128, in_ptr(I_NSA_KN) + l * 128, (bf16*)(ws + WS_NQ), (bf16*)(ws + WS_NKS), (bf16*)(ws + WS_NKW), (bf16*)(ws + WS_VST), (bf16*)(ws + WS_VWT)); }
        GRID_BAR();
        { unsigned char* ws = WSP(); ph_nsa_select_fast((bf16*)(ws + WS_NQ), (bf16*)(ws + WS_KCB), (bf16*)(ws + WS_VCT), (float*)(ws + WS_SMALL), in_ptr(I_REL_BIAS), (unsigned long long*)(ws + WS_SELM), (bf16*)(ws + WS_HB)); }
        { unsigned char* ws = WSP(); ph_sgu_mix_fast((bf16*)(ws + WS_PROJ), (bf16*)(ws + WS_VLN), (bf16*)(ws + WS_WSG), in_ptr(I_SGU_B) + l * 512, (bf16*)(ws + WS_HB), (unsigned*)(ws + WS_CTL + CTL_QUEUE) + 64 * (4 + l)); }
        GRID_BAR();
        if ((int)blockIdx.x < N_SCAN_WG) { unsigned char* ws = WSP(); ph_gdn_scan_fast((bf16*)(ws + WS_UF), (bf16*)(ws + WS_WP), (bf16*)(ws + WS_QGP), (bf16*)(ws + WS_KDT), (bf16*)(ws + WS_AP), (float*)(ws + WS_EGL), (bf16*)(ws + WS_PROJ), in_ptr(I_GDN_NORM) + l * 128, (bf16*)(ws + WS_HB), N_SCAN_WG); }
        { unsigned char* ws = WSP(); ph_nsa_main((bf16*)(ws + WS_NQ), (bf16*)(ws + WS_NKS), (bf16*)(ws + WS_NKW), (bf16*)(ws + WS_VST), (bf16*)(ws + WS_VWT), (unsigned long long*)(ws + WS_SELM), (bf16*)(ws + WS_HB),
                                                 (float*)(ws + WS_SMALL), in_ptr(I_REL_BIAS), (bf16*)(ws + WS_HB), (unsigned*)(ws + WS_CTL + CTL_QUEUE) + 64 * l); }
        { extern __shared__ __attribute__((aligned(16))) unsigned char lds_dyn[];
          volatile unsigned* tqw = (volatile unsigned*)(lds_dyn + LDS_MISC - 64);
          for (;;) {
              __syncthreads();
              if (ltid() == 0) *tqw = __hip_atomic_fetch_add((unsigned*)(WSP() + WS_CTL + CTL_QUEUE) + 64 * (20 + l), 1u, __ATOMIC_RELAXED, __HIP_MEMORY_SCOPE_AGENT);
              __syncthreads();
              const int qi = __builtin_amdgcn_readfirstlane((int)*tqw);
              if (qi >= 32 + 128 + 128) break;
              unsigned char* ws = WSP();
              if (qi < 32) ph_transpose<0>(in_ptr(I_W_OUT) + (size_t)l * D_MODEL * D_MODEL, D_MODEL, D_MODEL, (bf16*)(ws + WS_WOUT), D_MODEL, nullptr, qi * 32, 32);
              else if (qi < 160) ph_transpose<0>(in_ptr(I_W_UP) + (size_t)l * D_MODEL * D_FF, D_MODEL, D_FF, (bf16*)(ws + WS_WUP), D_FF, in_ptr(I_MLP_NORM) + l * D_MODEL, (qi - 32) * 32, 32);
              else ph_transpose<0>(in_ptr(I_W_DOWN) + (size_t)l * D_FF * D_MODEL, D_FF, D_MODEL, (bf16*)(ws + WS_WDN), D_MODEL, nullptr, (qi - 160) * 32, 32);
          }
          __syncthreads(); }
        GRID_BAR();
        { unsigned char* ws = WSP(); float* out = OUTP(); pg8::Gemm g{(bf16*)(ws + WS_HB), (bf16*)(ws + WS_WOUT), M, D_MODEL, D_MODEL, 0}; pg8::EpiRes E{(const bf16*)out, (bf16*)(ws + WS_XG2), nullptr, (float*)(ws + WS_RSP), D_MODEL, 0}; pg8::StaticOrder S; S.init(M, D_MODEL, G, (int)blockIdx.x);
          pg8::gemm_phase<pg8::EpiRes, pg8::StaticOrder, true, true>((PG8_LAS unsigned char*)lds_dyn, g, S, E); }
        GRID_BAR();
        { unsigned char* ws = WSP(); ph_rowsq_reduce((const float*)(ws + WS_RSP), (float*)(ws + WS_RSQ2)); }
        GRID_BAR();
        { unsigned char* ws = WSP(); pg8::Gemm g{(bf16*)(ws + WS_XG2), (bf16*)(ws + WS_WUP), M, D_FF, D_MODEL, 0}; pg8::EpiRelu2 E{(bf16*)(ws + WS_HID), (const float*)(ws + WS_RSQ2), D_FF, 0}; pg8::StaticOrder S; S.init(M, D_FF, G, (int)blockIdx.x);
          pg8::gemm_phase<pg8::EpiRelu2, pg8::StaticOrder, true, true>((PG8_LAS unsigned char*)lds_dyn, g, S, E); }
        GRID_BAR();
        { unsigned char* ws = WSP(); float* out = OUTP(); pg8::Gemm g{(bf16*)(ws + WS_HID), (bf16*)(ws + WS_WDN), M, D_MODEL, D_FF, 0}; pg8::EpiRes E{(const bf16*)(ws + WS_XG2), (bf16*)out, l + 1 < DEPTH ? nullptr : out, (float*)(ws + WS_RSP), D_MODEL, 0}; pg8::StaticOrder S; S.init(M, D_MODEL, G, (int)blockIdx.x);
          pg8::gemm_phase<pg8::EpiRes, pg8::StaticOrder, true, true>((PG8_LAS unsigned char*)lds_dyn, g, S, E); }
        GRID_BAR();
    }
}

extern "C" void kernel_launch(void* const* d_in, const int* in_sizes, int n_in, void* d_out, int out_size, void* d_ws, size_t ws_size, hipStream_t stream) {
    static int grid = 0;
    if (grid == 0) {
        if (n_in != 21 || in_sizes[0] != M * D_MODEL || out_size != M * D_MODEL || ws_size < WS_END) {
            fprintf(stderr, "kernel_launch: unexpected shapes: n_in %d in0 %d out %d ws %zu (need %zu)\n", n_in, n_in > 0 ? in_sizes[0] : -1, out_size, ws_size, (size_t)WS_END); grid = -1; return; }
        int dev = 0, cus = 0, per_cu = 0; (void)hipGetDevice(&dev); (void)hipDeviceGetAttribute(&cus, hipDeviceAttributeMultiprocessorCount, dev);
        if (hipFuncSetAttribute((const void*)mega, hipFuncAttributeMaxDynamicSharedMemorySize, LDS_BYTES) != hipSuccess) { fprintf(stderr, "kernel_launch: hipFuncSetAttribute failed\n"); grid = -1; return; }
        if (hipOccupancyMaxActiveBlocksPerMultiprocessor(&per_cu, (const void*)mega, NTHREADS, LDS_BYTES) != hipSuccess || per_cu < 1) fprintf(stderr, "kernel_launch: occupancy query says %d\n", per_cu);
        (void)hipGetLastError();
        grid = cus > 0 ? cus : 256;
    }
    if (grid < 0) return;
    (void)hipMemsetAsync((char*)d_ws + WS_CTL, 0, 65536, stream);
    Params p{};
    for (int i = 0; i < 21; ++i) p.in[i] = (const float*)d_in[i];
    p.out = (float*)d_out; p.ws = (unsigned char*)d_ws;
    hipLaunchKernelGGL(mega, dim3(grid), dim3(NTHREADS), LDS_BYTES, stream, p);
}
```
